# Optimizing an MI355X kernel written in HIP

```python
import jax, jax.numpy as jnp
from jax import lax
import numpy as np

D_MODEL = 2048
BATCH = 2
SEQ = 8192
DEPTH = 2
DEC_BATCH = 8
DEC_SEQ = 64
PAST_LEN = 1024

CHUNK = 64
D_MIX = D_MODEL
D_A = 768
D_B = 768
D_C = 512
K_A = 3
K_B = 31
POOL_WINDOWS = (2, 4, 8, 16)
N_POOL_GROUPS = len(POOL_WINDOWS)
POOL_GROUP = D_C // N_POOL_GROUPS
POOL_PAD = max(POOL_WINDOWS) - 1
D_FF = 5632
D_IN = 3 * D_A + 2 * D_B + D_C
IN_SPLITS = tuple(np.cumsum([D_A, D_A, D_A, D_B, D_B])[:].tolist())
EPS = 1e-6

kernel_name = "hybrid_streaming_conv_pool_encoder_step"


def _rms(x, g):
    x32 = x.astype(jnp.float32)
    y = x32 * lax.rsqrt(jnp.mean(x32 * x32, axis=-1, keepdims=True) + EPS)
    return (y * g.astype(jnp.float32)).astype(x.dtype)


def _layernorm(x, g, b):
    x32 = x.astype(jnp.float32)
    mu = jnp.mean(x32, axis=-1, keepdims=True)
    xc = x32 - mu
    var = jnp.mean(xc * xc, axis=-1, keepdims=True)
    y = xc * lax.rsqrt(var + EPS) * g.astype(jnp.float32) + b.astype(jnp.float32)
    return y.astype(x.dtype)


def _swiglu(x, wg, wu, wd):
    return (jax.nn.silu(x @ wg) * (x @ wu)) @ wd


def _causal_dwconv(buf, u, w):
    k, c = w.shape
    full = jnp.concatenate([buf.astype(u.dtype), u], axis=1)
    y = lax.conv_general_dilated(full, w[:, None, :].astype(u.dtype), window_strides=(1,),
                                 padding='VALID', dimension_numbers=('NWC', 'WIO', 'NWC'),
                                 feature_group_count=c)
    return y, full[:, full.shape[1] - (k - 1):]


def _pool_mixer(buf, u, pos0, pool_w, pool_scale):
    bsz, seq_len, _ = u.shape
    full = jnp.concatenate([buf.astype(u.dtype), u], axis=1)
    f32 = full.astype(jnp.float32)
    cs = jnp.concatenate([jnp.zeros((bsz, 1, D_C), jnp.float32), lax.cumsum(f32, axis=1)], axis=1)
    pos = pos0 + jnp.arange(seq_len)
    end = cs[:, POOL_PAD + 1:POOL_PAD + 1 + seq_len]
    means = []
    for g, w in enumerate(POOL_WINDOWS):
        sl = slice(g * POOL_GROUP, (g + 1) * POOL_GROUP)
        s = end[:, :, sl] - cs[:, POOL_PAD + 1 - w:POOL_PAD + 1 - w + seq_len, sl]
        cnt = jnp.minimum(pos + 1, w).astype(jnp.float32)[None, :, None]
        means.append(s / cnt)
    d = (jnp.concatenate(means, axis=-1) - u.astype(jnp.float32)).astype(u.dtype)
    d = d.reshape(bsz, seq_len, N_POOL_GROUPS, POOL_GROUP)
    y = jnp.einsum('blgc,gcd->blgd', d, pool_w).reshape(bsz, seq_len, D_C) * pool_scale
    return y, full[:, full.shape[1] - POOL_PAD:]


def _mixer(xn, buf_a, buf_b, buf_p, pos0, w_in, conv_a_w, conv_b_w, conv_b_bias,
           ln_b_gain, ln_b_bias, pool_w, pool_scale, w_out):
    z = xn @ w_in
    h_a, b_a, c_a, glu_a, glu_g, u_p = jnp.split(z, IN_SPLITS, axis=-1)
    conv_a, nbuf_a = _causal_dwconv(buf_a, c_a * h_a, conv_a_w)
    y_a = b_a * conv_a
    v = glu_a * jax.nn.sigmoid(glu_g)
    conv_b, nbuf_b = _causal_dwconv(buf_b, v, conv_b_w)
    y_b = jax.nn.silu(_layernorm(conv_b + conv_b_bias, ln_b_gain, ln_b_bias))
    y_c, nbuf_p = _pool_mixer(buf_p, u_p, pos0, pool_w, pool_scale)
    out = jnp.concatenate([y_a, y_b, y_c], axis=-1) @ w_out
    return out, nbuf_a, nbuf_b, nbuf_p


def _trunk(x, bufs_a, bufs_b, bufs_p, pos0, ffn1_norm, ffn1_wg, ffn1_wu, ffn1_wd, mix_norm, w_in,
           conv_a_w, conv_b_w, conv_b_bias, ln_b_gain, ln_b_bias, pool_w, pool_scale, w_out,
           ffn2_norm, ffn2_wg, ffn2_wu, ffn2_wd, final_norm):
    h = x
    new_a, new_b, new_p = [], [], []
    for l in range(DEPTH):
        h = h + 0.5 * _swiglu(_rms(h, ffn1_norm[l]), ffn1_wg[l], ffn1_wu[l], ffn1_wd[l])
        m, na, nb, npool = _mixer(_rms(h, mix_norm[l]), bufs_a[l], bufs_b[l], bufs_p[l], pos0,
                                  w_in[l], conv_a_w[l], conv_b_w[l], conv_b_bias[l],
                                  ln_b_gain[l], ln_b_bias[l], pool_w[l], pool_scale[l], w_out[l])
        h = h + m
        h = h + 0.5 * _swiglu(_rms(h, ffn2_norm[l]), ffn2_wg[l], ffn2_wu[l], ffn2_wd[l])
        new_a.append(na)
        new_b.append(nb)
        new_p.append(npool)
    return _rms(h, final_norm), jnp.stack(new_a), jnp.stack(new_b), jnp.stack(new_p)


def setup_inputs(seed: int = 0) -> dict:
    key = jax.random.key(seed)
    ks = jax.random.split(key, 32)
    f = jnp.float32
    nrm = lambda k, shape, s: jax.random.normal(k, shape, f) * s
    return {
        "x_prompt": nrm(ks[0], (BATCH, SEQ, D_MODEL), 1.0),
        "x_sample": nrm(ks[1], (DEC_BATCH, DEC_SEQ, D_MODEL), 1.0),
        "cache_conv_a": nrm(ks[2], (DEPTH, DEC_BATCH, K_A - 1, D_A), 1.0),
        "cache_conv_b": nrm(ks[3], (DEPTH, DEC_BATCH, K_B - 1, D_B), 1.0),
        "cache_pool": nrm(ks[4], (DEPTH, DEC_BATCH, POOL_PAD, D_C), 1.0),
        "ffn1_norm": 1.0 + nrm(ks[5], (DEPTH, D_MODEL), 0.01),
        "ffn1_wg": nrm(ks[6], (DEPTH, D_MODEL, D_FF), D_MODEL ** -0.5),
        "ffn1_wu": nrm(ks[7], (DEPTH, D_MODEL, D_FF), D_MODEL ** -0.5),
        "ffn1_wd": nrm(ks[8], (DEPTH, D_FF, D_MODEL), D_FF ** -0.5),
        "mix_norm": 1.0 + nrm(ks[9], (DEPTH, D_MODEL), 0.01),
        "w_in": nrm(ks[10], (DEPTH, D_MODEL, D_IN), D_MODEL ** -0.5),
        "conv_a_w": nrm(ks[11], (DEPTH, K_A, D_A), K_A ** -0.5),
        "conv_b_w": nrm(ks[12], (DEPTH, K_B, D_B), K_B ** -0.5),
        "conv_b_bias": nrm(ks[13], (DEPTH, D_B), 0.02),
        "ln_b_gain": 1.0 + nrm(ks[14], (DEPTH, D_B), 0.01),
        "ln_b_bias": nrm(ks[15], (DEPTH, D_B), 0.02),
        "pool_w": nrm(ks[16], (DEPTH, N_POOL_GROUPS, POOL_GROUP, POOL_GROUP), POOL_GROUP ** -0.5),
        "pool_scale": 1.0 + nrm(ks[17], (DEPTH, D_C), 0.1),
        "w_out": nrm(ks[18], (DEPTH, D_MIX, D_MODEL), D_MIX ** -0.5),
        "ffn2_norm": 1.0 + nrm(ks[19], (DEPTH, D_MODEL), 0.01),
        "ffn2_wg": nrm(ks[20], (DEPTH, D_MODEL, D_FF), D_MODEL ** -0.5),
        "ffn2_wu": nrm(ks[21], (DEPTH, D_MODEL, D_FF), D_MODEL ** -0.5),
        "ffn2_wd": nrm(ks[22], (DEPTH, D_FF, D_MODEL), D_FF ** -0.5),
        "final_norm": 1.0 + nrm(ks[23], (D_MODEL,), 0.01),
    }


def reference(x_prompt, x_sample, cache_conv_a, cache_conv_b, cache_pool, ffn1_norm, ffn1_wg,
              ffn1_wu, ffn1_wd, mix_norm, w_in, conv_a_w, conv_b_w, conv_b_bias, ln_b_gain,
              ln_b_bias, pool_w, pool_scale, w_out, ffn2_norm, ffn2_wg, ffn2_wu, ffn2_wd, final_norm):
    weights = (ffn1_norm, ffn1_wg, ffn1_wu, ffn1_wd, mix_norm, w_in, conv_a_w, conv_b_w, conv_b_bias,
               ln_b_gain, ln_b_bias, pool_w, pool_scale, w_out, ffn2_norm, ffn2_wg, ffn2_wu, ffn2_wd,
               final_norm)
    bp = x_prompt.shape[0]
    dt = x_prompt.dtype
    zero_a = jnp.zeros((DEPTH, bp, K_A - 1, D_A), dt)
    zero_b = jnp.zeros((DEPTH, bp, K_B - 1, D_B), dt)
    zero_p = jnp.zeros((DEPTH, bp, POOL_PAD, D_C), dt)
    y_prompt, new_a_p, new_b_p, new_pool_p = _trunk(x_prompt, zero_a, zero_b, zero_p, 0, *weights)
    y_sample, new_a_s, new_b_s, new_pool_s = _trunk(x_sample, cache_conv_a, cache_conv_b, cache_pool,
                                                     PAST_LEN, *weights)
    return (y_prompt, y_sample, new_a_p, new_b_p, new_pool_p, new_a_s, new_b_s, new_pool_s)
```

```cpp
#include <hip/hip_runtime.h>
#include <hip/hip_cooperative_groups.h>
#include <cstdio>
#include <cstdint>
namespace cg = cooperative_groups;

#define LAS __attribute__((address_space(3)))
typedef unsigned short bf16_t;
typedef short bf16x8 __attribute__((ext_vector_type(8)));
typedef float f32x4 __attribute__((ext_vector_type(4)));
typedef float f32x2 __attribute__((ext_vector_type(2)));
typedef unsigned u32x4 __attribute__((ext_vector_type(4)));
typedef unsigned u32x2 __attribute__((ext_vector_type(2)));

constexpr int DM = 2048, DFF = 5632, DIN = 4352, DA = 768, DB = 768, DC = 512;
constexpr int MP = 16384, MS = 512, MT = MP + MS;
constexpr float EPS = 1e-6f;
constexpr size_t MiB = 1u << 20;
constexpr size_t WS_SS = 0, WS_W = 1 * MiB, W_LAYER = 157 * MiB;
constexpr size_t W_GU1 = 0, W_D1 = 44 * MiB, W_IN = 66 * MiB, W_OUT = 83 * MiB, W_GU2 = 91 * MiB, W_D2 = 135 * MiB;
constexpr size_t WS_HB = 315 * MiB, WS_ACT = 381 * MiB, WS_CAT = 563 * MiB, WS_SLAB = 629 * MiB, WS_SSP = 645 * MiB, WS_END = 648 * MiB;
constexpr int OFF_A_P = 34603008, OFF_B_P = OFF_A_P + 6144, OFF_P_P = OFF_B_P + 92160, OFF_A_S = OFF_P_P + 30720, OFF_B_S = OFF_A_S + 24576, OFF_P_S = OFF_B_S + 368640;
#ifndef REP_GU
#define REP_GU 1
#endif
#ifndef REP_WIN
#define REP_WIN 1
#endif
#ifndef REP_MIX
#define REP_MIX 1
#endif
#ifndef REP_PRO
#define REP_PRO 1
#endif
constexpr int LDS_BYTES = 147456, MISC_OFF = 139264;
constexpr size_t WS_BAR = 512 * 1024, WS_BAR_BYTES = 16384;

#define LDS_WAIT() asm volatile("s_waitcnt lgkmcnt(0)" ::: "memory")

__device__ __forceinline__ unsigned cvt_pk_bf16(float lo, float hi) { unsigned r; asm volatile("v_cvt_pk_bf16_f32 %0, %1, %2" : "=v"(r) : "v"(lo), "v"(hi)); return r; }
__device__ __forceinline__ float bf_lo(unsigned w) { return __uint_as_float(w << 16); }
__device__ __forceinline__ float bf_hi(unsigned w) { return __uint_as_float(w & 0xffff0000u); }
__device__ __forceinline__ float sigmoidf_(float x) { return __builtin_amdgcn_rcpf(1.f + __builtin_amdgcn_exp2f(-1.44269504f * x)); }
__device__ __forceinline__ float siluf_(float x) { return x * sigmoidf_(x); }
__device__ __forceinline__ float wave_sum(float v) {
#pragma unroll
    for (int o = 1; o < 64; o <<= 1) v += __shfl_xor(v, o);
    return v;
}

namespace pg8 {
constexpr int BM = 256, BK = 64, HALF = 128, HTB = HALF * BK * 2, STAGE_BYTES = 8 * HTB, NXCD = 8, WGM = 8;
__host__ __device__ __forceinline__ int lds_byte(int r, int c) { const int st = (r >> 4) * 2 + (c >> 5), rr = r & 15, cc = c & 31, ob = rr * 64 + cc * 2; return st * 1024 + (ob ^ (((ob >> 9) & 1) << 5)); }
__host__ __device__ __forceinline__ void stage_rc(int b, int& R, int& C) { const int st = b / 1024, sb = b % 1024, swz = sb ^ (((sb >> 9) & 1) << 5); R = (st >> 1) * 16 + swz / 64; C = (st & 1) * 32 + (swz % 64) / 2; }
__host__ __device__ __forceinline__ int perm32(int rho) { const int n = rho >> 4, i = rho & 15; return 8 * (i >> 2) + 4 * n + (i & 3); }

struct Unit { int pm, pn, kb; };
struct Gemm { const bf16_t* A; const bf16_t* Bt; int M, N, K, nt; };

struct StaticOrder {
    int nM, nN, nwg, G, c;
    __device__ void init(int M, int N, int G_, int c_) { nM = M / BM; nN = N / BM; nwg = nM * nN; G = G_; c = c_; }
    __device__ __forceinline__ bool next(int i, Unit& u) const {
        const long L = (long)i * G + c; if (L >= nwg) return false;
        int wgid = (int)L; { const int q = nwg / NXCD, r = nwg % NXCD, xcd = wgid % NXCD, off = wgid / NXCD; wgid = (xcd < r ? xcd * (q + 1) : r * (q + 1) + (xcd - r) * q) + off; }
        const int nig = WGM * nN, gid = wgid / nig, fm = gid * WGM, gsz = (nM - fm) < WGM ? (nM - fm) : WGM;
        u.pm = fm + ((wgid % nig) % gsz); u.pn = (wgid % nig) / gsz; u.kb = 0; return true;
    }
    __device__ __forceinline__ void a_ready(const Unit&) const {}
    __device__ __forceinline__ void done(const Unit&) const {}
};

struct EpiSwiGLU {
    static constexpr bool PERM = true, AFTER_DRAIN = false, PREF = true;
    bf16_t* O; const float* ss;
    __device__ __forceinline__ void prefetch(const Unit& u, int wr, int fr, float (&sv)[8]) const {
        const int row0 = u.pm * BM + wr * 64 + fr;
#pragma unroll
        for (int ai = 0; ai < 2; ++ai)
#pragma unroll
            for (int m = 0; m < 4; ++m) sv[ai * 4 + m] = ss[row0 + ai * HALF + m * 16];
    }
    __device__ __forceinline__ void operator()(const f32x4 (&acc)[2][2][4][2], const Unit& u, int wr, int wc, int fr, int fq, const float (&sv)[8]) const {
        const int row0 = u.pm * BM + wr * 64 + fr, col0 = u.pn * HALF + wc * 32 + 8 * fq;
#pragma unroll
        for (int ai = 0; ai < 2; ++ai)
#pragma unroll
            for (int m = 0; m < 4; ++m) {
                const int row = row0 + ai * HALF + m * 16;
                const float rinv = __builtin_amdgcn_rsqf(sv[ai * 4 + m] * (1.f / DM) + EPS), rneg = rinv * -1.44269504f, r2 = rinv * rinv;
                const f32x4 g0 = acc[ai][0][m][0], g1 = acc[ai][0][m][1], u0 = acc[ai][1][m][0], u1 = acc[ai][1][m][1];
                f32x4 e0, e1;
#pragma unroll
                for (int j = 0; j < 4; ++j) { e0[j] = __builtin_amdgcn_rcpf(1.f + __builtin_amdgcn_exp2f(g0[j] * rneg)); e1[j] = __builtin_amdgcn_rcpf(1.f + __builtin_amdgcn_exp2f(g1[j] * rneg)); }
                const f32x4 a0 = (g0 * u0) * (e0 * r2), a1 = (g1 * u1) * (e1 * r2);
                u32x4 w;
                w.x = cvt_pk_bf16(a0[0], a0[1]); w.y = cvt_pk_bf16(a0[2], a0[3]); w.z = cvt_pk_bf16(a1[0], a1[1]); w.w = cvt_pk_bf16(a1[2], a1[3]);
                *(u32x4*)(O + (size_t)row * DFF + col0) = w;
            }
    }
};
struct EpiScaleBf16 {
    static constexpr bool PERM = true, AFTER_DRAIN = false, PREF = true;
    bf16_t* O; int ldc; const float* ss;
    __device__ __forceinline__ void prefetch(const Unit& u, int wr, int fr, float (&sv)[8]) const {
        const int row0 = u.pm * BM + wr * 64 + fr;
#pragma unroll
        for (int ai = 0; ai < 2; ++ai)
#pragma unroll
            for (int m = 0; m < 4; ++m) sv[ai * 4 + m] = ss[row0 + ai * HALF + m * 16];
    }
    __device__ __forceinline__ void operator()(const f32x4 (&acc)[2][2][4][2], const Unit& u, int wr, int wc, int fr, int fq, const float (&sv)[8]) const {
        const int row0 = u.pm * BM + wr * 64 + fr, col0 = u.pn * BM + wc * 32 + 8 * fq;
#pragma unroll
        for (int ai = 0; ai < 2; ++ai)
#pragma unroll
            for (int m = 0; m < 4; ++m) {
                const int row = row0 + ai * HALF + m * 16;
                const float rinv = __builtin_amdgcn_rsqf(sv[ai * 4 + m] * (1.f / DM) + EPS);
                bf16_t* rowp = O + (size_t)row * ldc + col0;
#pragma unroll
                for (int bj = 0; bj < 2; ++bj) { const f32x4 v0 = acc[ai][bj][m][0] * rinv, v1 = acc[ai][bj][m][1] * rinv;
                    u32x4 w; w.x = cvt_pk_bf16(v0[0], v0[1]); w.y = cvt_pk_bf16(v0[2], v0[3]); w.z = cvt_pk_bf16(v1[0], v1[1]); w.w = cvt_pk_bf16(v1[2], v1[3]);
                    *(u32x4*)(rowp + bj * HALF) = w; }
            }
    }
};
struct EpiResid {
    static constexpr bool PERM = true, AFTER_DRAIN = false, PREF = false;
    bf16_t* hb; float* ssn; float scale;
    __device__ __forceinline__ void prefetch(const Unit&, int, int, float (&)[8]) const {}
    __device__ __forceinline__ void operator()(const f32x4 (&acc)[2][2][4][2], const Unit& u, int wr, int wc, int fr, int fq, const float (&)[8]) const {
        const int row0 = u.pm * BM + wr * 64 + fr, col0 = u.pn * BM + wc * 32 + 8 * fq;
        bf16_t* bp0 = hb + (size_t)row0 * DM + col0;
#pragma unroll
        for (int ai = 0; ai < 2; ++ai) {
            u32x4 b[4][2];
#pragma unroll
            for (int m = 0; m < 4; ++m)
#pragma unroll
                for (int bj = 0; bj < 2; ++bj) b[m][bj] = *(const u32x4*)(bp0 + (size_t)(ai * HALF + m * 16) * DM + bj * HALF);
#pragma unroll
            for (int m = 0; m < 4; ++m) {
                const int row = row0 + ai * HALF + m * 16;
                float s = 0.f;
#pragma unroll
                for (int bj = 0; bj < 2; ++bj) { const u32x4 bb = b[m][bj];
                    const f32x4 b0 = (f32x4){bf_lo(bb.x), bf_hi(bb.x), bf_lo(bb.y), bf_hi(bb.y)}, b1 = (f32x4){bf_lo(bb.z), bf_hi(bb.z), bf_lo(bb.w), bf_hi(bb.w)};
                    const f32x4 h0 = b0 + acc[ai][bj][m][0] * scale, h1 = b1 + acc[ai][bj][m][1] * scale;
                    u32x4 w; w.x = cvt_pk_bf16(h0[0], h0[1]); w.y = cvt_pk_bf16(h0[2], h0[3]); w.z = cvt_pk_bf16(h1[0], h1[1]); w.w = cvt_pk_bf16(h1[2], h1[3]);
                    *(u32x4*)(bp0 + (size_t)(ai * HALF + m * 16) * DM + bj * HALF) = w;
                    const f32x4 r0 = (f32x4){bf_lo(w.x), bf_hi(w.x), bf_lo(w.y), bf_hi(w.y)}, r1 = (f32x4){bf_lo(w.z), bf_hi(w.z), bf_lo(w.w), bf_hi(w.w)};
                    s += (r0[0] * r0[0] + r0[1] * r0[1]) + (r0[2] * r0[2] + r0[3] * r0[3]) + (r1[0] * r1[0] + r1[1] * r1[1]) + (r1[2] * r1[2] + r1[3] * r1[3]); }
                s += __shfl_xor(s, 16); s += __shfl_xor(s, 32);
                if (fq == 0) ssn[(size_t)row * 32 + u.pn * 4 + wc] = s;
            }
            asm volatile("" ::: "memory");
        }
    }
};

struct SplitOrder {
    int c, kslice;
    __device__ __forceinline__ bool next(int i, Unit& u) const {
        if (i != 0 || c >= 64) return false;
        u.pm = 64 + (c & 1); u.pn = (c >> 1) & 7; u.kb = (c >> 4) * kslice; return true;
    }
    __device__ __forceinline__ void a_ready(const Unit&) const {}
    __device__ __forceinline__ void done(const Unit&) const {}
};
struct EpiSlab {
    static constexpr bool PERM = true, AFTER_DRAIN = false;
    static constexpr bool PREF = false;
    float* slab; float scale; int kslice;
    __device__ __forceinline__ void prefetch(const Unit&, int, int, float (&)[8]) const {}
    __device__ __forceinline__ void operator()(const f32x4 (&acc)[2][2][4][2], const Unit& u, int wr, int wc, int fr, int fq, const float (&)[8]) const {
        const int row0 = (u.pm - 64) * BM + wr * 64 + fr, col0 = u.pn * BM + wc * 32 + 8 * fq;
        float* sp = slab + (size_t)(u.kb / kslice) * (MS * DM);
#pragma unroll
        for (int ai = 0; ai < 2; ++ai)
#pragma unroll
            for (int m = 0; m < 4; ++m) { float* rp = sp + (size_t)(row0 + ai * HALF + m * 16) * DM + col0;
#pragma unroll
                for (int bj = 0; bj < 2; ++bj)
#pragma unroll
                    for (int n = 0; n < 2; ++n) *(f32x4*)(rp + bj * HALF + n * 4) = acc[ai][bj][m][n] * scale; }
    }
};

template <class Epi, class Sched, bool ALIGN_EPI = false, bool SP2 = false>
__device__ __forceinline__ void gemm_phase(LAS unsigned char* lds, const Gemm g, const Sched& S, const Epi& E) {
    int tid = threadIdx.x; asm volatile("" : "+v"(tid));
    const int wid = __builtin_amdgcn_readfirstlane(tid >> 6), lane = tid & 63, wr = wid >> 2, wc = wid & 3, fr = lane & 15, fq = lane >> 4;
    const int K = g.K, nt = g.nt;
    unsigned voffA[2], voffB[2];
#pragma unroll
    for (int i = 0; i < 2; ++i) { int R, C; stage_rc(tid * 16 + i * 8192, R, C); const int Rb = Epi::PERM ? ((R & ~31) + perm32(R & 31)) : R;
        voffA[i] = (unsigned)(R * K + C) * 2u; voffB[i] = (unsigned)(Rb * K + C) * 2u; }
    const size_t kstep = (size_t)(BK * 2);
    const size_t hstep = (size_t)HALF * K * 2;
    const size_t tstep = 2 * hstep;
    const unsigned ldsw = (unsigned)wid * 1024u;
    const int aoff = lds_byte(wr * 64 + fr, fq * 8), boff = lds_byte(wc * 32 + fr, fq * 8);
#define PG8_SA(b, h) (((b) * 2 + (h)) * HTB)
#define PG8_SB(b, h) ((4 + (b) * 2 + (h)) * HTB)
#define PG8_STAGE(bufoff, gbase, voff) do { _Pragma("unroll") for (int _i = 0; _i < 2; ++_i) \
        __builtin_amdgcn_global_load_lds((const unsigned*)((const char*)(gbase) + (voff)[_i]), (LAS unsigned*)(lds + (bufoff) + ldsw + _i * 8192), 16, 0, 0); } while (0)
#define PG8_LDA(dst, b, h) do { _Pragma("unroll") for (int m = 0; m < 4; ++m) _Pragma("unroll") for (int k = 0; k < 2; ++k) dst[m][k] = *(const LAS bf16x8*)(lds + PG8_SA(b, h) + aoff + m * 2048 + k * 1024); } while (0)
#define PG8_LDB(dst, b, h) do { _Pragma("unroll") for (int n = 0; n < 2; ++n) _Pragma("unroll") for (int k = 0; k < 2; ++k) dst[n][k] = *(const LAS bf16x8*)(lds + PG8_SB(b, h) + boff + n * 2048 + k * 1024); } while (0)
#define PG8_MMA(ai, bj, At, Bt) do { __builtin_amdgcn_s_setprio(1); _Pragma("unroll") for (int m = 0; m < 4; ++m) _Pragma("unroll") for (int n = 0; n < 2; ++n) _Pragma("unroll") for (int k = 0; k < 2; ++k) \
        acc[ai][bj][m][n] = __builtin_amdgcn_mfma_f32_16x16x32_bf16(Bt[n][k], At[m][k], acc[ai][bj][m][n], 0, 0, 0); __builtin_amdgcn_s_setprio(0); } while (0)
#define PG8_WAIT_V(n) asm volatile("s_waitcnt vmcnt(" #n ")" ::: "memory")
#define PG8_WAIT_L(n) asm volatile("s_waitcnt lgkmcnt(" #n ")" ::: "memory")
#define PG8_BAR __builtin_amdgcn_s_barrier()
#define PG8_SCHED __builtin_amdgcn_sched_barrier(0)
    Unit cur, nxt; int ui = 0;
    if (!S.next(0, cur)) return;
    f32x4 acc[2][2][4][2];
#pragma unroll
    for (int a = 0; a < 2; ++a)
#pragma unroll
        for (int b = 0; b < 2; ++b)
#pragma unroll
            for (int m = 0; m < 4; ++m)
#pragma unroll
                for (int n = 0; n < 2; ++n) acc[a][b][m][n] = (f32x4){0.f, 0.f, 0.f, 0.f};
    bf16x8 At[4][2], B0[2][2], B1[2][2];
    const char* cA = (const char*)g.A + (size_t)cur.pm * tstep + cur.kb; const char* cB = (const char*)g.Bt + (size_t)cur.pn * tstep + cur.kb;
    S.a_ready(cur);
    float sv[8];
    if constexpr (Epi::PREF) E.prefetch(cur, wr, fr, sv);
    if constexpr (SP2) {
        PG8_STAGE(PG8_SB(0, 0), cB, voffB); PG8_STAGE(PG8_SB(0, 1), cB + hstep, voffB); PG8_STAGE(PG8_SA(0, 0), cA, voffA); PG8_STAGE(PG8_SA(0, 1), cA + hstep, voffA);
        if (wr == 1) PG8_BAR;
        PG8_WAIT_V(2); PG8_BAR;
        PG8_STAGE(PG8_SB(1, 0), cB + kstep, voffB); PG8_STAGE(PG8_SA(1, 0), cA + kstep, voffA); PG8_STAGE(PG8_SB(1, 1), cB + hstep + kstep, voffB);
        PG8_WAIT_V(6); PG8_BAR;
    } else {
        PG8_STAGE(PG8_SB(0, 0), cB, voffB); PG8_STAGE(PG8_SA(0, 0), cA, voffA); PG8_STAGE(PG8_SB(0, 1), cB + hstep, voffB); PG8_STAGE(PG8_SA(0, 1), cA + hstep, voffA);
        if (wr == 1) PG8_BAR;
        PG8_WAIT_V(4); PG8_BAR;
        PG8_STAGE(PG8_SB(1, 0), cB + kstep, voffB); PG8_STAGE(PG8_SA(1, 0), cA + kstep, voffA); PG8_STAGE(PG8_SB(1, 1), cB + hstep + kstep, voffB);
        PG8_WAIT_V(6); PG8_BAR;
    }
    for (;;) {
        const bool has_next = S.next(ui + 1, nxt);
        const char* nA = has_next ? (const char*)g.A + (size_t)nxt.pm * tstep + nxt.kb : cA; const char* nB = has_next ? (const char*)g.Bt + (size_t)nxt.pn * tstep + nxt.kb : cB;
        for (int t = 0; t < nt; t += 2) {
            const bool last = (t == nt - 2);
            const char* a1 = cA + (size_t)(t + 1) * kstep;
            const char* a2 = last ? nA : cA + (size_t)(t + 2) * kstep; const char* b2 = last ? nB : cB + (size_t)(t + 2) * kstep;
            const char* a3 = a2 + kstep; const char* b3 = b2 + kstep;
            if (last && has_next) S.a_ready(nxt);
            if constexpr (SP2) {
            PG8_LDB(B0, 0, 0); PG8_LDB(B1, 0, 1); PG8_SCHED; PG8_LDA(At, 0, 0); PG8_STAGE(PG8_SA(1, 1), a1 + hstep, voffA);
            PG8_WAIT_V(8); PG8_WAIT_L(0); PG8_BAR; PG8_MMA(0, 0, At, B0); PG8_MMA(0, 1, At, B1); PG8_BAR; PG8_SCHED;
            PG8_LDA(At, 0, 1); PG8_STAGE(PG8_SB(0, 0), b2, voffB); PG8_STAGE(PG8_SB(0, 1), b2 + hstep, voffB); PG8_STAGE(PG8_SA(0, 0), a2, voffA);
            PG8_WAIT_V(8); PG8_WAIT_L(0); PG8_BAR; PG8_MMA(1, 0, At, B0); PG8_MMA(1, 1, At, B1); PG8_BAR; PG8_SCHED;
            PG8_LDB(B0, 1, 0); PG8_LDB(B1, 1, 1); PG8_SCHED; PG8_LDA(At, 1, 0); PG8_STAGE(PG8_SA(0, 1), a2 + hstep, voffA);
            PG8_WAIT_V(8); PG8_WAIT_L(0); PG8_BAR; PG8_MMA(0, 0, At, B0); PG8_MMA(0, 1, At, B1); PG8_BAR; PG8_SCHED;
            PG8_LDA(At, 1, 1); PG8_STAGE(PG8_SB(1, 0), b3, voffB); PG8_STAGE(PG8_SB(1, 1), b3 + hstep, voffB); PG8_STAGE(PG8_SA(1, 0), a3, voffA);
            PG8_WAIT_V(8); PG8_WAIT_L(0); PG8_BAR; PG8_MMA(1, 0, At, B0); PG8_MMA(1, 1, At, B1); PG8_BAR; PG8_SCHED;
            } else {
            PG8_LDB(B0, 0, 0); PG8_SCHED; PG8_LDA(At, 0, 0); PG8_STAGE(PG8_SA(1, 1), a1 + hstep, voffA);
            PG8_WAIT_L(8); PG8_BAR; PG8_WAIT_L(0); PG8_MMA(0, 0, At, B0); PG8_BAR; PG8_SCHED;
            PG8_LDB(B1, 0, 1); PG8_STAGE(PG8_SB(0, 0), b2, voffB);
            PG8_BAR; PG8_WAIT_L(0); PG8_MMA(0, 1, At, B1); PG8_BAR;
            PG8_LDA(At, 0, 1); PG8_STAGE(PG8_SA(0, 0), a2, voffA);
            PG8_BAR; PG8_WAIT_L(0); PG8_MMA(1, 0, At, B0); PG8_BAR; PG8_SCHED;
            PG8_STAGE(PG8_SB(0, 1), b2 + hstep, voffB);
            PG8_WAIT_V(6); PG8_BAR; PG8_MMA(1, 1, At, B1); PG8_BAR;
            PG8_LDB(B0, 1, 0); PG8_SCHED; PG8_LDA(At, 1, 0); PG8_STAGE(PG8_SA(0, 1), a2 + hstep, voffA);
            PG8_WAIT_L(8); PG8_BAR; PG8_WAIT_L(0); PG8_MMA(0, 0, At, B0); PG8_BAR; PG8_SCHED;
            PG8_LDB(B1, 1, 1); PG8_STAGE(PG8_SB(1, 0), b3, voffB);
            PG8_BAR; PG8_WAIT_L(0); PG8_MMA(0, 1, At, B1); PG8_BAR;
            PG8_LDA(At, 1, 1); PG8_STAGE(PG8_SA(1, 0), a3, voffA);
            PG8_BAR; PG8_WAIT_L(0); PG8_MMA(1, 0, At, B0); PG8_BAR; PG8_SCHED;
            PG8_STAGE(PG8_SB(1, 1), b3 + hstep, voffB);
            PG8_WAIT_V(6); PG8_BAR; PG8_MMA(1, 1, At, B1); PG8_BAR;
            }
        }
        if constexpr (ALIGN_EPI) { if (wr == 0) PG8_BAR; }
        if constexpr (!Epi::AFTER_DRAIN) { E(acc, cur, wr, wc, fr, fq, sv); S.done(cur); }
        if (!has_next) break;
#pragma unroll
        for (int a = 0; a < 2; ++a)
#pragma unroll
            for (int b = 0; b < 2; ++b)
#pragma unroll
                for (int m = 0; m < 4; ++m)
#pragma unroll
                    for (int n = 0; n < 2; ++n) acc[a][b][m][n] = (f32x4){0.f, 0.f, 0.f, 0.f};
        cur = nxt; cA = nA; cB = nB; ++ui;
        if constexpr (Epi::PREF) E.prefetch(cur, wr, fr, sv);
        if constexpr (ALIGN_EPI) { if (wr == 1) PG8_BAR; }
    }
    PG8_WAIT_V(0);
    if constexpr (!ALIGN_EPI) { if (wr == 0) PG8_BAR; }
    PG8_BAR;
#undef PG8_SA
#undef PG8_SB
#undef PG8_STAGE
#undef PG8_LDA
#undef PG8_LDB
#undef PG8_MMA
#undef PG8_WAIT_V
#undef PG8_WAIT_L
#undef PG8_BAR
#undef PG8_SCHED
}
}

struct Params { const float* in[24]; float* out; unsigned char* ws; };
enum { I_XP = 0, I_XS, I_CA, I_CB, I_CP, I_N1, I_WG1, I_WU1, I_WD1, I_NM, I_WIN, I_CAW, I_CBW, I_CBB, I_LNG, I_LNB, I_PW, I_PS, I_WOUT, I_N2, I_WG2, I_WU2, I_WD2, I_NF };

__device__ __forceinline__ void tr_item(const float* W, int N, const float* gk, bf16_t* WT, int ldk, int drow0, int k0, int n0, LAS float* scr, int lane) {
    const int l16 = lane & 15, kq = lane >> 4;
    f32x4 v[16];
#pragma unroll
    for (int i = 0; i < 16; ++i) v[i] = *(const f32x4*)(W + (size_t)(k0 + 4 * i + kq) * N + n0 + 4 * l16);
    if (gk) {
#pragma unroll
        for (int i = 0; i < 16; ++i) v[i] = v[i] * gk[k0 + 4 * i + kq]; }
#pragma unroll
    for (int i = 0; i < 16; ++i) { LAS float* d = scr + (4 * i + kq) * 65 + 4 * l16; d[0] = v[i][0]; d[1] = v[i][1]; d[2] = v[i][2]; d[3] = v[i][3]; }
    LDS_WAIT(); asm volatile("" ::: "memory");
    const int c = lane & 7;
#pragma unroll
    for (int j = 0; j < 8; ++j) { const int n = (lane >> 3) + 8 * j; const LAS float* s = scr + (8 * c) * 65 + n;
        u32x4 o; o.x = cvt_pk_bf16(s[0 * 65], s[1 * 65]); o.y = cvt_pk_bf16(s[2 * 65], s[3 * 65]); o.z = cvt_pk_bf16(s[4 * 65], s[5 * 65]); o.w = cvt_pk_bf16(s[6 * 65], s[7 * 65]);
        *(u32x4*)(WT + (size_t)(drow0 + n) * ldk + k0 + 8 * c) = o; }
    LDS_WAIT(); asm volatile("" ::: "memory");
}

__device__ __forceinline__ void prologue(const Params& p, LAS unsigned char* lds, int G) {
    const int tid = threadIdx.x, lane = tid & 63, wave = __builtin_amdgcn_readfirstlane(tid >> 6);
    const int gw = blockIdx.x * 8 + wave, NGW = G * 8;
    float* ss = (float*)(p.ws + WS_SS);
    for (int i = blockIdx.x * 512 + tid; i < 6 * MT; i += G * 512) ss[MT + i] = 0.f;
    for (int b = blockIdx.x; b < 256; b += G) {
        const int layer = b >> 7, g = (b >> 5) & 3, n0 = (b & 31) * 64;
        LAS float* Bs = (LAS float*)lds;
        LAS float* As = (LAS float*)(lds + 32768);
        const float* wo = p.in[I_WOUT] + (size_t)layer * DM * DM + (size_t)(1536 + g * 128) * DM + n0;
        const float* ps = p.in[I_PS] + layer * DC + g * 128;
        const float* pw = p.in[I_PW] + (size_t)(layer * 4 + g) * 128 * 128;
#pragma unroll
        for (int i = 0; i < 4; ++i) { const int e = (i * 512 + tid) * 4, d = e >> 6, n = e & 63; const f32x4 v = *(const f32x4*)(wo + (size_t)d * DM + n) * ps[d]; *(LAS f32x4*)(Bs + d * 64 + n) = v; }
#pragma unroll
        for (int i = 0; i < 8; ++i) { const int e = (i * 512 + tid) * 4, c = e >> 7, d = e & 127; const f32x4 v = *(const f32x4*)(pw + e); LAS float* dp = As + c * 129 + d; dp[0] = v[0]; dp[1] = v[1]; dp[2] = v[2]; dp[3] = v[3]; }
        __syncthreads();
        float a[16];
#pragma unroll
        for (int i = 0; i < 16; ++i) a[i] = 0.f;
        for (int d = 0; d < 128; ++d) { const float bv = Bs[d * 64 + lane];
#pragma unroll
            for (int i = 0; i < 16; ++i) a[i] += As[(wave * 16 + i) * 129 + d] * bv; }
        bf16_t* dst = (bf16_t*)(p.ws + WS_W + (size_t)layer * W_LAYER + W_OUT) + (size_t)(n0 + lane) * DM + 1536 + g * 128 + wave * 16;
        u32x4 o0, o1;
        o0.x = cvt_pk_bf16(a[0], a[1]); o0.y = cvt_pk_bf16(a[2], a[3]); o0.z = cvt_pk_bf16(a[4], a[5]); o0.w = cvt_pk_bf16(a[6], a[7]);
        o1.x = cvt_pk_bf16(a[8], a[9]); o1.y = cvt_pk_bf16(a[10], a[11]); o1.z = cvt_pk_bf16(a[12], a[13]); o1.w = cvt_pk_bf16(a[14], a[15]);
        *(u32x4*)dst = o0; *(u32x4*)(dst + 8) = o1;
        __syncthreads();
    }
    LAS float* scr = (LAS float*)(lds + wave * 16640);
    constexpr int PER_LAYER = 2816 * 6 + 2176 + 768;
#pragma unroll 1
    for (int it = gw; it < 2 * PER_LAYER; it += NGW) {
        const int layer = it >= PER_LAYER ? 1 : 0; int r = it - layer * PER_LAYER;
        unsigned char* wl = p.ws + WS_W + (size_t)layer * W_LAYER;
        const float* W; const float* gk = nullptr; bf16_t* WT; int N, ldk, nnb, kind = 0;
        if (r < 2816) { W = p.in[I_WG1] + (size_t)layer * DM * DFF; gk = p.in[I_N1] + layer * DM; WT = (bf16_t*)(wl + W_GU1); N = DFF; ldk = DM; nnb = 88; kind = 1; }
        else if ((r -= 2816) < 2816) { W = p.in[I_WU1] + (size_t)layer * DM * DFF; gk = p.in[I_N1] + layer * DM; WT = (bf16_t*)(wl + W_GU1); N = DFF; ldk = DM; nnb = 88; kind = 2; }
        else if ((r -= 2816) < 2816) { W = p.in[I_WD1] + (size_t)layer * DFF * DM; WT = (bf16_t*)(wl + W_D1); N = DM; ldk = DFF; nnb = 32; }
        else if ((r -= 2816) < 2176) { W = p.in[I_WIN] + (size_t)layer * DM * DIN; gk = p.in[I_NM] + layer * DM; WT = (bf16_t*)(wl + W_IN); N = DIN; ldk = DM; nnb = 68; }
        else if ((r -= 2176) < 768) { W = p.in[I_WOUT] + (size_t)layer * DM * DM; WT = (bf16_t*)(wl + W_OUT); N = DM; ldk = DM; nnb = 32; }
        else if ((r -= 768) < 2816) { W = p.in[I_WG2] + (size_t)layer * DM * DFF; gk = p.in[I_N2] + layer * DM; WT = (bf16_t*)(wl + W_GU2); N = DFF; ldk = DM; nnb = 88; kind = 1; }
        else if ((r -= 2816) < 2816) { W = p.in[I_WU2] + (size_t)layer * DM * DFF; gk = p.in[I_N2] + layer * DM; WT = (bf16_t*)(wl + W_GU2); N = DFF; ldk = DM; nnb = 88; kind = 2; }
        else { r -= 2816; W = p.in[I_WD2] + (size_t)layer * DFF * DM; WT = (bf16_t*)(wl + W_D2); N = DM; ldk = DFF; nnb = 32; }
        const int kb = r / nnb, nb = r - kb * nnb, k0 = kb * 64, n0 = nb * 64;
        const int drow0 = kind ? ((n0 >> 7) * 256 + (kind - 1) * 128 + (n0 & 127)) : n0;
        tr_item(W, N, gk, WT, ldk, drow0, k0, n0, scr, lane);
    }
    bf16_t* hb = (bf16_t*)(p.ws + WS_HB);
    for (int m = gw; m < MT; m += NGW) {
        const float* xr = (m < MP) ? p.in[I_XP] + (size_t)m * DM : p.in[I_XS] + (size_t)(m - MP) * DM;
        float s = 0.f;
#pragma unroll
        for (int j = 0; j < 4; ++j) { const f32x4 v0 = *(const f32x4*)(xr + j * 512 + lane * 8), v1 = *(const f32x4*)(xr + j * 512 + lane * 8 + 4);
            s += (v0[0] * v0[0] + v0[1] * v0[1]) + (v0[2] * v0[2] + v0[3] * v0[3]) + (v1[0] * v1[0] + v1[1] * v1[1]) + (v1[2] * v1[2] + v1[3] * v1[3]);
            u32x4 w; w.x = cvt_pk_bf16(v0[0], v0[1]); w.y = cvt_pk_bf16(v0[2], v0[3]); w.z = cvt_pk_bf16(v1[0], v1[1]); w.w = cvt_pk_bf16(v1[2], v1[3]);
            *(u32x4*)(hb + (size_t)m * DM + j * 512 + lane * 8) = w; }
        s = wave_sum(s);
        if (lane == 0) ss[m] = s;
    }
}

__device__ __forceinline__ void ld8_bf16(const bf16_t* p, float (&v)[8]) {
    const u32x4 w = *(const u32x4*)p;
    v[0] = bf_lo(w.x); v[1] = bf_hi(w.x); v[2] = bf_lo(w.y); v[3] = bf_hi(w.y); v[4] = bf_lo(w.z); v[5] = bf_hi(w.z); v[6] = bf_lo(w.w); v[7] = bf_hi(w.w);
}
__device__ __forceinline__ void ld8_f32(const float* p, float (&v)[8]) {
    const f32x4 a = *(const f32x4*)p, b = *(const f32x4*)(p + 4);
    v[0] = a[0]; v[1] = a[1]; v[2] = a[2]; v[3] = a[3]; v[4] = b[0]; v[5] = b[1]; v[6] = b[2]; v[7] = b[3];
}
__device__ __forceinline__ void st8_f32(float* p, const float (&v)[8]) {
    *(f32x4*)p = (f32x4){v[0], v[1], v[2], v[3]}; *(f32x4*)(p + 4) = (f32x4){v[4], v[5], v[6], v[7]};
}
__device__ __forceinline__ void st8_bf16(bf16_t* p, const float (&v)[8]) {
    u32x4 w; w.x = cvt_pk_bf16(v[0], v[1]); w.y = cvt_pk_bf16(v[2], v[3]); w.z = cvt_pk_bf16(v[4], v[5]); w.w = cvt_pk_bf16(v[6], v[7]);
    *(u32x4*)p = w;
}

constexpr int TOK = 16, HALO = 30, VROWS = TOK + HALO, CH = 384;
__device__ __forceinline__ void mixer_mid(const Params& p, LAS unsigned char* lds, int G, int layer) {
    int tid = threadIdx.x; asm volatile("" : "+v"(tid));
    const int lane = tid & 63, wave = __builtin_amdgcn_readfirstlane(tid >> 6);
    LAS float* vt = (LAS float*)lds;
    LAS float* cb = (LAS float*)(lds + VROWS * CH * 4);
    const bf16_t* z = (const bf16_t*)(p.ws + WS_ACT);
    bf16_t* cat = (bf16_t*)(p.ws + WS_CAT);
    const float* caw = p.in[I_CAW] + layer * 3 * DA;
    const float* cbw = p.in[I_CBW] + layer * 31 * DB;
    const float* cbb = p.in[I_CBB] + layer * DB;
    const float* lng = p.in[I_LNG] + layer * DB;
    const float* lnb = p.in[I_LNB] + layer * DB;
    for (int ch = blockIdx.x; ch < MT / TOK; ch += G) {
        const bool samp = ch >= MP / TOK;
        int seq, l0, L;
        if (!samp) { seq = ch >> 9; l0 = (ch & 511) * TOK; L = 8192; } else { const int cs = ch - MP / TOK; seq = cs >> 2; l0 = (cs & 3) * TOK; L = 64; }
        const int row0 = ch * TOK;
        const bool lastc = (l0 + TOK == L), fast = (l0 >= 32);
        const float* hist_a = p.in[I_CA] + (size_t)(layer * 8 + seq) * 2 * DA;
        const float* hist_b = p.in[I_CB] + (size_t)(layer * 8 + seq) * 30 * DB;
        const float* hist_p = p.in[I_CP] + (size_t)(layer * 8 + seq) * 15 * DC;
        float* out_a = p.out + (samp ? OFF_A_S + (layer * 8 + seq) * 2 * DA : OFF_A_P + (layer * 2 + seq) * 2 * DA);
        float* out_b = p.out + (samp ? OFF_B_S + (layer * 8 + seq) * 30 * DB : OFF_B_P + (layer * 2 + seq) * 30 * DB);
        float* out_p = p.out + (samp ? OFF_P_S + (layer * 8 + seq) * 15 * DC : OFF_P_P + (layer * 2 + seq) * 15 * DC);
#pragma unroll 1
        for (int hc = 0; hc < 2; ++hc) {
            if (fast) {
                u32x4 ra[5], rg[5];
#pragma unroll
                for (int i = 0; i < 5; ++i) { const int it = tid + 512 * i; if (it < VROWS * (CH / 8)) { const int j = it / (CH / 8), cl = (it - j * (CH / 8)) * 8;
                    const bf16_t* zr = z + (size_t)(row0 - HALO + j) * DIN + hc * CH + cl; ra[i] = *(const u32x4*)(zr + 2304); rg[i] = *(const u32x4*)(zr + 3072); } }
#pragma unroll
                for (int i = 0; i < 5; ++i) { const int it = tid + 512 * i; if (it < VROWS * (CH / 8)) { const int j = it / (CH / 8), cl = (it - j * (CH / 8)) * 8, c8 = hc * CH + cl;
                    float v[8];
                    v[0] = bf_lo(ra[i].x) * sigmoidf_(bf_lo(rg[i].x)); v[1] = bf_hi(ra[i].x) * sigmoidf_(bf_hi(rg[i].x));
                    v[2] = bf_lo(ra[i].y) * sigmoidf_(bf_lo(rg[i].y)); v[3] = bf_hi(ra[i].y) * sigmoidf_(bf_hi(rg[i].y));
                    v[4] = bf_lo(ra[i].z) * sigmoidf_(bf_lo(rg[i].z)); v[5] = bf_hi(ra[i].z) * sigmoidf_(bf_hi(rg[i].z));
                    v[6] = bf_lo(ra[i].w) * sigmoidf_(bf_lo(rg[i].w)); v[7] = bf_hi(ra[i].w) * sigmoidf_(bf_hi(rg[i].w));
                    *(LAS f32x4*)(vt + j * CH + cl) = (f32x4){v[0], v[1], v[2], v[3]}; *(LAS f32x4*)(vt + j * CH + cl + 4) = (f32x4){v[4], v[5], v[6], v[7]};
                    if (lastc && j >= TOK) st8_f32(out_b + (size_t)(j - TOK) * DB + c8, v); } }
            } else
#pragma unroll 1
            for (int it = tid; it < VROWS * (CH / 8); it += 512) {
                const int j = it / (CH / 8), cl = (it - j * (CH / 8)) * 8, c8 = hc * CH + cl, l = l0 - HALO + j;
                float v[8];
                if (l >= 0) { const bf16_t* zr = z + (size_t)(row0 - HALO + j) * DIN; float a[8], g[8]; ld8_bf16(zr + 2304 + c8, a); ld8_bf16(zr + 3072 + c8, g);
#pragma unroll
                    for (int i = 0; i < 8; ++i) v[i] = a[i] * sigmoidf_(g[i]); }
                else if (samp) ld8_f32(hist_b + (size_t)(30 + l) * DB + c8, v);
                else {
#pragma unroll
                    for (int i = 0; i < 8; ++i) v[i] = 0.f; }
                *(LAS f32x4*)(vt + j * CH + cl) = (f32x4){v[0], v[1], v[2], v[3]}; *(LAS f32x4*)(vt + j * CH + cl + 4) = (f32x4){v[4], v[5], v[6], v[7]};
                if (lastc && j >= TOK) st8_f32(out_b + (size_t)(j - TOK) * DB + c8, v);
            }
            __syncthreads();
            if (tid < CH) {
                const int c = hc * CH + tid;
                float wv[31];
#pragma unroll
                for (int k = 0; k < 31; ++k) wv[k] = cbw[k * DB + c];
                const float bias = cbb[c];
                float o[TOK];
#pragma unroll
                for (int i = 0; i < TOK; ++i) o[i] = bias;
                const LAS float* vp = vt + tid;
#pragma unroll
                for (int jj = 0; jj < VROWS; ++jj) { const float x = vp[jj * CH];
#pragma unroll
                    for (int i = 0; i < TOK; ++i) { if (jj - i >= 0 && jj - i <= 30) o[i] += wv[(jj - i >= 0 && jj - i <= 30) ? jj - i : 0] * x; } }
#pragma unroll
                for (int i = 0; i < TOK; ++i) cb[i * DB + c] = o[i];
            }
            __syncthreads();
        }
#pragma unroll 1
        for (int tt = 0; tt < 2; ++tt) { const int tk = wave * 2 + tt; f32x2 x[6]; float s = 0.f;
#pragma unroll
            for (int i = 0; i < 6; ++i) { x[i] = *(const LAS f32x2*)(cb + tk * DB + 128 * i + 2 * lane); s += x[i].x + x[i].y; }
            const float mean = wave_sum(s) * (1.f / DB); float q2 = 0.f;
#pragma unroll
            for (int i = 0; i < 6; ++i) { x[i].x -= mean; x[i].y -= mean; q2 += x[i].x * x[i].x + x[i].y * x[i].y; }
            const float rstd = __builtin_amdgcn_rsqf(wave_sum(q2) * (1.f / DB) + EPS);
#pragma unroll
            for (int i = 0; i < 6; ++i) { const int c = 128 * i + 2 * lane; const f32x2 gg = *(const f32x2*)(lng + c), bb = *(const f32x2*)(lnb + c);
                const float y0 = siluf_(x[i].x * rstd * gg.x + bb.x), y1 = siluf_(x[i].y * rstd * gg.y + bb.y);
                *(unsigned*)(cat + (size_t)(row0 + tk) * DM + DA + c) = cvt_pk_bf16(y0, y1); } }
        if (fast) {
#pragma unroll
            for (int i = 0; i < 3; ++i) { const int it = tid + 512 * i, tk = it / 96, c8 = (it - tk * 96) * 8; const size_t row = row0 + tk; const bf16_t* zr = z + row * DIN + c8;
                u32x4 qa[3], qc[3], qb;
#pragma unroll
                for (int q = 0; q < 3; ++q) { qa[q] = *(const u32x4*)(zr - (2 - q) * DIN); qc[q] = *(const u32x4*)(zr - (2 - q) * DIN + 1536); }
                qb = *(const u32x4*)(zr + 768);
                float y[8], t[8], w[8];
#pragma unroll
                for (int e = 0; e < 8; ++e) y[e] = 0.f;
#pragma unroll
                for (int q = 0; q < 3; ++q) { ld8_f32(caw + q * DA + c8, w);
                    t[0] = bf_lo(qa[q].x) * bf_lo(qc[q].x); t[1] = bf_hi(qa[q].x) * bf_hi(qc[q].x); t[2] = bf_lo(qa[q].y) * bf_lo(qc[q].y); t[3] = bf_hi(qa[q].y) * bf_hi(qc[q].y);
                    t[4] = bf_lo(qa[q].z) * bf_lo(qc[q].z); t[5] = bf_hi(qa[q].z) * bf_hi(qc[q].z); t[6] = bf_lo(qa[q].w) * bf_lo(qc[q].w); t[7] = bf_hi(qa[q].w) * bf_hi(qc[q].w);
#pragma unroll
                    for (int e = 0; e < 8; ++e) y[e] += w[e] * t[e]; }
                y[0] *= bf_lo(qb.x); y[1] *= bf_hi(qb.x); y[2] *= bf_lo(qb.y); y[3] *= bf_hi(qb.y); y[4] *= bf_lo(qb.z); y[5] *= bf_hi(qb.z); y[6] *= bf_lo(qb.w); y[7] *= bf_hi(qb.w);
                st8_bf16(cat + row * DM + c8, y);
                if (lastc && tk >= TOK - 2) st8_f32(out_a + (size_t)(tk - (TOK - 2)) * DA + c8, t); }
#pragma unroll 1
            for (int i = 0; i < 2; ++i) { const int it = tid + 512 * i, tk = it >> 6, c8 = (it & 63) * 8; const size_t row = row0 + tk; const int w = 2 << (c8 >> 7);
                const bf16_t* zr = z + row * DIN + 3840 + c8;
                u32x4 r[16];
#pragma unroll
                for (int q = 0; q < 16; ++q) { r[q] = (u32x4){0u, 0u, 0u, 0u}; if (q < w) r[q] = *(const u32x4*)(zr - (size_t)q * DIN); }
                float sm[8], u0[8];
                u0[0] = bf_lo(r[0].x); u0[1] = bf_hi(r[0].x); u0[2] = bf_lo(r[0].y); u0[3] = bf_hi(r[0].y); u0[4] = bf_lo(r[0].z); u0[5] = bf_hi(r[0].z); u0[6] = bf_lo(r[0].w); u0[7] = bf_hi(r[0].w);
#pragma unroll
                for (int e = 0; e < 8; ++e) sm[e] = u0[e];
#pragma unroll
                for (int q = 1; q < 16; ++q) { sm[0] += bf_lo(r[q].x); sm[1] += bf_hi(r[q].x); sm[2] += bf_lo(r[q].y); sm[3] += bf_hi(r[q].y); sm[4] += bf_lo(r[q].z); sm[5] += bf_hi(r[q].z); sm[6] += bf_lo(r[q].w); sm[7] += bf_hi(r[q].w); }
                const float rc = 1.f / (float)w; float d[8];
#pragma unroll
                for (int e = 0; e < 8; ++e) d[e] = sm[e] * rc - u0[e];
                st8_bf16(cat + row * DM + 1536 + c8, d);
                if (lastc && tk >= 1) st8_f32(out_p + (size_t)(tk - 1) * DC + c8, u0); }
        } else {
#pragma unroll 1
        for (int it = tid; it < TOK * 96; it += 512) {
            const int tk = it / 96, c8 = (it - tk * 96) * 8, l = l0 + tk; const size_t row = row0 + tk;
            float t[8], y[8], b[8];
#pragma unroll
            for (int i = 0; i < 8; ++i) y[i] = 0.f;
#pragma unroll
            for (int q = 0; q < 3; ++q) { const int lq = l - 2 + q;
                if (lq >= 0) { const bf16_t* zr = z + (row - 2 + q) * DIN; float a[8], c[8]; ld8_bf16(zr + c8, a); ld8_bf16(zr + 1536 + c8, c);
#pragma unroll
                    for (int i = 0; i < 8; ++i) t[i] = a[i] * c[i]; }
                else if (samp) ld8_f32(hist_a + (size_t)(2 + lq) * DA + c8, t);
                else {
#pragma unroll
                    for (int i = 0; i < 8; ++i) t[i] = 0.f; }
                float w[8]; ld8_f32(caw + q * DA + c8, w);
#pragma unroll
                for (int i = 0; i < 8; ++i) y[i] += w[i] * t[i]; }
            ld8_bf16(z + row * DIN + 768 + c8, b);
#pragma unroll
            for (int i = 0; i < 8; ++i) y[i] *= b[i];
            st8_bf16(cat + row * DM + c8, y);
            if (lastc && tk >= TOK - 2) st8_f32(out_a + (size_t)(tk - (TOK - 2)) * DA + c8, t);
        }
#pragma unroll 1
        for (int it = tid; it < TOK * 64; it += 512) {
            const int tk = it >> 6, c8 = (it & 63) * 8, l = l0 + tk; const size_t row = row0 + tk;
            const int w = 2 << (c8 >> 7);
            float u0[8], s[8];
            ld8_bf16(z + row * DIN + 3840 + c8, u0);
#pragma unroll
            for (int i = 0; i < 8; ++i) s[i] = u0[i];
#pragma unroll 1
            for (int q = 1; q < w; ++q) { const int lq = l - q; float uq[8];
                if (lq >= 0) ld8_bf16(z + (row - q) * DIN + 3840 + c8, uq);
                else if (samp) ld8_f32(hist_p + (size_t)(15 + lq) * DC + c8, uq);
                else break;
#pragma unroll
                for (int i = 0; i < 8; ++i) s[i] += uq[i]; }
            const int cnt = samp ? w : (l + 1 < w ? l + 1 : w);
            const float rc = 1.f / (float)cnt; float d[8];
#pragma unroll
            for (int i = 0; i < 8; ++i) d[i] = s[i] * rc - u0[i];
            st8_bf16(cat + row * DM + 1536 + c8, d);
            if (lastc && tk >= 1) st8_f32(out_p + (size_t)(tk - 1) * DC + c8, u0);
        }
        }
        __syncthreads();
    }
}

__device__ __forceinline__ void sample_fixup(const Params& p, int G, float* ss_out) {
    int tid = threadIdx.x; asm volatile("" : "+v"(tid));
    const int lane = tid & 63, wave = __builtin_amdgcn_readfirstlane(tid >> 6);
    bf16_t* hb = (bf16_t*)(p.ws + WS_HB);
    const float* slab = (const float*)(p.ws + WS_SLAB);
    for (int m = blockIdx.x * 8 + wave; m < MS; m += G * 8) {
        bf16_t* hr = hb + (size_t)(MP + m) * DM; float s = 0.f;
#pragma unroll
        for (int j = 0; j < 4; ++j) { const int c = j * 512 + lane * 8; float b[8]; ld8_bf16(hr + c, b);
            f32x4 v0 = (f32x4){b[0], b[1], b[2], b[3]}, v1 = (f32x4){b[4], b[5], b[6], b[7]};
#pragma unroll
            for (int q = 0; q < 4; ++q) { const float* sr = slab + (size_t)q * (MS * DM) + (size_t)m * DM + c; v0 += *(const f32x4*)sr; v1 += *(const f32x4*)(sr + 4); }
            u32x4 w; w.x = cvt_pk_bf16(v0[0], v0[1]); w.y = cvt_pk_bf16(v0[2], v0[3]); w.z = cvt_pk_bf16(v1[0], v1[1]); w.w = cvt_pk_bf16(v1[2], v1[3]);
            *(u32x4*)(hr + c) = w;
            const float r[8] = {bf_lo(w.x), bf_hi(w.x), bf_lo(w.y), bf_hi(w.y), bf_lo(w.z), bf_hi(w.z), bf_lo(w.w), bf_hi(w.w)};
#pragma unroll
            for (int e = 0; e < 8; ++e) s += r[e] * r[e]; }
        s = wave_sum(s);
        if (lane == 0) ss_out[MP + m] = s;
    }
    const float* ssp = (const float*)(p.ws + WS_SSP);
    for (int r2 = blockIdx.x * 8 + wave; r2 < MP / 2; r2 += G * 8) {
        const int row = r2 * 2 + (lane >> 5);
        float v = ssp[(size_t)row * 32 + (lane & 31)];
#pragma unroll
        for (int o = 1; o < 32; o <<= 1) v += __shfl_xor(v, o);
        if ((lane & 31) == 0) ss_out[row] = v;
    }
}

__device__ __forceinline__ void final_norm(const Params& p, int G) {
    int tid = threadIdx.x; asm volatile("" : "+v"(tid));
    const int lane = tid & 63, wave = __builtin_amdgcn_readfirstlane(tid >> 6);
    const int gw = blockIdx.x * 8 + wave, NGW = G * 8;
    const float* ss = (const float*)(p.ws + WS_SS) + 6 * MT;
    const float* gn = p.in[I_NF];
    const bf16_t* hb = (const bf16_t*)(p.ws + WS_HB);
    for (int m = gw; m < MT; m += NGW) {
        const float rinv = __builtin_amdgcn_rsqf(ss[m] * (1.f / DM) + EPS);
        float* orow = p.out + (size_t)m * DM;
#pragma unroll
        for (int j = 0; j < 4; ++j) { const int c = j * 512 + lane * 8; float b[8], g[8]; ld8_bf16(hb + (size_t)m * DM + c, b); ld8_f32(gn + c, g);
#pragma unroll
            for (int e = 0; e < 8; ++e) b[e] = b[e] * rinv * g[e];
            st8_f32(orow + c, b); }
    }
}

#define XB_TMO      128
#define XB_XCNT(j)  (256  + 64 * (j))
#define XB_XSUB(j)  (1280 + 64 * (j))
#define XB_XGEN(j)  (2304 + 64 * (j))
#define XB_TOP      3328
#define XB_TOPGEN   3392
#define XCD_BAR_WORDS 3456
#define XB_SPIN_CAP (1u << 22)
__device__ __forceinline__ unsigned xb_ld(unsigned* p)              { return __hip_atomic_load(p, __ATOMIC_RELAXED, __HIP_MEMORY_SCOPE_AGENT); }
__device__ __forceinline__ unsigned xb_add(unsigned* p, unsigned v) { return __hip_atomic_fetch_add(p, v, __ATOMIC_RELAXED, __HIP_MEMORY_SCOPE_AGENT); }
__device__ __forceinline__ unsigned xb_xcc_id() { return (unsigned)__builtin_amdgcn_s_getreg((3 << 11) | 20) & 0xFu; }
#define XB_SPIN(cond, bar) do { unsigned _sp = 0; while (cond) { __builtin_amdgcn_s_sleep(1); \
    if ((++_sp & 255u) == 0u) { if (xb_ld(&(bar)[XB_TMO])) break; if (_sp > XB_SPIN_CAP) { atomicAdd(&(bar)[XB_TMO], 1u); break; } } } } while (0)
struct XcdBarrier { unsigned* bar; unsigned x; volatile LAS unsigned* st; };
__device__ __forceinline__ XcdBarrier xcd_barrier_post(unsigned* bar, volatile LAS unsigned* st) {
    XcdBarrier b; b.bar = bar; b.x = xb_xcc_id(); b.st = st;
    if (threadIdx.x == 0) (void)xb_add(&bar[XB_XCNT(b.x)], 1u);
    return b;
}
__device__ __forceinline__ void xcd_barrier_complete(unsigned* bar, unsigned x, unsigned& nloc, unsigned& nx) {
    const unsigned G = gridDim.x * gridDim.y * gridDim.z;
    unsigned sum, cnt, mine, sp = 0u;
    for (;;) {
        sum = 0u; cnt = 0u; mine = 0u;
#pragma unroll
        for (unsigned j = 0; j < 16; ++j) { const unsigned c = xb_ld(&bar[XB_XCNT(j)]); sum += c; cnt += (c > 0u) ? 1u : 0u; mine = (j == x) ? c : mine; }
        if (sum == G) break;
        __builtin_amdgcn_s_sleep(1);
        if ((++sp & 255u) == 0u) { if (xb_ld(&bar[XB_TMO])) break; if (sp > XB_SPIN_CAP) { atomicAdd(&bar[XB_TMO], 1u); break; } }
    }
    nloc = mine > 0u ? mine : 1u; nx = cnt > 0u ? cnt : 1u;
}
__device__ __forceinline__ void xcd_barrier(const XcdBarrier& b) {
    asm volatile("s_waitcnt vmcnt(0)" ::: "memory");
    __syncthreads();
    if (threadIdx.x == 0) {
        unsigned* bar = b.bar;
        __builtin_amdgcn_s_waitcnt(0);
        unsigned nloc = b.st[0], nx = b.st[1];
        if (nloc == 0u) { xcd_barrier_complete(bar, b.x, nloc, nx); b.st[0] = nloc; b.st[1] = nx; }
        const unsigned old = xb_add(&bar[XB_XSUB(b.x)], 1u);
        const unsigned gen = old / nloc;
        if (old + 1u == (gen + 1u) * nloc) {
            __builtin_amdgcn_fence(__ATOMIC_RELEASE, "agent");
            asm volatile("s_waitcnt vmcnt(0)" ::: "memory");
            const unsigned og = xb_add(&bar[XB_TOP], 1u);
            const unsigned tg = og / nx;
            if (og + 1u == (tg + 1u) * nx) xb_add(&bar[XB_TOPGEN], 1u);
            else XB_SPIN(xb_ld(&bar[XB_TOPGEN]) == tg, bar);
            __builtin_amdgcn_fence(__ATOMIC_ACQUIRE, "agent");
            xb_add(&bar[XB_XGEN(b.x)], 1u);
            asm volatile("s_waitcnt vmcnt(0)" ::: "memory");
        } else {
            XB_SPIN(xb_ld(&bar[XB_XGEN(b.x)]) == gen, bar);
            __builtin_amdgcn_fence(__ATOMIC_ACQUIRE, "agent");
            asm volatile("s_waitcnt vmcnt(0)" ::: "memory");
        }
    }
    __syncthreads();
}

__global__ void __launch_bounds__(512, 2) fwd_megakernel(Params p) {
    extern __shared__ __attribute__((aligned(16))) unsigned char lds_raw[];
    LAS unsigned char* lds = (LAS unsigned char*)lds_raw;
    cg::grid_group grid = cg::this_grid();
    const int G = gridDim.x;
    float* ssb = (float*)(p.ws + WS_SS);
    bf16_t* hb = (bf16_t*)(p.ws + WS_HB);
    bf16_t* act = (bf16_t*)(p.ws + WS_ACT);
    bf16_t* cat = (bf16_t*)(p.ws + WS_CAT);

    volatile LAS unsigned* misc = (volatile LAS unsigned*)(lds + MISC_OFF);
    if (threadIdx.x < 2) misc[threadIdx.x] = 0u;
    __syncthreads();
    const XcdBarrier xbar = xcd_barrier_post((unsigned*)(p.ws + WS_BAR), misc);
#pragma unroll 1
    for (int rep = 0; rep < REP_PRO; ++rep)
    prologue(p, lds, G);
    grid.sync();
#define GRID_BAR() xcd_barrier(xbar)

    for (int st = 0; st < 6; ++st) {
        const int layer = st / 3, sub = st - layer * 3;
        unsigned char* wl = p.ws + WS_W + (size_t)layer * W_LAYER;
        if (sub != 1) {
            const int f = sub >> 1;
            const float* ss_in = ssb + (size_t)(layer * 3 + (f ? 2 : 0)) * MT;
            float* ss_out = ssb + (size_t)(layer * 3 + (f ? 3 : 1)) * MT;
            const bf16_t* wgu = (const bf16_t*)(wl + (f ? W_GU2 : W_GU1));
            const bf16_t* wd = (const bf16_t*)(wl + (f ? W_D2 : W_D1));
            { pg8::Gemm g{hb, wgu, MT, 2 * DFF, DM, DM / 64}; pg8::StaticOrder S; S.init(MT, 2 * DFF, G, (int)blockIdx.x);
              pg8::EpiSwiGLU E{act, ss_in};
#pragma unroll 1
              for (int rep = 0; rep < REP_GU; ++rep)
              pg8::gemm_phase<pg8::EpiSwiGLU, pg8::StaticOrder, true, true>(lds, g, S, E); }
            GRID_BAR();
            { const bool first = (st == 0);
              { pg8::Gemm g{act, wd, MP, DM, DFF, DFF / 64}; pg8::StaticOrder S; S.init(MP, DM, G, (int)blockIdx.x);
                pg8::EpiResid E{hb, (float*)(p.ws + WS_SSP), 0.5f};
                pg8::gemm_phase<pg8::EpiResid, pg8::StaticOrder, true, true>(lds, g, S, E); }
              { pg8::Gemm g{act, wd, MT, DM, DFF, DFF / 256}; pg8::SplitOrder S{(int)blockIdx.x, (DFF / 4) * 2};
                pg8::EpiSlab E{(float*)(p.ws + WS_SLAB), 0.5f, (DFF / 4) * 2};
                pg8::gemm_phase<pg8::EpiSlab, pg8::SplitOrder, true, true>(lds, g, S, E); } }
            GRID_BAR();
            sample_fixup(p, G, ss_out);
            GRID_BAR();
        } else {
            const float* ss_in = ssb + (size_t)(layer * 3 + 1) * MT;
            float* ss_out = ssb + (size_t)(layer * 3 + 2) * MT;
            { pg8::Gemm g{hb, (const bf16_t*)(wl + W_IN), MT, DIN, DM, DM / 64}; pg8::StaticOrder S; S.init(MT, DIN, G, (int)blockIdx.x);
              pg8::EpiScaleBf16 E{act, DIN, ss_in};
#pragma unroll 1
              for (int rep = 0; rep < REP_WIN; ++rep)
              pg8::gemm_phase<pg8::EpiScaleBf16, pg8::StaticOrder, true, true>(lds, g, S, E); }
            GRID_BAR();
#pragma unroll 1
            for (int rep = 0; rep < REP_MIX; ++rep)
            mixer_mid(p, lds, G, layer);
            GRID_BAR();
            { pg8::Gemm g{cat, (const bf16_t*)(wl + W_OUT), MP, DM, DM, DM / 64}; pg8::StaticOrder S; S.init(MP, DM, G, (int)blockIdx.x);
              pg8::EpiResid E{hb, (float*)(p.ws + WS_SSP), 1.0f};
              pg8::gemm_phase<pg8::EpiResid, pg8::StaticOrder, true, true>(lds, g, S, E); }
            { pg8::Gemm g{cat, (const bf16_t*)(wl + W_OUT), MT, DM, DM, DM / 256}; pg8::SplitOrder S{(int)blockIdx.x, (DM / 4) * 2};
              pg8::EpiSlab E{(float*)(p.ws + WS_SLAB), 1.0f, (DM / 4) * 2};
              pg8::gemm_phase<pg8::EpiSlab, pg8::SplitOrder, true, true>(lds, g, S, E); }
            GRID_BAR();
            sample_fixup(p, G, ss_out);
            GRID_BAR();
        }
    }
    final_norm(p, G);
}

extern "C" void kernel_launch(void* const* d_in, const int* in_sizes, int n_in, void* d_out, int out_size, void* d_ws, size_t ws_size, hipStream_t stream) {
    static int grid = 0;
    if (grid == 0) {
        if (n_in != 24 || ws_size < WS_END) { fprintf(stderr, "kernel_launch: need 24 inputs and >= %zu bytes of workspace (got %d, %zu)\n", (size_t)WS_END, n_in, ws_size); grid = -1; return; }
        int dev = 0, cus = 0, per_cu = 0;
        hipGetDevice(&dev);
        hipDeviceGetAttribute(&cus, hipDeviceAttributeMultiprocessorCount, dev);
        hipFuncSetAttribute((const void*)fwd_megakernel, hipFuncAttributeMaxDynamicSharedMemorySize, LDS_BYTES);
        hipOccupancyMaxActiveBlocksPerMultiprocessor(&per_cu, (const void*)fwd_megakernel, 512, LDS_BYTES);
        if (per_cu < 1) { fprintf(stderr, "kernel_launch: occupancy query returned %d\n", per_cu); per_cu = 1; }
        grid = cus * per_cu;
    }
    if (grid < 0) return;
    if (hipMemsetAsync((char*)d_ws + WS_BAR, 0, WS_BAR_BYTES, stream) != hipSuccess) { fprintf(stderr, "kernel_launch: memset failed\n"); return; }
    Params p{};
    for (int i = 0; i < 24; ++i) p.in[i] = (const float*)d_in[i];
    p.out = (float*)d_out; p.ws = (unsigned char*)d_ws;
    void* args[] = {&p};
    hipError_t e = hipLaunchCooperativeKernel((void*)fwd_megakernel, dim3(grid), dim3(512), args, LDS_BYTES, stream);
    if (e != hipSuccess) fprintf(stderr, "cooperative launch failed: %s (grid %d)\n", hipGetErrorString(e), grid);
}
```

```cpp
#include <hip/hip_runtime.h>
#include <hip/hip_cooperative_groups.h>
#include <cstdio>
#include <cstdint>
namespace cg = cooperative_groups;

#define LAS __attribute__((address_space(3)))
typedef unsigned short bf16_t;
typedef short bf16x8 __attribute__((ext_vector_type(8)));
typedef float f32x4 __attribute__((ext_vector_type(4)));
typedef float f32x2 __attribute__((ext_vector_type(2)));
typedef unsigned u32x4 __attribute__((ext_vector_type(4)));
typedef unsigned u32x2 __attribute__((ext_vector_type(2)));

constexpr int DM = 2048, DFF = 5632, DIN = 4352, DA = 768, DB = 768, DC = 512;
constexpr int MP = 16384, MS = 512, MT = MP + MS;
constexpr float EPS = 1e-6f;
constexpr size_t MiB = 1u << 20;
constexpr size_t WS_SS = 0, WS_W = 1 * MiB, W_LAYER = 157 * MiB;
constexpr size_t W_GU1 = 0, W_D1 = 44 * MiB, W_IN = 66 * MiB, W_OUT = 83 * MiB, W_GU2 = 91 * MiB, W_D2 = 135 * MiB;
constexpr size_t WS_HB = 315 * MiB, WS_ACT = 381 * MiB, WS_CAT = 563 * MiB, WS_SLAB = 629 * MiB, WS_SSP = 645 * MiB, WS_END = 648 * MiB;
constexpr int OFF_A_P = 34603008, OFF_B_P = OFF_A_P + 6144, OFF_P_P = OFF_B_P + 92160, OFF_A_S = OFF_P_P + 30720, OFF_B_S = OFF_A_S + 24576, OFF_P_S = OFF_B_S + 368640;
#ifndef REP_GU
#define REP_GU 1
#endif
#ifndef REP_WIN
#define REP_WIN 1
#endif
#ifndef REP_MIX
#define REP_MIX 1
#endif
#ifndef REP_PRO
#define REP_PRO 1
#endif
constexpr int LDS_BYTES = 147456, MISC_OFF = 139264;
constexpr size_t WS_BAR = 512 * 1024, WS_BAR_BYTES = 16384;

#define LDS_WAIT() asm volatile("s_waitcnt lgkmcnt(0)" ::: "memory")

__device__ __forceinline__ unsigned cvt_pk_bf16(float lo, float hi) { unsigned r; asm volatile("v_cvt_pk_bf16_f32 %0, %1, %2" : "=v"(r) : "v"(lo), "v"(hi)); return r; }
__device__ __forceinline__ float bf_lo(unsigned w) { return __uint_as_float(w << 16); }
__device__ __forceinline__ float bf_hi(unsigned w) { return __uint_as_float(w & 0xffff0000u); }
__device__ __forceinline__ float sigmoidf_(float x) { return __builtin_amdgcn_rcpf(1.f + __builtin_amdgcn_exp2f(-1.44269504f * x)); }
__device__ __forceinline__ float siluf_(float x) { return x * sigmoidf_(x); }
__device__ __forceinline__ float wave_sum(float v) {
#pragma unroll
    for (int o = 1; o < 64; o <<= 1) v += __shfl_xor(v, o);
    return v;
}

namespace pg8 {
constexpr int BM = 256, BK = 64, HALF = 128, HTB = HALF * BK * 2, STAGE_BYTES = 8 * HTB, NXCD = 8, WGM = 8;
__host__ __device__ __forceinline__ int lds_byte(int r, int c) { const int st = (r >> 4) * 2 + (c >> 5), rr = r & 15, cc = c & 31, ob = rr * 64 + cc * 2; return st * 1024 + (ob ^ (((ob >> 9) & 1) << 5)); }
__host__ __device__ __forceinline__ void stage_rc(int b, int& R, int& C) { const int st = b / 1024, sb = b % 1024, swz = sb ^ (((sb >> 9) & 1) << 5); R = (st >> 1) * 16 + swz / 64; C = (st & 1) * 32 + (swz % 64) / 2; }
__host__ __device__ __forceinline__ int perm32(int rho) { const int n = rho >> 4, i = rho & 15; return 8 * (i >> 2) + 4 * n + (i & 3); }

struct Unit { int pm, pn, kb; };
struct Gemm { const bf16_t* A; const bf16_t* Bt; int M, N, K, nt; };

struct StaticOrder {
    int nM, nN, nwg, G, c;
    __device__ void init(int M, int N, int G_, int c_) { nM = M / BM; nN = N / BM; nwg = nM * nN; G = G_; c = c_; }
    __device__ __forceinline__ bool next(int i, Unit& u) const {
        const long L = (long)i * G + c; if (L >= nwg) return false;
        int wgid = (int)L; { const int q = nwg / NXCD, r = nwg % NXCD, xcd = wgid % NXCD, off = wgid / NXCD; wgid = (xcd < r ? xcd * (q + 1) : r * (q + 1) + (xcd - r) * q) + off; }
        const int nig = WGM * nN, gid = wgid / nig, fm = gid * WGM, gsz = (nM - fm) < WGM ? (nM - fm) : WGM;
        u.pm = fm + ((wgid % nig) % gsz); u.pn = (wgid % nig) / gsz; u.kb = 0; return true;
    }
    __device__ __forceinline__ void a_ready(const Unit&) const {}
    __device__ __forceinline__ void done(const Unit&) const {}
};

struct EpiSwiGLU {
    static constexpr bool PERM = true, AFTER_DRAIN = false, PREF = true;
    bf16_t* O; const float* ss;
    __device__ __forceinline__ void prefetch(const Unit& u, int wr, int fr, float (&sv)[8]) const {
        const int row0 = u.pm * BM + wr * 64 + fr;
#pragma unroll
        for (int ai = 0; ai < 2; ++ai)
#pragma unroll
            for (int m = 0; m < 4; ++m) sv[ai * 4 + m] = ss[row0 + ai * HALF + m * 16];
    }
    __device__ __forceinline__ void operator()(const f32x4 (&acc)[2][2][4][2], const Unit& u, int wr, int wc, int fr, int fq, const float (&sv)[8]) const {
        const int row0 = u.pm * BM + wr * 64 + fr, col0 = u.pn * HALF + wc * 32 + 8 * fq;
#pragma unroll
        for (int ai = 0; ai < 2; ++ai)
#pragma unroll
            for (int m = 0; m < 4; ++m) {
                const int row = row0 + ai * HALF + m * 16;
                const float rinv = __builtin_amdgcn_rsqf(sv[ai * 4 + m] * (1.f / DM) + EPS), rneg = rinv * -1.44269504f, r2 = rinv * rinv;
                const f32x4 g0 = acc[ai][0][m][0], g1 = acc[ai][0][m][1], u0 = acc[ai][1][m][0], u1 = acc[ai][1][m][1];
                f32x4 e0, e1;
#pragma unroll
                for (int j = 0; j < 4; ++j) { e0[j] = __builtin_amdgcn_rcpf(1.f + __builtin_amdgcn_exp2f(g0[j] * rneg)); e1[j] = __builtin_amdgcn_rcpf(1.f + __builtin_amdgcn_exp2f(g1[j] * rneg)); }
                const f32x4 a0 = (g0 * u0) * (e0 * r2), a1 = (g1 * u1) * (e1 * r2);
                u32x4 w;
                w.x = cvt_pk_bf16(a0[0], a0[1]); w.y = cvt_pk_bf16(a0[2], a0[3]); w.z = cvt_pk_bf16(a1[0], a1[1]); w.w = cvt_pk_bf16(a1[2], a1[3]);
                *(u32x4*)(O + (size_t)row * DFF + col0) = w;
            }
    }
};
struct EpiScaleBf16 {
    static constexpr bool PERM = true, AFTER_DRAIN = false, PREF = true;
    bf16_t* O; int ldc; const float* ss;
    __device__ __forceinline__ void prefetch(const Unit& u, int wr, int fr, float (&sv)[8]) const {
        const int row0 = u.pm * BM + wr * 64 + fr;
#pragma unroll
        for (int ai = 0; ai < 2; ++ai)
#pragma unroll
            for (int m = 0; m < 4; ++m) sv[ai * 4 + m] = ss[row0 + ai * HALF + m * 16];
    }
    __device__ __forceinline__ void operator()(const f32x4 (&acc)[2][2][4][2], const Unit& u, int wr, int wc, int fr, int fq, const float (&sv)[8]) const {
        const int row0 = u.pm * BM + wr * 64 + fr, col0 = u.pn * BM + wc * 32 + 8 * fq;
#pragma unroll
        for (int ai = 0; ai < 2; ++ai)
#pragma unroll
            for (int m = 0; m < 4; ++m) {
                const int row = row0 + ai * HALF + m * 16;
                const float rinv = __builtin_amdgcn_rsqf(sv[ai * 4 + m] * (1.f / DM) + EPS);
                bf16_t* rowp = O + (size_t)row * ldc + col0;
#pragma unroll
                for (int bj = 0; bj < 2; ++bj) { const f32x4 v0 = acc[ai][bj][m][0] * rinv, v1 = acc[ai][bj][m][1] * rinv;
                    u32x4 w; w.x = cvt_pk_bf16(v0[0], v0[1]); w.y = cvt_pk_bf16(v0[2], v0[3]); w.z = cvt_pk_bf16(v1[0], v1[1]); w.w = cvt_pk_bf16(v1[2], v1[3]);
                    *(u32x4*)(rowp + bj * HALF) = w; }
            }
    }
};
struct EpiResid {
    static constexpr bool PERM = true, AFTER_DRAIN = false, PREF = false;
    bf16_t* hb; float* ssn; float scale;
    __device__ __forceinline__ void prefetch(const Unit&, int, int, float (&)[8]) const {}
    __device__ __forceinline__ void operator()(const f32x4 (&acc)[2][2][4][2], const Unit& u, int wr, int wc, int fr, int fq, const float (&)[8]) const {
        const int row0 = u.pm * BM + wr * 64 + fr, col0 = u.pn * BM + wc * 32 + 8 * fq;
        bf16_t* bp0 = hb + (size_t)row0 * DM + col0;
        u32x4 b[2][4][2];
#pragma unroll
        for (int ai = 0; ai < 2; ++ai)
#pragma unroll
            for (int m = 0; m < 4; ++m)
#pragma unroll
                for (int bj = 0; bj < 2; ++bj) b[ai][m][bj] = *(const u32x4*)(bp0 + (size_t)(ai * HALF + m * 16) * DM + bj * HALF);
#pragma unroll
        for (int ai = 0; ai < 2; ++ai) {
#pragma unroll
            for (int m = 0; m < 4; ++m) {
                const int row = row0 + ai * HALF + m * 16;
                float s = 0.f;
#pragma unroll
                for (int bj = 0; bj < 2; ++bj) { const u32x4 bb = b[ai][m][bj];
                    const f32x4 b0 = (f32x4){bf_lo(bb.x), bf_hi(bb.x), bf_lo(bb.y), bf_hi(bb.y)}, b1 = (f32x4){bf_lo(bb.z), bf_hi(bb.z), bf_lo(bb.w), bf_hi(bb.w)};
                    const f32x4 h0 = b0 + acc[ai][bj][m][0] * scale, h1 = b1 + acc[ai][bj][m][1] * scale;
                    u32x4 w; w.x = cvt_pk_bf16(h0[0], h0[1]); w.y = cvt_pk_bf16(h0[2], h0[3]); w.z = cvt_pk_bf16(h1[0], h1[1]); w.w = cvt_pk_bf16(h1[2], h1[3]);
                    *(u32x4*)(bp0 + (size_t)(ai * HALF + m * 16) * DM + bj * HALF) = w;
                    const f32x4 r0 = (f32x4){bf_lo(w.x), bf_hi(w.x), bf_lo(w.y), bf_hi(w.y)}, r1 = (f32x4){bf_lo(w.z), bf_hi(w.z), bf_lo(w.w), bf_hi(w.w)};
                    s += (r0[0] * r0[0] + r0[1] * r0[1]) + (r0[2] * r0[2] + r0[3] * r0[3]) + (r1[0] * r1[0] + r1[1] * r1[1]) + (r1[2] * r1[2] + r1[3] * r1[3]); }
                s += __shfl_xor(s, 16); s += __shfl_xor(s, 32);
                if (fq == 0) ssn[(size_t)row * 32 + u.pn * 4 + wc] = s;
            }
        }
    }
};

struct SplitOrder {
    int c, kslice;
    __device__ __forceinline__ bool next(int i, Unit& u) const {
        if (i != 0 || c >= 64) return false;
        u.pm = 64 + (c & 1); u.pn = (c >> 1) & 7; u.kb = (c >> 4) * kslice; return true;
    }
    __device__ __forceinline__ void a_ready(const Unit&) const {}
    __device__ __forceinline__ void done(const Unit&) const {}
};
struct EpiSlab {
    static constexpr bool PERM = true, AFTER_DRAIN = false;
    static constexpr bool PREF = false;
    float* slab; float scale; int kslice;
    __device__ __forceinline__ void prefetch(const Unit&, int, int, float (&)[8]) const {}
    __device__ __forceinline__ void operator()(const f32x4 (&acc)[2][2][4][2], const Unit& u, int wr, int wc, int fr, int fq, const float (&)[8]) const {
        const int row0 = (u.pm - 64) * BM + wr * 64 + fr, col0 = u.pn * BM + wc * 32 + 8 * fq;
        float* sp = slab + (size_t)(u.kb / kslice) * (MS * DM);
#pragma unroll
        for (int ai = 0; ai < 2; ++ai)
#pragma unroll
            for (int m = 0; m < 4; ++m) { float* rp = sp + (size_t)(row0 + ai * HALF + m * 16) * DM + col0;
#pragma unroll
                for (int bj = 0; bj < 2; ++bj)
#pragma unroll
                    for (int n = 0; n < 2; ++n) *(f32x4*)(rp + bj * HALF + n * 4) = acc[ai][bj][m][n] * scale; }
    }
};

template <class Epi, class Sched, bool ALIGN_EPI = false, bool SP2 = false>
__device__ __forceinline__ void gemm_phase(LAS unsigned char* lds, const Gemm g, const Sched& S, const Epi& E) {
    int tid = threadIdx.x; asm volatile("" : "+v"(tid));
    const int wid = __builtin_amdgcn_readfirstlane(tid >> 6), lane = tid & 63, wr = wid >> 2, wc = wid & 3, fr = lane & 15, fq = lane >> 4;
    const int K = g.K, nt = g.nt;
    unsigned voffA[2], voffB[2];
#pragma unroll
    for (int i = 0; i < 2; ++i) { int R, C; stage_rc(tid * 16 + i * 8192, R, C); const int Rb = Epi::PERM ? ((R & ~31) + perm32(R & 31)) : R;
        voffA[i] = (unsigned)(R * K + C) * 2u; voffB[i] = (unsigned)(Rb * K + C) * 2u; }
    const size_t kstep = (size_t)(BK * 2);
    const size_t hstep = (size_t)HALF * K * 2;
    const size_t tstep = 2 * hstep;
    const unsigned ldsw = (unsigned)wid * 1024u;
    const int aoff = lds_byte(wr * 64 + fr, fq * 8), boff = lds_byte(wc * 32 + fr, fq * 8);
#define PG8_SA(b, h) (((b) * 2 + (h)) * HTB)
#define PG8_SB(b, h) ((4 + (b) * 2 + (h)) * HTB)
#define PG8_STAGE(bufoff, gbase, voff) do { _Pragma("unroll") for (int _i = 0; _i < 2; ++_i) \
        __builtin_amdgcn_global_load_lds((const unsigned*)((const char*)(gbase) + (voff)[_i]), (LAS unsigned*)(lds + (bufoff) + ldsw + _i * 8192), 16, 0, 0); } while (0)
#define PG8_LDA(dst, b, h) do { _Pragma("unroll") for (int m = 0; m < 4; ++m) _Pragma("unroll") for (int k = 0; k < 2; ++k) dst[m][k] = *(const LAS bf16x8*)(lds + PG8_SA(b, h) + aoff + m * 2048 + k * 1024); } while (0)
#define PG8_LDB(dst, b, h) do { _Pragma("unroll") for (int n = 0; n < 2; ++n) _Pragma("unroll") for (int k = 0; k < 2; ++k) dst[n][k] = *(const LAS bf16x8*)(lds + PG8_SB(b, h) + boff + n * 2048 + k * 1024); } while (0)
#define PG8_MMA(ai, bj, At, Bt) do { __builtin_amdgcn_s_setprio(1); _Pragma("unroll") for (int m = 0; m < 4; ++m) _Pragma("unroll") for (int n = 0; n < 2; ++n) _Pragma("unroll") for (int k = 0; k < 2; ++k) \
        acc[ai][bj][m][n] = __builtin_amdgcn_mfma_f32_16x16x32_bf16(Bt[n][k], At[m][k], acc[ai][bj][m][n], 0, 0, 0); __builtin_amdgcn_s_setprio(0); } while (0)
#define PG8_WAIT_V(n) asm volatile("s_waitcnt vmcnt(" #n ")" ::: "memory")
#define PG8_WAIT_L(n) asm volatile("s_waitcnt lgkmcnt(" #n ")" ::: "memory")
#define PG8_BAR __builtin_amdgcn_s_barrier()
#define PG8_SCHED __builtin_amdgcn_sched_barrier(0)
    Unit cur, nxt; int ui = 0;
    if (!S.next(0, cur)) return;
    f32x4 acc[2][2][4][2];
#pragma unroll
    for (int a = 0; a < 2; ++a)
#pragma unroll
        for (int b = 0; b < 2; ++b)
#pragma unroll
            for (int m = 0; m < 4; ++m)
#pragma unroll
                for (int n = 0; n < 2; ++n) acc[a][b][m][n] = (f32x4){0.f, 0.f, 0.f, 0.f};
    bf16x8 At[4][2], B0[2][2], B1[2][2];
    const char* cA = (const char*)g.A + (size_t)cur.pm * tstep + cur.kb; const char* cB = (const char*)g.Bt + (size_t)cur.pn * tstep + cur.kb;
    S.a_ready(cur);
    float sv[8];
#define PG8_SS_DMA(u, buf) do { if constexpr (Epi::PREF) { if (wid == 0) __builtin_amdgcn_global_load_lds((const unsigned*)(E.ss + (size_t)(u).pm * BM + 4 * lane), (LAS unsigned*)(lds + STAGE_BYTES + (buf) * 1024), 16, 0, 0); } } while (0)
    PG8_SS_DMA(cur, 0);
    if constexpr (SP2) {
        PG8_STAGE(PG8_SB(0, 0), cB, voffB); PG8_STAGE(PG8_SB(0, 1), cB + hstep, voffB); PG8_STAGE(PG8_SA(0, 0), cA, voffA); PG8_STAGE(PG8_SA(0, 1), cA + hstep, voffA);
        if (wr == 1) PG8_BAR;
        PG8_WAIT_V(2); PG8_BAR;
        PG8_STAGE(PG8_SB(1, 0), cB + kstep, voffB); PG8_STAGE(PG8_SA(1, 0), cA + kstep, voffA); PG8_STAGE(PG8_SB(1, 1), cB + hstep + kstep, voffB);
        PG8_WAIT_V(6); PG8_BAR;
    } else {
        PG8_STAGE(PG8_SB(0, 0), cB, voffB); PG8_STAGE(PG8_SA(0, 0), cA, voffA); PG8_STAGE(PG8_SB(0, 1), cB + hstep, voffB); PG8_STAGE(PG8_SA(0, 1), cA + hstep, voffA);
        if (wr == 1) PG8_BAR;
        PG8_WAIT_V(4); PG8_BAR;
        PG8_STAGE(PG8_SB(1, 0), cB + kstep, voffB); PG8_STAGE(PG8_SA(1, 0), cA + kstep, voffA); PG8_STAGE(PG8_SB(1, 1), cB + hstep + kstep, voffB);
        PG8_WAIT_V(6); PG8_BAR;
    }
    for (;;) {
        const bool has_next = S.next(ui + 1, nxt);
        const char* nA = has_next ? (const char*)g.A + (size_t)nxt.pm * tstep + nxt.kb : cA; const char* nB = has_next ? (const char*)g.Bt + (size_t)nxt.pn * tstep + nxt.kb : cB;
        for (int t = 0; t < nt; t += 2) {
            const bool last = (t == nt - 2);
            const char* a1 = cA + (size_t)(t + 1) * kstep;
            const char* a2 = last ? nA : cA + (size_t)(t + 2) * kstep; const char* b2 = last ? nB : cB + (size_t)(t + 2) * kstep;
            const char* a3 = a2 + kstep; const char* b3 = b2 + kstep;
            if (last && has_next) S.a_ready(nxt);
            if constexpr (SP2) {
            PG8_LDB(B0, 0, 0); PG8_LDB(B1, 0, 1); PG8_SCHED; PG8_LDA(At, 0, 0); PG8_STAGE(PG8_SA(1, 1), a1 + hstep, voffA);
            PG8_WAIT_V(8); PG8_WAIT_L(0); PG8_BAR; PG8_MMA(0, 0, At, B0); PG8_MMA(0, 1, At, B1); PG8_BAR; PG8_SCHED;
            PG8_LDA(At, 0, 1); PG8_STAGE(PG8_SB(0, 0), b2, voffB); PG8_STAGE(PG8_SB(0, 1), b2 + hstep, voffB); PG8_STAGE(PG8_SA(0, 0), a2, voffA);
            PG8_WAIT_V(8); PG8_WAIT_L(0); PG8_BAR; PG8_MMA(1, 0, At, B0); PG8_MMA(1, 1, At, B1); PG8_BAR; PG8_SCHED;
            PG8_LDB(B0, 1, 0); PG8_LDB(B1, 1, 1); PG8_SCHED; PG8_LDA(At, 1, 0); PG8_STAGE(PG8_SA(0, 1), a2 + hstep, voffA);
            PG8_WAIT_V(8); PG8_WAIT_L(0); PG8_BAR; PG8_MMA(0, 0, At, B0); PG8_MMA(0, 1, At, B1); PG8_BAR; PG8_SCHED;
            PG8_LDA(At, 1, 1); PG8_STAGE(PG8_SB(1, 0), b3, voffB); PG8_STAGE(PG8_SB(1, 1), b3 + hstep, voffB); PG8_STAGE(PG8_SA(1, 0), a3, voffA);
            PG8_WAIT_V(8); PG8_WAIT_L(0); PG8_BAR; PG8_MMA(1, 0, At, B0); PG8_MMA(1, 1, At, B1); PG8_BAR; PG8_SCHED;
            } else {
            PG8_LDB(B0, 0, 0); PG8_SCHED; PG8_LDA(At, 0, 0); PG8_STAGE(PG8_SA(1, 1), a1 + hstep, voffA);
            PG8_WAIT_L(8); PG8_BAR; PG8_WAIT_L(0); PG8_MMA(0, 0, At, B0); PG8_BAR; PG8_SCHED;
            PG8_LDB(B1, 0, 1); PG8_STAGE(PG8_SB(0, 0), b2, voffB);
            PG8_BAR; PG8_WAIT_L(0); PG8_MMA(0, 1, At, B1); PG8_BAR;
            PG8_LDA(At, 0, 1); PG8_STAGE(PG8_SA(0, 0), a2, voffA);
            PG8_BAR; PG8_WAIT_L(0); PG8_MMA(1, 0, At, B0); PG8_BAR; PG8_SCHED;
            PG8_STAGE(PG8_SB(0, 1), b2 + hstep, voffB);
            PG8_WAIT_V(6); PG8_BAR; PG8_MMA(1, 1, At, B1); PG8_BAR;
            PG8_LDB(B0, 1, 0); PG8_SCHED; PG8_LDA(At, 1, 0); PG8_STAGE(PG8_SA(0, 1), a2 + hstep, voffA);
            PG8_WAIT_L(8); PG8_BAR; PG8_WAIT_L(0); PG8_MMA(0, 0, At, B0); PG8_BAR; PG8_SCHED;
            PG8_LDB(B1, 1, 1); PG8_STAGE(PG8_SB(1, 0), b3, voffB);
            PG8_BAR; PG8_WAIT_L(0); PG8_MMA(0, 1, At, B1); PG8_BAR;
            PG8_LDA(At, 1, 1); PG8_STAGE(PG8_SA(1, 0), a3, voffA);
            PG8_BAR; PG8_WAIT_L(0); PG8_MMA(1, 0, At, B0); PG8_BAR; PG8_SCHED;
            PG8_STAGE(PG8_SB(1, 1), b3 + hstep, voffB);
            PG8_WAIT_V(6); PG8_BAR; PG8_MMA(1, 1, At, B1); PG8_BAR;
            }
        }
        if constexpr (ALIGN_EPI) { if (wr == 0) PG8_BAR; }
        if constexpr (Epi::PREF) {
#pragma unroll
            for (int ai = 0; ai < 2; ++ai)
#pragma unroll
                for (int m = 0; m < 4; ++m) sv[ai * 4 + m] = *(const LAS float*)(lds + STAGE_BYTES + (ui & 1) * 1024 + 4 * (ai * HALF + wr * 64 + m * 16 + fr));
        }
        if constexpr (!Epi::AFTER_DRAIN) { E(acc, cur, wr, wc, fr, fq, sv); S.done(cur); }
        if (!has_next) break;
#pragma unroll
        for (int a = 0; a < 2; ++a)
#pragma unroll
            for (int b = 0; b < 2; ++b)
#pragma unroll
                for (int m = 0; m < 4; ++m)
#pragma unroll
                    for (int n = 0; n < 2; ++n) acc[a][b][m][n] = (f32x4){0.f, 0.f, 0.f, 0.f};
        cur = nxt; cA = nA; cB = nB; ++ui;
        PG8_SS_DMA(cur, ui & 1);
        if constexpr (ALIGN_EPI) { if (wr == 1) PG8_BAR; }
    }
    PG8_WAIT_V(0);
    if constexpr (!ALIGN_EPI) { if (wr == 0) PG8_BAR; }
    PG8_BAR;
#undef PG8_SS_DMA
#undef PG8_SA
#undef PG8_SB
#undef PG8_STAGE
#undef PG8_LDA
#undef PG8_LDB
#undef PG8_MMA
#undef PG8_WAIT_V
#undef PG8_WAIT_L
#undef PG8_BAR
#undef PG8_SCHED
}
}

struct Params { const float* in[24]; float* out; unsigned char* ws; };
enum { I_XP = 0, I_XS, I_CA, I_CB, I_CP, I_N1, I_WG1, I_WU1, I_WD1, I_NM, I_WIN, I_CAW, I_CBW, I_CBB, I_LNG, I_LNB, I_PW, I_PS, I_WOUT, I_N2, I_WG2, I_WU2, I_WD2, I_NF };

__device__ __forceinline__ void tr_item(const float* W, int N, const float* gk, bf16_t* WT, int ldk, int drow0, int k0, int n0, LAS float* scr, int lane) {
    const int l16 = lane & 15, kq = lane >> 4;
    f32x4 v[16];
#pragma unroll
    for (int i = 0; i < 16; ++i) v[i] = *(const f32x4*)(W + (size_t)(k0 + 4 * i + kq) * N + n0 + 4 * l16);
    if (gk) {
#pragma unroll
        for (int i = 0; i < 16; ++i) v[i] = v[i] * gk[k0 + 4 * i + kq]; }
#pragma unroll
    for (int i = 0; i < 16; ++i) { LAS float* d = scr + (4 * i + kq) * 65 + 4 * l16; d[0] = v[i][0]; d[1] = v[i][1]; d[2] = v[i][2]; d[3] = v[i][3]; }
    LDS_WAIT(); asm volatile("" ::: "memory");
    const int c = lane & 7;
#pragma unroll
    for (int j = 0; j < 8; ++j) { const int n = (lane >> 3) + 8 * j; const LAS float* s = scr + (8 * c) * 65 + n;
        u32x4 o; o.x = cvt_pk_bf16(s[0 * 65], s[1 * 65]); o.y = cvt_pk_bf16(s[2 * 65], s[3 * 65]); o.z = cvt_pk_bf16(s[4 * 65], s[5 * 65]); o.w = cvt_pk_bf16(s[6 * 65], s[7 * 65]);
        *(u32x4*)(WT + (size_t)(drow0 + n) * ldk + k0 + 8 * c) = o; }
    LDS_WAIT(); asm volatile("" ::: "memory");
}

__device__ __forceinline__ void prologue(const Params& p, LAS unsigned char* lds, int G) {
    const int tid = threadIdx.x, lane = tid & 63, wave = __builtin_amdgcn_readfirstlane(tid >> 6);
    const int gw = blockIdx.x * 8 + wave, NGW = G * 8;
    float* ss = (float*)(p.ws + WS_SS);
    for (int b = blockIdx.x; b < 256; b += G) {
        const int layer = b >> 7, g = (b >> 5) & 3, n0 = (b & 31) * 64;
        LAS float* Bs = (LAS float*)lds;
        LAS float* As = (LAS float*)(lds + 32768);
        const float* wo = p.in[I_WOUT] + (size_t)layer * DM * DM + (size_t)(1536 + g * 128) * DM + n0;
        const float* ps = p.in[I_PS] + layer * DC + g * 128;
        const float* pw = p.in[I_PW] + (size_t)(layer * 4 + g) * 128 * 128;
#pragma unroll
        for (int i = 0; i < 4; ++i) { const int e = (i * 512 + tid) * 4, d = e >> 6, n = e & 63; const f32x4 v = *(const f32x4*)(wo + (size_t)d * DM + n) * ps[d]; *(LAS f32x4*)(Bs + d * 64 + n) = v; }
#pragma unroll
        for (int i = 0; i < 8; ++i) { const int e = (i * 512 + tid) * 4, c = e >> 7, d = e & 127; const f32x4 v = *(const f32x4*)(pw + e); LAS float* dp = As + c * 129 + d; dp[0] = v[0]; dp[1] = v[1]; dp[2] = v[2]; dp[3] = v[3]; }
        __syncthreads();
        float a[16];
#pragma unroll
        for (int i = 0; i < 16; ++i) a[i] = 0.f;
        for (int d = 0; d < 128; ++d) { const float bv = Bs[d * 64 + lane];
#pragma unroll
            for (int i = 0; i < 16; ++i) a[i] += As[(wave * 16 + i) * 129 + d] * bv; }
        bf16_t* dst = (bf16_t*)(p.ws + WS_W + (size_t)layer * W_LAYER + W_OUT) + (size_t)(n0 + lane) * DM + 1536 + g * 128 + wave * 16;
        u32x4 o0, o1;
        o0.x = cvt_pk_bf16(a[0], a[1]); o0.y = cvt_pk_bf16(a[2], a[3]); o0.z = cvt_pk_bf16(a[4], a[5]); o0.w = cvt_pk_bf16(a[6], a[7]);
        o1.x = cvt_pk_bf16(a[8], a[9]); o1.y = cvt_pk_bf16(a[10], a[11]); o1.z = cvt_pk_bf16(a[12], a[13]); o1.w = cvt_pk_bf16(a[14], a[15]);
        *(u32x4*)dst = o0; *(u32x4*)(dst + 8) = o1;
        __syncthreads();
    }
    LAS float* scr = (LAS float*)(lds + wave * 16640);
    constexpr int PER_LAYER = 2816 * 6 + 2176 + 768;
#pragma unroll 1
    for (int it = gw; it < 2 * PER_LAYER; it += NGW) {
        const int layer = it >= PER_LAYER ? 1 : 0; int r = it - layer * PER_LAYER;
        unsigned char* wl = p.ws + WS_W + (size_t)layer * W_LAYER;
        const float* W; const float* gk = nullptr; bf16_t* WT; int N, ldk, nnb, kind = 0;
        if (r < 2816) { W = p.in[I_WG1] + (size_t)layer * DM * DFF; gk = p.in[I_N1] + layer * DM; WT = (bf16_t*)(wl + W_GU1); N = DFF; ldk = DM; nnb = 88; kind = 1; }
        else if ((r -= 2816) < 2816) { W = p.in[I_WU1] + (size_t)layer * DM * DFF; gk = p.in[I_N1] + layer * DM; WT = (bf16_t*)(wl + W_GU1); N = DFF; ldk = DM; nnb = 88; kind = 2; }
        else if ((r -= 2816) < 2816) { W = p.in[I_WD1] + (size_t)layer * DFF * DM; WT = (bf16_t*)(wl + W_D1); N = DM; ldk = DFF; nnb = 32; }
        else if ((r -= 2816) < 2176) { W = p.in[I_WIN] + (size_t)layer * DM * DIN; gk = p.in[I_NM] + layer * DM; WT = (bf16_t*)(wl + W_IN); N = DIN; ldk = DM; nnb = 68; }
        else if ((r -= 2176) < 768) { W = p.in[I_WOUT] + (size_t)layer * DM * DM; WT = (bf16_t*)(wl + W_OUT); N = DM; ldk = DM; nnb = 32; }
        else if ((r -= 768) < 2816) { W = p.in[I_WG2] + (size_t)layer * DM * DFF; gk = p.in[I_N2] + layer * DM; WT = (bf16_t*)(wl + W_GU2); N = DFF; ldk = DM; nnb = 88; kind = 1; }
        else if ((r -= 2816) < 2816) { W = p.in[I_WU2] + (size_t)layer * DM * DFF; gk = p.in[I_N2] + layer * DM; WT = (bf16_t*)(wl + W_GU2); N = DFF; ldk = DM; nnb = 88; kind = 2; }
        else { r -= 2816; W = p.in[I_WD2] + (size_t)layer * DFF * DM; WT = (bf16_t*)(wl + W_D2); N = DM; ldk = DFF; nnb = 32; }
        const int kb = r / nnb, nb = r - kb * nnb, k0 = kb * 64, n0 = nb * 64;
        const int drow0 = kind ? ((n0 >> 7) * 256 + (kind - 1) * 128 + (n0 & 127)) : n0;
        tr_item(W, N, gk, WT, ldk, drow0, k0, n0, scr, lane);
    }
    bf16_t* hb = (bf16_t*)(p.ws + WS_HB);
    for (int m = gw; m < MT; m += NGW) {
        const float* xr = (m < MP) ? p.in[I_XP] + (size_t)m * DM : p.in[I_XS] + (size_t)(m - MP) * DM;
        float s = 0.f;
#pragma unroll
        for (int j = 0; j < 4; ++j) { const f32x4 v0 = *(const f32x4*)(xr + j * 512 + lane * 8), v1 = *(const f32x4*)(xr + j * 512 + lane * 8 + 4);
            s += (v0[0] * v0[0] + v0[1] * v0[1]) + (v0[2] * v0[2] + v0[3] * v0[3]) + (v1[0] * v1[0] + v1[1] * v1[1]) + (v1[2] * v1[2] + v1[3] * v1[3]);
            u32x4 w; w.x = cvt_pk_bf16(v0[0], v0[1]); w.y = cvt_pk_bf16(v0[2], v0[3]); w.z = cvt_pk_bf16(v1[0], v1[1]); w.w = cvt_pk_bf16(v1[2], v1[3]);
            *(u32x4*)(hb + (size_t)m * DM + j * 512 + lane * 8) = w; }
        s = wave_sum(s);
        if (lane == 0) ss[m] = s;
    }
}

__device__ __forceinline__ void ld8_bf16(const bf16_t* p, float (&v)[8]) {
    const u32x4 w = *(const u32x4*)p;
    v[0] = bf_lo(w.x); v[1] = bf_hi(w.x); v[2] = bf_lo(w.y); v[3] = bf_hi(w.y); v[4] = bf_lo(w.z); v[5] = bf_hi(w.z); v[6] = bf_lo(w.w); v[7] = bf_hi(w.w);
}
__device__ __forceinline__ void ld8_f32(const float* p, float (&v)[8]) {
    const f32x4 a = *(const f32x4*)p, b = *(const f32x4*)(p + 4);
    v[0] = a[0]; v[1] = a[1]; v[2] = a[2]; v[3] = a[3]; v[4] = b[0]; v[5] = b[1]; v[6] = b[2]; v[7] = b[3];
}
__device__ __forceinline__ void st8_f32(float* p, const float (&v)[8]) {
    *(f32x4*)p = (f32x4){v[0], v[1], v[2], v[3]}; *(f32x4*)(p + 4) = (f32x4){v[4], v[5], v[6], v[7]};
}
__device__ __forceinline__ void st8_bf16(bf16_t* p, const float (&v)[8]) {
    u32x4 w; w.x = cvt_pk_bf16(v[0], v[1]); w.y = cvt_pk_bf16(v[2], v[3]); w.z = cvt_pk_bf16(v[4], v[5]); w.w = cvt_pk_bf16(v[6], v[7]);
    *(u32x4*)p = w;
}

constexpr int TOK = 16, HALO = 30, VROWS = TOK + HALO, CH = 384;
__device__ __forceinline__ void mixer_mid(const Params& p, LAS unsigned char* lds, int G, int layer) {
    int tid = threadIdx.x; asm volatile("" : "+v"(tid));
    const int lane = tid & 63, wave = __builtin_amdgcn_readfirstlane(tid >> 6);
    LAS float* vt = (LAS float*)lds;
    LAS float* cb = (LAS float*)(lds + VROWS * CH * 4);
    const bf16_t* z = (const bf16_t*)(p.ws + WS_ACT);
    bf16_t* cat = (bf16_t*)(p.ws + WS_CAT);
    const float* caw = p.in[I_CAW] + layer * 3 * DA;
    const float* cbw = p.in[I_CBW] + layer * 31 * DB;
    const float* cbb = p.in[I_CBB] + layer * DB;
    const float* lng = p.in[I_LNG] + layer * DB;
    const float* lnb = p.in[I_LNB] + layer * DB;
    for (int ch = blockIdx.x; ch < MT / TOK; ch += G) {
        const bool samp = ch >= MP / TOK;
        int seq, l0, L;
        if (!samp) { seq = ch >> 9; l0 = (ch & 511) * TOK; L = 8192; } else { const int cs = ch - MP / TOK; seq = cs >> 2; l0 = (cs & 3) * TOK; L = 64; }
        const int row0 = ch * TOK;
        const bool lastc = (l0 + TOK == L), fast = (l0 >= 32);
        const float* hist_a = p.in[I_CA] + (size_t)(layer * 8 + seq) * 2 * DA;
        const float* hist_b = p.in[I_CB] + (size_t)(layer * 8 + seq) * 30 * DB;
        const float* hist_p = p.in[I_CP] + (size_t)(layer * 8 + seq) * 15 * DC;
        float* out_a = p.out + (samp ? OFF_A_S + (layer * 8 + seq) * 2 * DA : OFF_A_P + (layer * 2 + seq) * 2 * DA);
        float* out_b = p.out + (samp ? OFF_B_S + (layer * 8 + seq) * 30 * DB : OFF_B_P + (layer * 2 + seq) * 30 * DB);
        float* out_p = p.out + (samp ? OFF_P_S + (layer * 8 + seq) * 15 * DC : OFF_P_P + (layer * 2 + seq) * 15 * DC);
        u32x4 ra[5], rg[5];
#define MIX_VLOAD(hc_) do { _Pragma("unroll") for (int i = 0; i < 5; ++i) { const int it = tid + 512 * i; if (it < VROWS * (CH / 8)) { const int j = it / (CH / 8), cl = (it - j * (CH / 8)) * 8; \
            const bf16_t* zr = z + (size_t)(row0 - HALO + j) * DIN + (hc_) * CH + cl; ra[i] = *(const u32x4*)(zr + 2304); rg[i] = *(const u32x4*)(zr + 3072); } } } while (0)
        if (fast) MIX_VLOAD(0);
#pragma unroll 1
        for (int hc = 0; hc < 2; ++hc) {
            if (fast) {
#pragma unroll
                for (int i = 0; i < 5; ++i) { const int it = tid + 512 * i; if (it < VROWS * (CH / 8)) { const int j = it / (CH / 8), cl = (it - j * (CH / 8)) * 8, c8 = hc * CH + cl;
                    float v[8];
                    v[0] = bf_lo(ra[i].x) * sigmoidf_(bf_lo(rg[i].x)); v[1] = bf_hi(ra[i].x) * sigmoidf_(bf_hi(rg[i].x));
                    v[2] = bf_lo(ra[i].y) * sigmoidf_(bf_lo(rg[i].y)); v[3] = bf_hi(ra[i].y) * sigmoidf_(bf_hi(rg[i].y));
                    v[4] = bf_lo(ra[i].z) * sigmoidf_(bf_lo(rg[i].z)); v[5] = bf_hi(ra[i].z) * sigmoidf_(bf_hi(rg[i].z));
                    v[6] = bf_lo(ra[i].w) * sigmoidf_(bf_lo(rg[i].w)); v[7] = bf_hi(ra[i].w) * sigmoidf_(bf_hi(rg[i].w));
                    *(LAS f32x4*)(vt + j * CH + cl) = (f32x4){v[0], v[1], v[2], v[3]}; *(LAS f32x4*)(vt + j * CH + cl + 4) = (f32x4){v[4], v[5], v[6], v[7]};
                    if (lastc && j >= TOK) st8_f32(out_b + (size_t)(j - TOK) * DB + c8, v); } }
                if (hc == 0) MIX_VLOAD(1);
            } else
#pragma unroll 1
            for (int it = tid; it < VROWS * (CH / 8); it += 512) {
                const int j = it / (CH / 8), cl = (it - j * (CH / 8)) * 8, c8 = hc * CH + cl, l = l0 - HALO + j;
                float v[8];
                if (l >= 0) { const bf16_t* zr = z + (size_t)(row0 - HALO + j) * DIN; float a[8], g[8]; ld8_bf16(zr + 2304 + c8, a); ld8_bf16(zr + 3072 + c8, g);
#pragma unroll
                    for (int i = 0; i < 8; ++i) v[i] = a[i] * sigmoidf_(g[i]); }
                else if (samp) ld8_f32(hist_b + (size_t)(30 + l) * DB + c8, v);
                else {
#pragma unroll
                    for (int i = 0; i < 8; ++i) v[i] = 0.f; }
                *(LAS f32x4*)(vt + j * CH + cl) = (f32x4){v[0], v[1], v[2], v[3]}; *(LAS f32x4*)(vt + j * CH + cl + 4) = (f32x4){v[4], v[5], v[6], v[7]};
                if (lastc && j >= TOK) st8_f32(out_b + (size_t)(j - TOK) * DB + c8, v);
            }
            __syncthreads();
            if (tid < CH) {
                const int c = hc * CH + tid;
                float wv[31];
#pragma unroll
                for (int k = 0; k < 31; ++k) wv[k] = cbw[k * DB + c];
                const float bias = cbb[c];
                float o[TOK];
#pragma unroll
                for (int i = 0; i < TOK; ++i) o[i] = bias;
                const LAS float* vp = vt + tid;
#pragma unroll
                for (int jj = 0; jj < VROWS; ++jj) { const float x = vp[jj * CH];
#pragma unroll
                    for (int i = 0; i < TOK; ++i) { if (jj - i >= 0 && jj - i <= 30) o[i] += wv[(jj - i >= 0 && jj - i <= 30) ? jj - i : 0] * x; } }
#pragma unroll
                for (int i = 0; i < TOK; ++i) cb[i * DB + c] = o[i];
            }
            __syncthreads();
        }
#pragma unroll 1
        for (int tt = 0; tt < 2; ++tt) { const int tk = wave * 2 + tt; f32x2 x[6]; float s = 0.f;
#pragma unroll
            for (int i = 0; i < 6; ++i) { x[i] = *(const LAS f32x2*)(cb + tk * DB + 128 * i + 2 * lane); s += x[i].x + x[i].y; }
            const float mean = wave_sum(s) * (1.f / DB); float q2 = 0.f;
#pragma unroll
            for (int i = 0; i < 6; ++i) { x[i].x -= mean; x[i].y -= mean; q2 += x[i].x * x[i].x + x[i].y * x[i].y; }
            const float rstd = __builtin_amdgcn_rsqf(wave_sum(q2) * (1.f / DB) + EPS);
#pragma unroll
            for (int i = 0; i < 6; ++i) { const int c = 128 * i + 2 * lane; const f32x2 gg = *(const f32x2*)(lng + c), bb = *(const f32x2*)(lnb + c);
                const float y0 = siluf_(x[i].x * rstd * gg.x + bb.x), y1 = siluf_(x[i].y * rstd * gg.y + bb.y);
                *(unsigned*)(cat + (size_t)(row0 + tk) * DM + DA + c) = cvt_pk_bf16(y0, y1); } }
        if (fast) {
#pragma unroll 1
            for (int i = 0; i < 3; ++i) { const int it = tid + 512 * i, tk = it / 96, c8 = (it - tk * 96) * 8; const size_t row = row0 + tk; const bf16_t* zr = z + row * DIN + c8;
                u32x4 qa[3], qc[3], qb;
#pragma unroll
                for (int q = 0; q < 3; ++q) { qa[q] = *(const u32x4*)(zr - (2 - q) * DIN); qc[q] = *(const u32x4*)(zr - (2 - q) * DIN + 1536); }
                qb = *(const u32x4*)(zr + 768);
                float y[8], t[8], w[8];
#pragma unroll
                for (int e = 0; e < 8; ++e) y[e] = 0.f;
#pragma unroll
                for (int q = 0; q < 3; ++q) { ld8_f32(caw + q * DA + c8, w);
                    t[0] = bf_lo(qa[q].x) * bf_lo(qc[q].x); t[1] = bf_hi(qa[q].x) * bf_hi(qc[q].x); t[2] = bf_lo(qa[q].y) * bf_lo(qc[q].y); t[3] = bf_hi(qa[q].y) * bf_hi(qc[q].y);
                    t[4] = bf_lo(qa[q].z) * bf_lo(qc[q].z); t[5] = bf_hi(qa[q].z) * bf_hi(qc[q].z); t[6] = bf_lo(qa[q].w) * bf_lo(qc[q].w); t[7] = bf_hi(qa[q].w) * bf_hi(qc[q].w);
#pragma unroll
                    for (int e = 0; e < 8; ++e) y[e] += w[e] * t[e]; }
                y[0] *= bf_lo(qb.x); y[1] *= bf_hi(qb.x); y[2] *= bf_lo(qb.y); y[3] *= bf_hi(qb.y); y[4] *= bf_lo(qb.z); y[5] *= bf_hi(qb.z); y[6] *= bf_lo(qb.w); y[7] *= bf_hi(qb.w);
                st8_bf16(cat + row * DM + c8, y);
                if (lastc && tk >= TOK - 2) st8_f32(out_a + (size_t)(tk - (TOK - 2)) * DA + c8, t); }
#pragma unroll 1
            for (int i = 0; i < 2; ++i) { const int it = tid + 512 * i, tk = it >> 6, c8 = (it & 63) * 8; const size_t row = row0 + tk; const int w = 2 << (c8 >> 7);
                const bf16_t* zr = z + row * DIN + 3840 + c8;
                u32x4 r[16];
#pragma unroll
                for (int q = 0; q < 16; ++q) { r[q] = (u32x4){0u, 0u, 0u, 0u}; if (q < w) r[q] = *(const u32x4*)(zr - (size_t)q * DIN); }
                float sm[8], u0[8];
                u0[0] = bf_lo(r[0].x); u0[1] = bf_hi(r[0].x); u0[2] = bf_lo(r[0].y); u0[3] = bf_hi(r[0].y); u0[4] = bf_lo(r[0].z); u0[5] = bf_hi(r[0].z); u0[6] = bf_lo(r[0].w); u0[7] = bf_hi(r[0].w);
#pragma unroll
                for (int e = 0; e < 8; ++e) sm[e] = u0[e];
#pragma unroll
                for (int q = 1; q < 16; ++q) { sm[0] += bf_lo(r[q].x); sm[1] += bf_hi(r[q].x); sm[2] += bf_lo(r[q].y); sm[3] += bf_hi(r[q].y); sm[4] += bf_lo(r[q].z); sm[5] += bf_hi(r[q].z); sm[6] += bf_lo(r[q].w); sm[7] += bf_hi(r[q].w); }
                const float rc = 1.f / (float)w; float d[8];
#pragma unroll
                for (int e = 0; e < 8; ++e) d[e] = sm[e] * rc - u0[e];
                st8_bf16(cat + row * DM + 1536 + c8, d);
                if (lastc && tk >= 1) st8_f32(out_p + (size_t)(tk - 1) * DC + c8, u0); }
        } else {
#pragma unroll 1
        for (int it = tid; it < TOK * 96; it += 512) {
            const int tk = it / 96, c8 = (it - tk * 96) * 8, l = l0 + tk; const size_t row = row0 + tk;
            float t[8], y[8], b[8];
#pragma unroll
            for (int i = 0; i < 8; ++i) y[i] = 0.f;
#pragma unroll
            for (int q = 0; q < 3; ++q) { const int lq = l - 2 + q;
                if (lq >= 0) { const bf16_t* zr = z + (row - 2 + q) * DIN; float a[8], c[8]; ld8_bf16(zr + c8, a); ld8_bf16(zr + 1536 + c8, c);
#pragma unroll
                    for (int i = 0; i < 8; ++i) t[i] = a[i] * c[i]; }
                else if (samp) ld8_f32(hist_a + (size_t)(2 + lq) * DA + c8, t);
                else {
#pragma unroll
                    for (int i = 0; i < 8; ++i) t[i] = 0.f; }
                float w[8]; ld8_f32(caw + q * DA + c8, w);
#pragma unroll
                for (int i = 0; i < 8; ++i) y[i] += w[i] * t[i]; }
            ld8_bf16(z + row * DIN + 768 + c8, b);
#pragma unroll
            for (int i = 0; i < 8; ++i) y[i] *= b[i];
            st8_bf16(cat + row * DM + c8, y);
            if (lastc && tk >= TOK - 2) st8_f32(out_a + (size_t)(tk - (TOK - 2)) * DA + c8, t);
        }
#pragma unroll 1
        for (int it = tid; it < TOK * 64; it += 512) {
            const int tk = it >> 6, c8 = (it & 63) * 8, l = l0 + tk; const size_t row = row0 + tk;
            const int w = 2 << (c8 >> 7);
            float u0[8], s[8];
            ld8_bf16(z + row * DIN + 3840 + c8, u0);
#pragma unroll
            for (int i = 0; i < 8; ++i) s[i] = u0[i];
#pragma unroll 1
            for (int q = 1; q < w; ++q) { const int lq = l - q; float uq[8];
                if (lq >= 0) ld8_bf16(z + (row - q) * DIN + 3840 + c8, uq);
                else if (samp) ld8_f32(hist_p + (size_t)(15 + lq) * DC + c8, uq);
                else break;
#pragma unroll
                for (int i = 0; i < 8; ++i) s[i] += uq[i]; }
            const int cnt = samp ? w : (l + 1 < w ? l + 1 : w);
            const float rc = 1.f / (float)cnt; float d[8];
#pragma unroll
            for (int i = 0; i < 8; ++i) d[i] = s[i] * rc - u0[i];
            st8_bf16(cat + row * DM + 1536 + c8, d);
            if (lastc && tk >= 1) st8_f32(out_p + (size_t)(tk - 1) * DC + c8, u0);
        }
        }
        __syncthreads();
    }
}

__device__ __forceinline__ void sample_fixup(const Params& p, int G, float* ss_out) {
    int tid = threadIdx.x; asm volatile("" : "+v"(tid));
    const int lane = tid & 63, wave = __builtin_amdgcn_readfirstlane(tid >> 6);
    bf16_t* hb = (bf16_t*)(p.ws + WS_HB);
    const float* slab = (const float*)(p.ws + WS_SLAB);
    for (int m = blockIdx.x * 8 + wave; m < MS; m += G * 8) {
        bf16_t* hr = hb + (size_t)(MP + m) * DM; float s = 0.f;
#pragma unroll
        for (int j = 0; j < 4; ++j) { const int c = j * 512 + lane * 8; float b[8]; ld8_bf16(hr + c, b);
            f32x4 v0 = (f32x4){b[0], b[1], b[2], b[3]}, v1 = (f32x4){b[4], b[5], b[6], b[7]};
#pragma unroll
            for (int q = 0; q < 4; ++q) { const float* sr = slab + (size_t)q * (MS * DM) + (size_t)m * DM + c; v0 += *(const f32x4*)sr; v1 += *(const f32x4*)(sr + 4); }
            u32x4 w; w.x = cvt_pk_bf16(v0[0], v0[1]); w.y = cvt_pk_bf16(v0[2], v0[3]); w.z = cvt_pk_bf16(v1[0], v1[1]); w.w = cvt_pk_bf16(v1[2], v1[3]);
            *(u32x4*)(hr + c) = w;
            const float r[8] = {bf_lo(w.x), bf_hi(w.x), bf_lo(w.y), bf_hi(w.y), bf_lo(w.z), bf_hi(w.z), bf_lo(w.w), bf_hi(w.w)};
#pragma unroll
            for (int e = 0; e < 8; ++e) s += r[e] * r[e]; }
        s = wave_sum(s);
        if (lane == 0) ss_out[MP + m] = s;
    }
    const float* ssp = (const float*)(p.ws + WS_SSP);
    for (int r2 = blockIdx.x * 8 + wave; r2 < MP / 2; r2 += G * 8) {
        const int row = r2 * 2 + (lane >> 5);
        float v = ssp[(size_t)row * 32 + (lane & 31)];
#pragma unroll
        for (int o = 1; o < 32; o <<= 1) v += __shfl_xor(v, o);
        if ((lane & 31) == 0) ss_out[row] = v;
    }
}

__device__ __forceinline__ void final_norm(const Params& p, int G) {
    int tid = threadIdx.x; asm volatile("" : "+v"(tid));
    const int lane = tid & 63, wave = __builtin_amdgcn_readfirstlane(tid >> 6);
    const int gw = blockIdx.x * 8 + wave, NGW = G * 8;
    const float* ss = (const float*)(p.ws + WS_SS) + 6 * MT;
    const float* gn = p.in[I_NF];
    const bf16_t* hb = (const bf16_t*)(p.ws + WS_HB);
    for (int m = gw; m < MT; m += NGW) {
        const float rinv = __builtin_amdgcn_rsqf(ss[m] * (1.f / DM) + EPS);
        float* orow = p.out + (size_t)m * DM;
#pragma unroll
        for (int j = 0; j < 4; ++j) { const int c = j * 512 + lane * 8; float b[8], g[8]; ld8_bf16(hb + (size_t)m * DM + c, b); ld8_f32(gn + c, g);
#pragma unroll
            for (int e = 0; e < 8; ++e) b[e] = b[e] * rinv * g[e];
            st8_f32(orow + c, b); }
    }
}

__device__ __forceinline__ void final_fused(const Params& p, int G) {
    int tid = threadIdx.x; asm volatile("" : "+v"(tid));
    const int lane = tid & 63, wave = __builtin_amdgcn_readfirstlane(tid >> 6);
    const int gw = blockIdx.x * 8 + wave, NGW = G * 8;
    const float* gn = p.in[I_NF];
    const bf16_t* hb = (const bf16_t*)(p.ws + WS_HB);
    const float* ssp = (const float*)(p.ws + WS_SSP);
    const float* slab = (const float*)(p.ws + WS_SLAB);
    for (int m = gw; m < MT; m += NGW) {
        float b[4][8]; float s;
#pragma unroll
        for (int j = 0; j < 4; ++j) ld8_bf16(hb + (size_t)m * DM + j * 512 + lane * 8, b[j]);
        if (m < MP) {
            float v = ssp[(size_t)m * 32 + (lane & 31)];
#pragma unroll
            for (int o = 1; o < 32; o <<= 1) v += __shfl_xor(v, o);
            s = v;
        } else {
            s = 0.f;
#pragma unroll
            for (int j = 0; j < 4; ++j) {
#pragma unroll
                for (int q = 0; q < 4; ++q) { float t[8]; ld8_f32(slab + (size_t)q * (MS * DM) + (size_t)(m - MP) * DM + j * 512 + lane * 8, t);
#pragma unroll
                    for (int e = 0; e < 8; ++e) b[j][e] += t[e]; }
#pragma unroll
                for (int e = 0; e < 8; ++e) s += b[j][e] * b[j][e]; }
            s = wave_sum(s);
        }
        const float rinv = __builtin_amdgcn_rsqf(s * (1.f / DM) + EPS);
        float* orow = p.out + (size_t)m * DM;
#pragma unroll
        for (int j = 0; j < 4; ++j) { const int c = j * 512 + lane * 8; float g[8]; ld8_f32(gn + c, g);
#pragma unroll
            for (int e = 0; e < 8; ++e) b[j][e] = b[j][e] * rinv * g[e];
            st8_f32(orow + c, b[j]); }
    }
}

#define XB_TMO      128
#define XB_XCNT(j)  (256  + 64 * (j))
#define XB_XSUB(j)  (1280 + 64 * (j))
#define XB_XGEN(j)  (2304 + 64 * (j))
#define XB_TOP      3328
#define XB_TOPGEN   3392
#define XCD_BAR_WORDS 3456
#define XB_SPIN_CAP (1u << 22)
__device__ __forceinline__ unsigned xb_ld(unsigned* p)              { return __hip_atomic_load(p, __ATOMIC_RELAXED, __HIP_MEMORY_SCOPE_AGENT); }
__device__ __forceinline__ unsigned xb_add(unsigned* p, unsigned v) { return __hip_atomic_fetch_add(p, v, __ATOMIC_RELAXED, __HIP_MEMORY_SCOPE_AGENT); }
__device__ __forceinline__ unsigned xb_xcc_id() { return (unsigned)__builtin_amdgcn_s_getreg((3 << 11) | 20) & 0xFu; }
#define XB_SPIN(cond, bar) do { unsigned _sp = 0; while (cond) { __builtin_amdgcn_s_sleep(1); \
    if ((++_sp & 255u) == 0u) { if (xb_ld(&(bar)[XB_TMO])) break; if (_sp > XB_SPIN_CAP) { atomicAdd(&(bar)[XB_TMO], 1u); break; } } } } while (0)
struct XcdBarrier { unsigned* bar; unsigned x; volatile LAS unsigned* st; };
__device__ __forceinline__ XcdBarrier xcd_barrier_post(unsigned* bar, volatile LAS unsigned* st) {
    XcdBarrier b; b.bar = bar; b.x = xb_xcc_id(); b.st = st;
    if (threadIdx.x == 0) (void)xb_add(&bar[XB_XCNT(b.x)], 1u);
    return b;
}
__device__ __forceinline__ void xcd_barrier_complete(unsigned* bar, unsigned x, unsigned& nloc, unsigned& nx) {
    const unsigned G = gridDim.x * gridDim.y * gridDim.z;
    unsigned sum, cnt, mine, sp = 0u;
    for (;;) {
        sum = 0u; cnt = 0u; mine = 0u;
#pragma unroll
        for (unsigned j = 0; j < 16; ++j) { const unsigned c = xb_ld(&bar[XB_XCNT(j)]); sum += c; cnt += (c > 0u) ? 1u : 0u; mine = (j == x) ? c : mine; }
        if (sum == G) break;
        __builtin_amdgcn_s_sleep(1);
        if ((++sp & 255u) == 0u) { if (xb_ld(&bar[XB_TMO])) break; if (sp > XB_SPIN_CAP) { atomicAdd(&bar[XB_TMO], 1u); break; } }
    }
    nloc = mine > 0u ? mine : 1u; nx = cnt > 0u ? cnt : 1u;
}
__device__ __forceinline__ void xcd_barrier(const XcdBarrier& b) {
    asm volatile("s_waitcnt vmcnt(0)" ::: "memory");
    __syncthreads();
    if (threadIdx.x == 0) {
        unsigned* bar = b.bar;
        __builtin_amdgcn_s_waitcnt(0);
        unsigned nloc = b.st[0], nx = b.st[1];
        if (nloc == 0u) { xcd_barrier_complete(bar, b.x, nloc, nx); b.st[0] = nloc; b.st[1] = nx; }
        const unsigned old = xb_add(&bar[XB_XSUB(b.x)], 1u);
        const unsigned gen = old / nloc;
        if (old + 1u == (gen + 1u) * nloc) {
            __builtin_amdgcn_fence(__ATOMIC_RELEASE, "agent");
            asm volatile("s_waitcnt vmcnt(0)" ::: "memory");
            const unsigned og = xb_add(&bar[XB_TOP], 1u);
            const unsigned tg = og / nx;
            if (og + 1u == (tg + 1u) * nx) xb_add(&bar[XB_TOPGEN], 1u);
            else XB_SPIN(xb_ld(&bar[XB_TOPGEN]) == tg, bar);
            __builtin_amdgcn_fence(__ATOMIC_ACQUIRE, "agent");
            xb_add(&bar[XB_XGEN(b.x)], 1u);
            asm volatile("s_waitcnt vmcnt(0)" ::: "memory");
        } else {
            XB_SPIN(xb_ld(&bar[XB_XGEN(b.x)]) == gen, bar);
            __builtin_amdgcn_fence(__ATOMIC_ACQUIRE, "agent");
            asm volatile("s_waitcnt vmcnt(0)" ::: "memory");
        }
    }
    __syncthreads();
}

__global__ void __launch_bounds__(512, 2) fwd_megakernel(Params p) {
    extern __shared__ __attribute__((aligned(16))) unsigned char lds_raw[];
    LAS unsigned char* lds = (LAS unsigned char*)lds_raw;
    cg::grid_group grid = cg::this_grid();
    const int G = gridDim.x;
    float* ssb = (float*)(p.ws + WS_SS);
    bf16_t* hb = (bf16_t*)(p.ws + WS_HB);
    bf16_t* act = (bf16_t*)(p.ws + WS_ACT);
    bf16_t* cat = (bf16_t*)(p.ws + WS_CAT);

    volatile LAS unsigned* misc = (volatile LAS unsigned*)(lds + MISC_OFF);
    if (threadIdx.x < 2) misc[threadIdx.x] = 0u;
    __syncthreads();
    const XcdBarrier xbar = xcd_barrier_post((unsigned*)(p.ws + WS_BAR), misc);
#pragma unroll 1
    for (int rep = 0; rep < REP_PRO; ++rep)
    prologue(p, lds, G);
    grid.sync();
#define GRID_BAR() xcd_barrier(xbar)

    for (int st = 0; st < 6; ++st) {
        const int layer = st / 3, sub = st - layer * 3;
        unsigned char* wl = p.ws + WS_W + (size_t)layer * W_LAYER;
        if (sub != 1) {
            const int f = sub >> 1;
            const float* ss_in = ssb + (size_t)(layer * 3 + (f ? 2 : 0)) * MT;
            float* ss_out = ssb + (size_t)(layer * 3 + (f ? 3 : 1)) * MT;
            const bf16_t* wgu = (const bf16_t*)(wl + (f ? W_GU2 : W_GU1));
            const bf16_t* wd = (const bf16_t*)(wl + (f ? W_D2 : W_D1));
            { pg8::Gemm g{hb, wgu, MT, 2 * DFF, DM, DM / 64}; pg8::StaticOrder S; S.init(MT, 2 * DFF, G, (int)blockIdx.x);
              pg8::EpiSwiGLU E{act, ss_in};
#pragma unroll 1
              for (int rep = 0; rep < REP_GU; ++rep)
              pg8::gemm_phase<pg8::EpiSwiGLU, pg8::StaticOrder, true, true>(lds, g, S, E); }
            GRID_BAR();
            { const bool first = (st == 0);
              { pg8::Gemm g{act, wd, MP, DM, DFF, DFF / 64}; pg8::StaticOrder S; S.init(MP, DM, G, (int)blockIdx.x);
                pg8::EpiResid E{hb, (float*)(p.ws + WS_SSP), 0.5f};
                pg8::gemm_phase<pg8::EpiResid, pg8::StaticOrder, true, true>(lds, g, S, E); }
              { pg8::Gemm g{act, wd, MT, DM, DFF, DFF / 256}; pg8::SplitOrder S{(int)blockIdx.x, (DFF / 4) * 2};
                pg8::EpiSlab E{(float*)(p.ws + WS_SLAB), 0.5f, (DFF / 4) * 2};
                pg8::gemm_phase<pg8::EpiSlab, pg8::SplitOrder, true, true>(lds, g, S, E); } }
            GRID_BAR();
            if (st != 5) { sample_fixup(p, G, ss_out); GRID_BAR(); }
        } else {
            const float* ss_in = ssb + (size_t)(layer * 3 + 1) * MT;
            float* ss_out = ssb + (size_t)(layer * 3 + 2) * MT;
            { pg8::Gemm g{hb, (const bf16_t*)(wl + W_IN), MT, DIN, DM, DM / 64}; pg8::StaticOrder S; S.init(MT, DIN, G, (int)blockIdx.x);
              pg8::EpiScaleBf16 E{act, DIN, ss_in};
#pragma unroll 1
              for (int rep = 0; rep < REP_WIN; ++rep)
              pg8::gemm_phase<pg8::EpiScaleBf16, pg8::StaticOrder, true, true>(lds, g, S, E); }
            GRID_BAR();
#pragma unroll 1
            for (int rep = 0; rep < REP_MIX; ++rep)
            mixer_mid(p, lds, G, layer);
            GRID_BAR();
            { pg8::Gemm g{cat, (const bf16_t*)(wl + W_OUT), MP, DM, DM, DM / 64}; pg8::StaticOrder S; S.init(MP, DM, G, (int)blockIdx.x);
              pg8::EpiResid E{hb, (float*)(p.ws + WS_SSP), 1.0f};
              pg8::gemm_phase<pg8::EpiResid, pg8::StaticOrder, true, true>(lds, g, S, E); }
            { pg8::Gemm g{cat, (const bf16_t*)(wl + W_OUT), MT, DM, DM, DM / 256}; pg8::SplitOrder S{(int)blockIdx.x, (DM / 4) * 2};
              pg8::EpiSlab E{(float*)(p.ws + WS_SLAB), 1.0f, (DM / 4) * 2};
              pg8::gemm_phase<pg8::EpiSlab, pg8::SplitOrder, true, true>(lds, g, S, E); }
            GRID_BAR();
            sample_fixup(p, G, ss_out);
            GRID_BAR();
        }
    }
    final_fused(p, G);
}

extern "C" void kernel_launch(void* const* d_in, const int* in_sizes, int n_in, void* d_out, int out_size, void* d_ws, size_t ws_size, hipStream_t stream) {
    static int grid = 0;
    if (grid == 0) {
        if (n_in != 24 || ws_size < WS_END) { fprintf(stderr, "kernel_launch: need 24 inputs and >= %zu bytes of workspace (got %d, %zu)\n", (size_t)WS_END, n_in, ws_size); grid = -1; return; }
        int dev = 0, cus = 0, per_cu = 0;
        hipGetDevice(&dev);
        hipDeviceGetAttribute(&cus, hipDeviceAttributeMultiprocessorCount, dev);
        hipFuncSetAttribute((const void*)fwd_megakernel, hipFuncAttributeMaxDynamicSharedMemorySize, LDS_BYTES);
        hipOccupancyMaxActiveBlocksPerMultiprocessor(&per_cu, (const void*)fwd_megakernel, 512, LDS_BYTES);
        if (per_cu < 1) { fprintf(stderr, "kernel_launch: occupancy query returned %d\n", per_cu); per_cu = 1; }
        grid = cus * per_cu;
    }
    if (grid < 0) return;
    if (hipMemsetAsync((char*)d_ws + WS_BAR, 0, WS_BAR_BYTES, stream) != hipSuccess) { fprintf(stderr, "kernel_launch: memset failed\n"); return; }
    Params p{};
    for (int i = 0; i < 24; ++i) p.in[i] = (const float*)d_in[i];
    p.out = (float*)d_out; p.ws = (unsigned char*)d_ws;
    void* args[] = {&p};
    hipError_t e = hipLaunchCooperativeKernel((void*)fwd_megakernel, dim3(grid), dim3(512), args, LDS_BYTES, stream);
    if (e != hipSuccess) fprintf(stderr, "cooperative launch failed: %s (grid %d)\n", hipGetErrorString(e), grid);
}
```

```cpp
#include <hip/hip_runtime.h>
#include <hip/hip_cooperative_groups.h>
#include <cstdio>
#include <cstdint>
namespace cg = cooperative_groups;

#define LAS __attribute__((address_space(3)))
typedef unsigned short bf16_t;
typedef short bf16x8 __attribute__((ext_vector_type(8)));
typedef float f32x4 __attribute__((ext_vector_type(4)));
typedef float f32x2 __attribute__((ext_vector_type(2)));
typedef unsigned u32x4 __attribute__((ext_vector_type(4)));
typedef unsigned u32x2 __attribute__((ext_vector_type(2)));

constexpr int DM = 2048, DFF = 5632, DIN = 4352, DA = 768, DB = 768, DC = 512;
constexpr int MP = 16384, MS = 512, MT = MP + MS;
constexpr float EPS = 1e-6f;
constexpr size_t MiB = 1u << 20;
constexpr size_t WS_SS = 0, WS_W = 1 * MiB, W_LAYER = 157 * MiB;
constexpr size_t W_GU1 = 0, W_D1 = 44 * MiB, W_IN = 66 * MiB, W_OUT = 83 * MiB, W_GU2 = 91 * MiB, W_D2 = 135 * MiB;
constexpr size_t WS_HB = 315 * MiB, WS_ACT = 381 * MiB, WS_CAT = 563 * MiB, WS_SLAB = 629 * MiB, WS_SSP = 645 * MiB, WS_END = 648 * MiB;
constexpr int OFF_A_P = 34603008, OFF_B_P = OFF_A_P + 6144, OFF_P_P = OFF_B_P + 92160, OFF_A_S = OFF_P_P + 30720, OFF_B_S = OFF_A_S + 24576, OFF_P_S = OFF_B_S + 368640;
#ifndef REP_GU
#define REP_GU 1
#endif
#ifndef REP_WIN
#define REP_WIN 1
#endif
#ifndef REP_MIX
#define REP_MIX 1
#endif
#ifndef REP_PRO
#define REP_PRO 1
#endif
constexpr int LDS_BYTES = 147456, MISC_OFF = 139264;
constexpr size_t WS_BAR = 512 * 1024, WS_BAR_BYTES = 16384;

#define LDS_WAIT() asm volatile("s_waitcnt lgkmcnt(0)" ::: "memory")

__device__ __forceinline__ unsigned cvt_pk_bf16(float lo, float hi) { unsigned r; asm volatile("v_cvt_pk_bf16_f32 %0, %1, %2" : "=v"(r) : "v"(lo), "v"(hi)); return r; }
__device__ __forceinline__ float bf_lo(unsigned w) { return __uint_as_float(w << 16); }
__device__ __forceinline__ float bf_hi(unsigned w) { return __uint_as_float(w & 0xffff0000u); }
__device__ __forceinline__ float sigmoidf_(float x) { return __builtin_amdgcn_rcpf(1.f + __builtin_amdgcn_exp2f(-1.44269504f * x)); }
__device__ __forceinline__ float siluf_(float x) { return x * sigmoidf_(x); }
__device__ __forceinline__ float wave_sum(float v) {
#pragma unroll
    for (int o = 1; o < 64; o <<= 1) v += __shfl_xor(v, o);
    return v;
}

namespace pg8 {
constexpr int BM = 256, BK = 64, HALF = 128, HTB = HALF * BK * 2, STAGE_BYTES = 8 * HTB, NXCD = 8, WGM = 4;
__host__ __device__ __forceinline__ int lds_byte(int r, int c) { const int st = (r >> 4) * 2 + (c >> 5), rr = r & 15, cc = c & 31, ob = rr * 64 + cc * 2; return st * 1024 + (ob ^ (((ob >> 9) & 1) << 5)); }
__host__ __device__ __forceinline__ void stage_rc(int b, int& R, int& C) { const int st = b / 1024, sb = b % 1024, swz = sb ^ (((sb >> 9) & 1) << 5); R = (st >> 1) * 16 + swz / 64; C = (st & 1) * 32 + (swz % 64) / 2; }
__host__ __device__ __forceinline__ int perm32(int rho) { const int n = rho >> 4, i = rho & 15; return 8 * (i >> 2) + 4 * n + (i & 3); }

struct Unit { int pm, pn, kb; };
struct Gemm { const bf16_t* A; const bf16_t* Bt; int M, N, K, nt; };

struct StaticOrder {
    int nM, nN, nwg, G, c;
    __device__ void init(int M, int N, int G_, int c_) { nM = M / BM; nN = N / BM; nwg = nM * nN; G = G_; c = c_; }
    __device__ __forceinline__ bool next(int i, Unit& u) const {
        const long L = (long)i * G + c; if (L >= nwg) return false;
        int wgid = (int)L; { const int q = nwg / NXCD, r = nwg % NXCD, xcd = wgid % NXCD, off = wgid / NXCD; wgid = (xcd < r ? xcd * (q + 1) : r * (q + 1) + (xcd - r) * q) + off; }
        const int nig = WGM * nN, gid = wgid / nig, fm = gid * WGM, gsz = (nM - fm) < WGM ? (nM - fm) : WGM;
        u.pm = fm + ((wgid % nig) % gsz); u.pn = (wgid % nig) / gsz; u.kb = 0; return true;
    }
    __device__ __forceinline__ void a_ready(const Unit&) const {}
    __device__ __forceinline__ void done(const Unit&) const {}
};

struct EpiSwiGLU {
    static constexpr bool PERM = true, AFTER_DRAIN = false, PREF = true;
    bf16_t* O; const float* ss;
    __device__ __forceinline__ void prefetch(const Unit& u, int wr, int fr, float (&sv)[8]) const {
        const int row0 = u.pm * BM + wr * 64 + fr;
#pragma unroll
        for (int ai = 0; ai < 2; ++ai)
#pragma unroll
            for (int m = 0; m < 4; ++m) sv[ai * 4 + m] = ss[row0 + ai * HALF + m * 16];
    }
    __device__ __forceinline__ void operator()(const f32x4 (&acc)[2][2][4][2], const Unit& u, int wr, int wc, int fr, int fq, const float (&sv)[8]) const {
        const int row0 = u.pm * BM + wr * 64 + fr, col0 = u.pn * HALF + wc * 32 + 8 * fq;
#pragma unroll
        for (int ai = 0; ai < 2; ++ai)
#pragma unroll
            for (int m = 0; m < 4; ++m) {
                const int row = row0 + ai * HALF + m * 16;
                const float rinv = __builtin_amdgcn_rsqf(sv[ai * 4 + m] * (1.f / DM) + EPS), rneg = rinv * -1.44269504f, r2 = rinv * rinv;
                const f32x4 g0 = acc[ai][0][m][0], g1 = acc[ai][0][m][1], u0 = acc[ai][1][m][0], u1 = acc[ai][1][m][1];
                f32x4 e0, e1;
#pragma unroll
                for (int j = 0; j < 4; ++j) { e0[j] = __builtin_amdgcn_rcpf(1.f + __builtin_amdgcn_exp2f(g0[j] * rneg)); e1[j] = __builtin_amdgcn_rcpf(1.f + __builtin_amdgcn_exp2f(g1[j] * rneg)); }
                const f32x4 a0 = (g0 * u0) * (e0 * r2), a1 = (g1 * u1) * (e1 * r2);
                u32x4 w;
                w.x = cvt_pk_bf16(a0[0], a0[1]); w.y = cvt_pk_bf16(a0[2], a0[3]); w.z = cvt_pk_bf16(a1[0], a1[1]); w.w = cvt_pk_bf16(a1[2], a1[3]);
                *(u32x4*)(O + (size_t)row * DFF + col0) = w;
            }
    }
};
struct EpiScaleBf16 {
    static constexpr bool PERM = true, AFTER_DRAIN = false, PREF = true;
    bf16_t* O; int ldc; const float* ss;
    __device__ __forceinline__ void prefetch(const Unit& u, int wr, int fr, float (&sv)[8]) const {
        const int row0 = u.pm * BM + wr * 64 + fr;
#pragma unroll
        for (int ai = 0; ai < 2; ++ai)
#pragma unroll
            for (int m = 0; m < 4; ++m) sv[ai * 4 + m] = ss[row0 + ai * HALF + m * 16];
    }
    __device__ __forceinline__ void operator()(const f32x4 (&acc)[2][2][4][2], const Unit& u, int wr, int wc, int fr, int fq, const float (&sv)[8]) const {
        const int row0 = u.pm * BM + wr * 64 + fr, col0 = u.pn * BM + wc * 32 + 8 * fq;
#pragma unroll
        for (int ai = 0; ai < 2; ++ai)
#pragma unroll
            for (int m = 0; m < 4; ++m) {
                const int row = row0 + ai * HALF + m * 16;
                const float rinv = __builtin_amdgcn_rsqf(sv[ai * 4 + m] * (1.f / DM) + EPS);
                bf16_t* rowp = O + (size_t)row * ldc + col0;
#pragma unroll
                for (int bj = 0; bj < 2; ++bj) { const f32x4 v0 = acc[ai][bj][m][0] * rinv, v1 = acc[ai][bj][m][1] * rinv;
                    u32x4 w; w.x = cvt_pk_bf16(v0[0], v0[1]); w.y = cvt_pk_bf16(v0[2], v0[3]); w.z = cvt_pk_bf16(v1[0], v1[1]); w.w = cvt_pk_bf16(v1[2], v1[3]);
                    *(u32x4*)(rowp + bj * HALF) = w; }
            }
    }
};
struct EpiResid {
    static constexpr bool PERM = true, AFTER_DRAIN = false, PREF = false;
    bf16_t* hb; float* ssn; float scale;
    __device__ __forceinline__ void prefetch(const Unit&, int, int, float (&)[8]) const {}
    __device__ __forceinline__ void operator()(const f32x4 (&acc)[2][2][4][2], const Unit& u, int wr, int wc, int fr, int fq, const float (&)[8]) const {
        const int row0 = u.pm * BM + wr * 64 + fr, col0 = u.pn * BM + wc * 32 + 8 * fq;
        bf16_t* bp0 = hb + (size_t)row0 * DM + col0;
        u32x4 b[2][4][2];
#pragma unroll
        for (int ai = 0; ai < 2; ++ai)
#pragma unroll
            for (int m = 0; m < 4; ++m)
#pragma unroll
                for (int bj = 0; bj < 2; ++bj) b[ai][m][bj] = *(const u32x4*)(bp0 + (size_t)(ai * HALF + m * 16) * DM + bj * HALF);
#pragma unroll
        for (int ai = 0; ai < 2; ++ai) {
#pragma unroll
            for (int m = 0; m < 4; ++m) {
                const int row = row0 + ai * HALF + m * 16;
                float s = 0.f;
#pragma unroll
                for (int bj = 0; bj < 2; ++bj) { const u32x4 bb = b[ai][m][bj];
                    const f32x4 b0 = (f32x4){bf_lo(bb.x), bf_hi(bb.x), bf_lo(bb.y), bf_hi(bb.y)}, b1 = (f32x4){bf_lo(bb.z), bf_hi(bb.z), bf_lo(bb.w), bf_hi(bb.w)};
                    const f32x4 h0 = b0 + acc[ai][bj][m][0] * scale, h1 = b1 + acc[ai][bj][m][1] * scale;
                    u32x4 w; w.x = cvt_pk_bf16(h0[0], h0[1]); w.y = cvt_pk_bf16(h0[2], h0[3]); w.z = cvt_pk_bf16(h1[0], h1[1]); w.w = cvt_pk_bf16(h1[2], h1[3]);
                    *(u32x4*)(bp0 + (size_t)(ai * HALF + m * 16) * DM + bj * HALF) = w;
                    const f32x4 r0 = (f32x4){bf_lo(w.x), bf_hi(w.x), bf_lo(w.y), bf_hi(w.y)}, r1 = (f32x4){bf_lo(w.z), bf_hi(w.z), bf_lo(w.w), bf_hi(w.w)};
                    s += (r0[0] * r0[0] + r0[1] * r0[1]) + (r0[2] * r0[2] + r0[3] * r0[3]) + (r1[0] * r1[0] + r1[1] * r1[1]) + (r1[2] * r1[2] + r1[3] * r1[3]); }
                s += __shfl_xor(s, 16); s += __shfl_xor(s, 32);
                if (fq == 0) ssn[(size_t)row * 32 + u.pn * 4 + wc] = s;
            }
        }
    }
};

struct SplitOrder {
    int c, kslice;
    __device__ __forceinline__ bool next(int i, Unit& u) const {
        if (i != 0 || c >= 64) return false;
        u.pm = 64 + (c & 1); u.pn = (c >> 1) & 7; u.kb = (c >> 4) * kslice; return true;
    }
    __device__ __forceinline__ void a_ready(const Unit&) const {}
    __device__ __forceinline__ void done(const Unit&) const {}
};
struct EpiSlab {
    static constexpr bool PERM = true, AFTER_DRAIN = false;
    static constexpr bool PREF = false;
    float* slab; float scale; int kslice;
    __device__ __forceinline__ void prefetch(const Unit&, int, int, float (&)[8]) const {}
    __device__ __forceinline__ void operator()(const f32x4 (&acc)[2][2][4][2], const Unit& u, int wr, int wc, int fr, int fq, const float (&)[8]) const {
        const int row0 = (u.pm - 64) * BM + wr * 64 + fr, col0 = u.pn * BM + wc * 32 + 8 * fq;
        float* sp = slab + (size_t)(u.kb / kslice) * (MS * DM);
#pragma unroll
        for (int ai = 0; ai < 2; ++ai)
#pragma unroll
            for (int m = 0; m < 4; ++m) { float* rp = sp + (size_t)(row0 + ai * HALF + m * 16) * DM + col0;
#pragma unroll
                for (int bj = 0; bj < 2; ++bj)
#pragma unroll
                    for (int n = 0; n < 2; ++n) *(f32x4*)(rp + bj * HALF + n * 4) = acc[ai][bj][m][n] * scale; }
    }
};

template <class Epi, class Sched, bool ALIGN_EPI = false, bool SP2 = false>
__device__ __forceinline__ void gemm_phase(LAS unsigned char* lds, const Gemm g, const Sched& S, const Epi& E) {
    int tid = threadIdx.x; asm volatile("" : "+v"(tid));
    const int wid = __builtin_amdgcn_readfirstlane(tid >> 6), lane = tid & 63, wr = wid >> 2, wc = wid & 3, fr = lane & 15, fq = lane >> 4;
    const int K = g.K, nt = g.nt;
    unsigned voffA[2], voffB[2];
#pragma unroll
    for (int i = 0; i < 2; ++i) { int R, C; stage_rc(tid * 16 + i * 8192, R, C); const int Rb = Epi::PERM ? ((R & ~31) + perm32(R & 31)) : R;
        voffA[i] = (unsigned)(R * K + C) * 2u; voffB[i] = (unsigned)(Rb * K + C) * 2u; }
    const size_t kstep = (size_t)(BK * 2);
    const size_t hstep = (size_t)HALF * K * 2;
    const size_t tstep = 2 * hstep;
    const unsigned ldsw = (unsigned)wid * 1024u;
    const int aoff = lds_byte(wr * 64 + fr, fq * 8), boff = lds_byte(wc * 32 + fr, fq * 8);
#define PG8_SA(b, h) (((b) * 2 + (h)) * HTB)
#define PG8_SB(b, h) ((4 + (b) * 2 + (h)) * HTB)
#define PG8_STAGE(bufoff, gbase, voff) do { _Pragma("unroll") for (int _i = 0; _i < 2; ++_i) \
        __builtin_amdgcn_global_load_lds((const unsigned*)((const char*)(gbase) + (voff)[_i]), (LAS unsigned*)(lds + (bufoff) + ldsw + _i * 8192), 16, 0, 0); } while (0)
#define PG8_LDA(dst, b, h) do { _Pragma("unroll") for (int m = 0; m < 4; ++m) _Pragma("unroll") for (int k = 0; k < 2; ++k) dst[m][k] = *(const LAS bf16x8*)(lds + PG8_SA(b, h) + aoff + m * 2048 + k * 1024); } while (0)
#define PG8_LDB(dst, b, h) do { _Pragma("unroll") for (int n = 0; n < 2; ++n) _Pragma("unroll") for (int k = 0; k < 2; ++k) dst[n][k] = *(const LAS bf16x8*)(lds + PG8_SB(b, h) + boff + n * 2048 + k * 1024); } while (0)
#define PG8_MMA(ai, bj, At, Bt) do { __builtin_amdgcn_s_setprio(1); _Pragma("unroll") for (int m = 0; m < 4; ++m) _Pragma("unroll") for (int n = 0; n < 2; ++n) _Pragma("unroll") for (int k = 0; k < 2; ++k) \
        acc[ai][bj][m][n] = __builtin_amdgcn_mfma_f32_16x16x32_bf16(Bt[n][k], At[m][k], acc[ai][bj][m][n], 0, 0, 0); __builtin_amdgcn_s_setprio(0); } while (0)
#define PG8_WAIT_V(n) asm volatile("s_waitcnt vmcnt(" #n ")" ::: "memory")
#define PG8_WAIT_L(n) asm volatile("s_waitcnt lgkmcnt(" #n ")" ::: "memory")
#define PG8_BAR __builtin_amdgcn_s_barrier()
#define PG8_SCHED __builtin_amdgcn_sched_barrier(0)
    Unit cur, nxt; int ui = 0;
    if (!S.next(0, cur)) return;
    f32x4 acc[2][2][4][2];
#pragma unroll
    for (int a = 0; a < 2; ++a)
#pragma unroll
        for (int b = 0; b < 2; ++b)
#pragma unroll
            for (int m = 0; m < 4; ++m)
#pragma unroll
                for (int n = 0; n < 2; ++n) acc[a][b][m][n] = (f32x4){0.f, 0.f, 0.f, 0.f};
    bf16x8 At[4][2], B0[2][2], B1[2][2];
    const char* cA = (const char*)g.A + (size_t)cur.pm * tstep + cur.kb; const char* cB = (const char*)g.Bt + (size_t)cur.pn * tstep + cur.kb;
    S.a_ready(cur);
    float sv[8];
#define PG8_SS_DMA(u, buf) do { if constexpr (Epi::PREF) { if (wid == 0) __builtin_amdgcn_global_load_lds((const unsigned*)(E.ss + (size_t)(u).pm * BM + 4 * lane), (LAS unsigned*)(lds + STAGE_BYTES + (buf) * 1024), 16, 0, 0); } } while (0)
    PG8_SS_DMA(cur, 0);
    if constexpr (SP2) {
        PG8_STAGE(PG8_SB(0, 0), cB, voffB); PG8_STAGE(PG8_SB(0, 1), cB + hstep, voffB); PG8_STAGE(PG8_SA(0, 0), cA, voffA); PG8_STAGE(PG8_SA(0, 1), cA + hstep, voffA);
        if (wr == 1) PG8_BAR;
        PG8_WAIT_V(2); PG8_BAR;
        PG8_STAGE(PG8_SB(1, 0), cB + kstep, voffB); PG8_STAGE(PG8_SA(1, 0), cA + kstep, voffA); PG8_STAGE(PG8_SB(1, 1), cB + hstep + kstep, voffB);
        PG8_WAIT_V(6); PG8_BAR;
    } else {
        PG8_STAGE(PG8_SB(0, 0), cB, voffB); PG8_STAGE(PG8_SA(0, 0), cA, voffA); PG8_STAGE(PG8_SB(0, 1), cB + hstep, voffB); PG8_STAGE(PG8_SA(0, 1), cA + hstep, voffA);
        if (wr == 1) PG8_BAR;
        PG8_WAIT_V(4); PG8_BAR;
        PG8_STAGE(PG8_SB(1, 0), cB + kstep, voffB); PG8_STAGE(PG8_SA(1, 0), cA + kstep, voffA); PG8_STAGE(PG8_SB(1, 1), cB + hstep + kstep, voffB);
        PG8_WAIT_V(6); PG8_BAR;
    }
    for (;;) {
        const bool has_next = S.next(ui + 1, nxt);
        const char* nA = has_next ? (const char*)g.A + (size_t)nxt.pm * tstep + nxt.kb : cA; const char* nB = has_next ? (const char*)g.Bt + (size_t)nxt.pn * tstep + nxt.kb : cB;
        for (int t = 0; t < nt; t += 2) {
            const bool last = (t == nt - 2);
            const char* a1 = cA + (size_t)(t + 1) * kstep;
            const char* a2 = last ? nA : cA + (size_t)(t + 2) * kstep; const char* b2 = last ? nB : cB + (size_t)(t + 2) * kstep;
            const char* a3 = a2 + kstep; const char* b3 = b2 + kstep;
            if (last && has_next) S.a_ready(nxt);
            if constexpr (SP2) {
            PG8_LDB(B0, 0, 0); PG8_LDB(B1, 0, 1); PG8_SCHED; PG8_LDA(At, 0, 0); PG8_STAGE(PG8_SA(1, 1), a1 + hstep, voffA);
            PG8_WAIT_V(8); PG8_WAIT_L(0); PG8_BAR; PG8_MMA(0, 0, At, B0); PG8_MMA(0, 1, At, B1); PG8_BAR; PG8_SCHED;
            PG8_LDA(At, 0, 1); PG8_STAGE(PG8_SB(0, 0), b2, voffB); PG8_STAGE(PG8_SB(0, 1), b2 + hstep, voffB); PG8_STAGE(PG8_SA(0, 0), a2, voffA);
            PG8_WAIT_V(8); PG8_WAIT_L(0); PG8_BAR; PG8_MMA(1, 0, At, B0); PG8_MMA(1, 1, At, B1); PG8_BAR; PG8_SCHED;
            PG8_LDB(B0, 1, 0); PG8_LDB(B1, 1, 1); PG8_SCHED; PG8_LDA(At, 1, 0); PG8_STAGE(PG8_SA(0, 1), a2 + hstep, voffA);
            PG8_WAIT_V(8); PG8_WAIT_L(0); PG8_BAR; PG8_MMA(0, 0, At, B0); PG8_MMA(0, 1, At, B1); PG8_BAR; PG8_SCHED;
            PG8_LDA(At, 1, 1); PG8_STAGE(PG8_SB(1, 0), b3, voffB); PG8_STAGE(PG8_SB(1, 1), b3 + hstep, voffB); PG8_STAGE(PG8_SA(1, 0), a3, voffA);
            PG8_WAIT_V(8); PG8_WAIT_L(0); PG8_BAR; PG8_MMA(1, 0, At, B0); PG8_MMA(1, 1, At, B1); PG8_BAR; PG8_SCHED;
            } else {
            PG8_LDB(B0, 0, 0); PG8_SCHED; PG8_LDA(At, 0, 0); PG8_STAGE(PG8_SA(1, 1), a1 + hstep, voffA);
            PG8_WAIT_L(8); PG8_BAR; PG8_WAIT_L(0); PG8_MMA(0, 0, At, B0); PG8_BAR; PG8_SCHED;
            PG8_LDB(B1, 0, 1); PG8_STAGE(PG8_SB(0, 0), b2, voffB);
            PG8_BAR; PG8_WAIT_L(0); PG8_MMA(0, 1, At, B1); PG8_BAR;
            PG8_LDA(At, 0, 1); PG8_STAGE(PG8_SA(0, 0), a2, voffA);
            PG8_BAR; PG8_WAIT_L(0); PG8_MMA(1, 0, At, B0); PG8_BAR; PG8_SCHED;
            PG8_STAGE(PG8_SB(0, 1), b2 + hstep, voffB);
            PG8_WAIT_V(6); PG8_BAR; PG8_MMA(1, 1, At, B1); PG8_BAR;
            PG8_LDB(B0, 1, 0); PG8_SCHED; PG8_LDA(At, 1, 0); PG8_STAGE(PG8_SA(0, 1), a2 + hstep, voffA);
            PG8_WAIT_L(8); PG8_BAR; PG8_WAIT_L(0); PG8_MMA(0, 0, At, B0); PG8_BAR; PG8_SCHED;
            PG8_LDB(B1, 1, 1); PG8_STAGE(PG8_SB(1, 0), b3, voffB);
            PG8_BAR; PG8_WAIT_L(0); PG8_MMA(0, 1, At, B1); PG8_BAR;
            PG8_LDA(At, 1, 1); PG8_STAGE(PG8_SA(1, 0), a3, voffA);
            PG8_BAR; PG8_WAIT_L(0); PG8_MMA(1, 0, At, B0); PG8_BAR; PG8_SCHED;
            PG8_STAGE(PG8_SB(1, 1), b3 + hstep, voffB);
            PG8_WAIT_V(6); PG8_BAR; PG8_MMA(1, 1, At, B1); PG8_BAR;
            }
        }
        if constexpr (ALIGN_EPI) { if (wr == 0) PG8_BAR; }
        if constexpr (Epi::PREF) {
#pragma unroll
            for (int ai = 0; ai < 2; ++ai)
#pragma unroll
                for (int m = 0; m < 4; ++m) sv[ai * 4 + m] = *(const LAS float*)(lds + STAGE_BYTES + (ui & 1) * 1024 + 4 * (ai * HALF + wr * 64 + m * 16 + fr));
        }
        if constexpr (!Epi::AFTER_DRAIN) { E(acc, cur, wr, wc, fr, fq, sv); S.done(cur); }
        if (!has_next) break;
#pragma unroll
        for (int a = 0; a < 2; ++a)
#pragma unroll
            for (int b = 0; b < 2; ++b)
#pragma unroll
                for (int m = 0; m < 4; ++m)
#pragma unroll
                    for (int n = 0; n < 2; ++n) acc[a][b][m][n] = (f32x4){0.f, 0.f, 0.f, 0.f};
        cur = nxt; cA = nA; cB = nB; ++ui;
        PG8_SS_DMA(cur, ui & 1);
        if constexpr (ALIGN_EPI) { if (wr == 1) PG8_BAR; }
    }
    PG8_WAIT_V(0);
    if constexpr (!ALIGN_EPI) { if (wr == 0) PG8_BAR; }
    PG8_BAR;
#undef PG8_SS_DMA
#undef PG8_SA
#undef PG8_SB
#undef PG8_STAGE
#undef PG8_LDA
#undef PG8_LDB
#undef PG8_MMA
#undef PG8_WAIT_V
#undef PG8_WAIT_L
#undef PG8_BAR
#undef PG8_SCHED
}
}

struct Params { const float* in[24]; float* out; unsigned char* ws; };
enum { I_XP = 0, I_XS, I_CA, I_CB, I_CP, I_N1, I_WG1, I_WU1, I_WD1, I_NM, I_WIN, I_CAW, I_CBW, I_CBB, I_LNG, I_LNB, I_PW, I_PS, I_WOUT, I_N2, I_WG2, I_WU2, I_WD2, I_NF };

__device__ __forceinline__ void tr_item(const float* W, int N, const float* gk, bf16_t* WT, int ldk, int drow0, int k0, int n0, LAS float* scr, int lane) {
    const int l16 = lane & 15, kq = lane >> 4;
    f32x4 v[16];
#pragma unroll
    for (int i = 0; i < 16; ++i) v[i] = *(const f32x4*)(W + (size_t)(k0 + 4 * i + kq) * N + n0 + 4 * l16);
    if (gk) {
#pragma unroll
        for (int i = 0; i < 16; ++i) v[i] = v[i] * gk[k0 + 4 * i + kq]; }
#pragma unroll
    for (int i = 0; i < 16; ++i) { LAS float* d = scr + (4 * i + kq) * 65 + 4 * l16; d[0] = v[i][0]; d[1] = v[i][1]; d[2] = v[i][2]; d[3] = v[i][3]; }
    LDS_WAIT(); asm volatile("" ::: "memory");
    const int c = lane & 7;
#pragma unroll
    for (int j = 0; j < 8; ++j) { const int n = (lane >> 3) + 8 * j; const LAS float* s = scr + (8 * c) * 65 + n;
        u32x4 o; o.x = cvt_pk_bf16(s[0 * 65], s[1 * 65]); o.y = cvt_pk_bf16(s[2 * 65], s[3 * 65]); o.z = cvt_pk_bf16(s[4 * 65], s[5 * 65]); o.w = cvt_pk_bf16(s[6 * 65], s[7 * 65]);
        *(u32x4*)(WT + (size_t)(drow0 + n) * ldk + k0 + 8 * c) = o; }
    LDS_WAIT(); asm volatile("" ::: "memory");
}

__device__ __forceinline__ void prologue(const Params& p, LAS unsigned char* lds, int G) {
    const int tid = threadIdx.x, lane = tid & 63, wave = __builtin_amdgcn_readfirstlane(tid >> 6);
    const int gw = blockIdx.x * 8 + wave, NGW = G * 8;
    float* ss = (float*)(p.ws + WS_SS);
    for (int b = blockIdx.x; b < 256; b += G) {
        const int layer = b >> 7, g = (b >> 5) & 3, n0 = (b & 31) * 64;
        LAS float* Bs = (LAS float*)lds;
        LAS float* As = (LAS float*)(lds + 32768);
        const float* wo = p.in[I_WOUT] + (size_t)layer * DM * DM + (size_t)(1536 + g * 128) * DM + n0;
        const float* ps = p.in[I_PS] + layer * DC + g * 128;
        const float* pw = p.in[I_PW] + (size_t)(layer * 4 + g) * 128 * 128;
#pragma unroll
        for (int i = 0; i < 4; ++i) { const int e = (i * 512 + tid) * 4, d = e >> 6, n = e & 63; const f32x4 v = *(const f32x4*)(wo + (size_t)d * DM + n) * ps[d]; *(LAS f32x4*)(Bs + d * 64 + n) = v; }
#pragma unroll
        for (int i = 0; i < 8; ++i) { const int e = (i * 512 + tid) * 4, c = e >> 7, d = e & 127; const f32x4 v = *(const f32x4*)(pw + e); LAS float* dp = As + c * 129 + d; dp[0] = v[0]; dp[1] = v[1]; dp[2] = v[2]; dp[3] = v[3]; }
        __syncthreads();
        float a[16];
#pragma unroll
        for (int i = 0; i < 16; ++i) a[i] = 0.f;
        for (int d = 0; d < 128; ++d) { const float bv = Bs[d * 64 + lane];
#pragma unroll
            for (int i = 0; i < 16; ++i) a[i] += As[(wave * 16 + i) * 129 + d] * bv; }
        bf16_t* dst = (bf16_t*)(p.ws + WS_W + (size_t)layer * W_LAYER + W_OUT) + (size_t)(n0 + lane) * DM + 1536 + g * 128 + wave * 16;
        u32x4 o0, o1;
        o0.x = cvt_pk_bf16(a[0], a[1]); o0.y = cvt_pk_bf16(a[2], a[3]); o0.z = cvt_pk_bf16(a[4], a[5]); o0.w = cvt_pk_bf16(a[6], a[7]);
        o1.x = cvt_pk_bf16(a[8], a[9]); o1.y = cvt_pk_bf16(a[10], a[11]); o1.z = cvt_pk_bf16(a[12], a[13]); o1.w = cvt_pk_bf16(a[14], a[15]);
        *(u32x4*)dst = o0; *(u32x4*)(dst + 8) = o1;
        __syncthreads();
    }
    LAS float* scr = (LAS float*)(lds + wave * 16640);
    constexpr int PER_LAYER = 2816 * 6 + 2176 + 768;
#pragma unroll 1
    for (int it = gw; it < 2 * PER_LAYER; it += NGW) {
        const int layer = it >= PER_LAYER ? 1 : 0; int r = it - layer * PER_LAYER;
        unsigned char* wl = p.ws + WS_W + (size_t)layer * W_LAYER;
        const float* W; const float* gk = nullptr; bf16_t* WT; int N, ldk, nnb, kind = 0;
        if (r < 2816) { W = p.in[I_WG1] + (size_t)layer * DM * DFF; gk = p.in[I_N1] + layer * DM; WT = (bf16_t*)(wl + W_GU1); N = DFF; ldk = DM; nnb = 88; kind = 1; }
        else if ((r -= 2816) < 2816) { W = p.in[I_WU1] + (size_t)layer * DM * DFF; gk = p.in[I_N1] + layer * DM; WT = (bf16_t*)(wl + W_GU1); N = DFF; ldk = DM; nnb = 88; kind = 2; }
        else if ((r -= 2816) < 2816) { W = p.in[I_WD1] + (size_t)layer * DFF * DM; WT = (bf16_t*)(wl + W_D1); N = DM; ldk = DFF; nnb = 32; }
        else if ((r -= 2816) < 2176) { W = p.in[I_WIN] + (size_t)layer * DM * DIN; gk = p.in[I_NM] + layer * DM; WT = (bf16_t*)(wl + W_IN); N = DIN; ldk = DM; nnb = 68; }
        else if ((r -= 2176) < 768) { W = p.in[I_WOUT] + (size_t)layer * DM * DM; WT = (bf16_t*)(wl + W_OUT); N = DM; ldk = DM; nnb = 32; }
        else if ((r -= 768) < 2816) { W = p.in[I_WG2] + (size_t)layer * DM * DFF; gk = p.in[I_N2] + layer * DM; WT = (bf16_t*)(wl + W_GU2); N = DFF; ldk = DM; nnb = 88; kind = 1; }
        else if ((r -= 2816) < 2816) { W = p.in[I_WU2] + (size_t)layer * DM * DFF; gk = p.in[I_N2] + layer * DM; WT = (bf16_t*)(wl + W_GU2); N = DFF; ldk = DM; nnb = 88; kind = 2; }
        else { r -= 2816; W = p.in[I_WD2] + (size_t)layer * DFF * DM; WT = (bf16_t*)(wl + W_D2); N = DM; ldk = DFF; nnb = 32; }
        const int kb = r / nnb, nb = r - kb * nnb, k0 = kb * 64, n0 = nb * 64;
        const int drow0 = kind ? ((n0 >> 7) * 256 + (kind - 1) * 128 + (n0 & 127)) : n0;
        tr_item(W, N, gk, WT, ldk, drow0, k0, n0, scr, lane);
    }
    bf16_t* hb = (bf16_t*)(p.ws + WS_HB);
    for (int m = gw; m < MT; m += NGW) {
        const float* xr = (m < MP) ? p.in[I_XP] + (size_t)m * DM : p.in[I_XS] + (size_t)(m - MP) * DM;
        float s = 0.f;
#pragma unroll
        for (int j = 0; j < 4; ++j) { const f32x4 v0 = *(const f32x4*)(xr + j * 512 + lane * 8), v1 = *(const f32x4*)(xr + j * 512 + lane * 8 + 4);
            s += (v0[0] * v0[0] + v0[1] * v0[1]) + (v0[2] * v0[2] + v0[3] * v0[3]) + (v1[0] * v1[0] + v1[1] * v1[1]) + (v1[2] * v1[2] + v1[3] * v1[3]);
            u32x4 w; w.x = cvt_pk_bf16(v0[0], v0[1]); w.y = cvt_pk_bf16(v0[2], v0[3]); w.z = cvt_pk_bf16(v1[0], v1[1]); w.w = cvt_pk_bf16(v1[2], v1[3]);
            *(u32x4*)(hb + (size_t)m * DM + j * 512 + lane * 8) = w; }
        s = wave_sum(s);
        if (lane == 0) ss[m] = s;
    }
}

__device__ __forceinline__ void ld8_bf16(const bf16_t* p, float (&v)[8]) {
    const u32x4 w = *(const u32x4*)p;
    v[0] = bf_lo(w.x); v[1] = bf_hi(w.x); v[2] = bf_lo(w.y); v[3] = bf_hi(w.y); v[4] = bf_lo(w.z); v[5] = bf_hi(w.z); v[6] = bf_lo(w.w); v[7] = bf_hi(w.w);
}
__device__ __forceinline__ void ld8_f32(const float* p, float (&v)[8]) {
    const f32x4 a = *(const f32x4*)p, b = *(const f32x4*)(p + 4);
    v[0] = a[0]; v[1] = a[1]; v[2] = a[2]; v[3] = a[3]; v[4] = b[0]; v[5] = b[1]; v[6] = b[2]; v[7] = b[3];
}
__device__ __forceinline__ void st8_f32(float* p, const float (&v)[8]) {
    *(f32x4*)p = (f32x4){v[0], v[1], v[2], v[3]}; *(f32x4*)(p + 4) = (f32x4){v[4], v[5], v[6], v[7]};
}
__device__ __forceinline__ void st8_bf16(bf16_t* p, const float (&v)[8]) {
    u32x4 w; w.x = cvt_pk_bf16(v[0], v[1]); w.y = cvt_pk_bf16(v[2], v[3]); w.z = cvt_pk_bf16(v[4], v[5]); w.w = cvt_pk_bf16(v[6], v[7]);
    *(u32x4*)p = w;
}

constexpr int TOK = 16, HALO = 30, VROWS = TOK + HALO, CH = 384;
__device__ __forceinline__ void mixer_mid(const Params& p, LAS unsigned char* lds, int G, int layer) {
    int tid = threadIdx.x; asm volatile("" : "+v"(tid));
    const int lane = tid & 63, wave = __builtin_amdgcn_readfirstlane(tid >> 6);
    LAS float* vt = (LAS float*)lds;
    LAS float* cb = (LAS float*)(lds + VROWS * CH * 4);
    const bf16_t* z = (const bf16_t*)(p.ws + WS_ACT);
    bf16_t* cat = (bf16_t*)(p.ws + WS_CAT);
    const float* caw = p.in[I_CAW] + layer * 3 * DA;
    const float* cbw = p.in[I_CBW] + layer * 31 * DB;
    const float* cbb = p.in[I_CBB] + layer * DB;
    const float* lng = p.in[I_LNG] + layer * DB;
    const float* lnb = p.in[I_LNB] + layer * DB;
    for (int ch = blockIdx.x; ch < MT / TOK; ch += G) {
        const bool samp = ch >= MP / TOK;
        int seq, l0, L;
        if (!samp) { seq = ch >> 9; l0 = (ch & 511) * TOK; L = 8192; } else { const int cs = ch - MP / TOK; seq = cs >> 2; l0 = (cs & 3) * TOK; L = 64; }
        const int row0 = ch * TOK;
        const bool lastc = (l0 + TOK == L), fast = (l0 >= 32);
        const float* hist_a = p.in[I_CA] + (size_t)(layer * 8 + seq) * 2 * DA;
        const float* hist_b = p.in[I_CB] + (size_t)(layer * 8 + seq) * 30 * DB;
        const float* hist_p = p.in[I_CP] + (size_t)(layer * 8 + seq) * 15 * DC;
        float* out_a = p.out + (samp ? OFF_A_S + (layer * 8 + seq) * 2 * DA : OFF_A_P + (layer * 2 + seq) * 2 * DA);
        float* out_b = p.out + (samp ? OFF_B_S + (layer * 8 + seq) * 30 * DB : OFF_B_P + (layer * 2 + seq) * 30 * DB);
        float* out_p = p.out + (samp ? OFF_P_S + (layer * 8 + seq) * 15 * DC : OFF_P_P + (layer * 2 + seq) * 15 * DC);
        u32x4 ra[5], rg[5];
#define MIX_VLOAD(hc_) do { _Pragma("unroll") for (int i = 0; i < 5; ++i) { const int it = tid + 512 * i; if (it < VROWS * (CH / 8)) { const int j = it / (CH / 8), cl = (it - j * (CH / 8)) * 8; \
            const bf16_t* zr = z + (size_t)(row0 - HALO + j) * DIN + (hc_) * CH + cl; ra[i] = *(const u32x4*)(zr + 2304); rg[i] = *(const u32x4*)(zr + 3072); } } } while (0)
        if (fast) MIX_VLOAD(0);
#pragma unroll 1
        for (int hc = 0; hc < 2; ++hc) {
            if (fast) {
#pragma unroll
                for (int i = 0; i < 5; ++i) { const int it = tid + 512 * i; if (it < VROWS * (CH / 8)) { const int j = it / (CH / 8), cl = (it - j * (CH / 8)) * 8, c8 = hc * CH + cl;
                    float v[8];
                    v[0] = bf_lo(ra[i].x) * sigmoidf_(bf_lo(rg[i].x)); v[1] = bf_hi(ra[i].x) * sigmoidf_(bf_hi(rg[i].x));
                    v[2] = bf_lo(ra[i].y) * sigmoidf_(bf_lo(rg[i].y)); v[3] = bf_hi(ra[i].y) * sigmoidf_(bf_hi(rg[i].y));
                    v[4] = bf_lo(ra[i].z) * sigmoidf_(bf_lo(rg[i].z)); v[5] = bf_hi(ra[i].z) * sigmoidf_(bf_hi(rg[i].z));
                    v[6] = bf_lo(ra[i].w) * sigmoidf_(bf_lo(rg[i].w)); v[7] = bf_hi(ra[i].w) * sigmoidf_(bf_hi(rg[i].w));
                    *(LAS f32x4*)(vt + j * CH + cl) = (f32x4){v[0], v[1], v[2], v[3]}; *(LAS f32x4*)(vt + j * CH + cl + 4) = (f32x4){v[4], v[5], v[6], v[7]};
                    if (lastc && j >= TOK) st8_f32(out_b + (size_t)(j - TOK) * DB + c8, v); } }
                if (hc == 0) MIX_VLOAD(1);
            } else
#pragma unroll 1
            for (int it = tid; it < VROWS * (CH / 8); it += 512) {
                const int j = it / (CH / 8), cl = (it - j * (CH / 8)) * 8, c8 = hc * CH + cl, l = l0 - HALO + j;
                float v[8];
                if (l >= 0) { const bf16_t* zr = z + (size_t)(row0 - HALO + j) * DIN; float a[8], g[8]; ld8_bf16(zr + 2304 + c8, a); ld8_bf16(zr + 3072 + c8, g);
#pragma unroll
                    for (int i = 0; i < 8; ++i) v[i] = a[i] * sigmoidf_(g[i]); }
                else if (samp) ld8_f32(hist_b + (size_t)(30 + l) * DB + c8, v);
                else {
#pragma unroll
                    for (int i = 0; i < 8; ++i) v[i] = 0.f; }
                *(LAS f32x4*)(vt + j * CH + cl) = (f32x4){v[0], v[1], v[2], v[3]}; *(LAS f32x4*)(vt + j * CH + cl + 4) = (f32x4){v[4], v[5], v[6], v[7]};
                if (lastc && j >= TOK) st8_f32(out_b + (size_t)(j - TOK) * DB + c8, v);
            }
            __syncthreads();
            if (tid < CH) {
                const int c = hc * CH + tid;
                float wv[31];
#pragma unroll
                for (int k = 0; k < 31; ++k) wv[k] = cbw[k * DB + c];
                const float bias = cbb[c];
                float o[TOK];
#pragma unroll
                for (int i = 0; i < TOK; ++i) o[i] = bias;
                const LAS float* vp = vt + tid;
#pragma unroll
                for (int jj = 0; jj < VROWS; ++jj) { const float x = vp[jj * CH];
#pragma unroll
                    for (int i = 0; i < TOK; ++i) { if (jj - i >= 0 && jj - i <= 30) o[i] += wv[(jj - i >= 0 && jj - i <= 30) ? jj - i : 0] * x; } }
#pragma unroll
                for (int i = 0; i < TOK; ++i) cb[i * DB + c] = o[i];
            }
            __syncthreads();
        }
#pragma unroll 1
        for (int tt = 0; tt < 2; ++tt) { const int tk = wave * 2 + tt; f32x2 x[6]; float s = 0.f;
#pragma unroll
            for (int i = 0; i < 6; ++i) { x[i] = *(const LAS f32x2*)(cb + tk * DB + 128 * i + 2 * lane); s += x[i].x + x[i].y; }
            const float mean = wave_sum(s) * (1.f / DB); float q2 = 0.f;
#pragma unroll
            for (int i = 0; i < 6; ++i) { x[i].x -= mean; x[i].y -= mean; q2 += x[i].x * x[i].x + x[i].y * x[i].y; }
            const float rstd = __builtin_amdgcn_rsqf(wave_sum(q2) * (1.f / DB) + EPS);
#pragma unroll
            for (int i = 0; i < 6; ++i) { const int c = 128 * i + 2 * lane; const f32x2 gg = *(const f32x2*)(lng + c), bb = *(const f32x2*)(lnb + c);
                const float y0 = siluf_(x[i].x * rstd * gg.x + bb.x), y1 = siluf_(x[i].y * rstd * gg.y + bb.y);
                *(unsigned*)(cat + (size_t)(row0 + tk) * DM + DA + c) = cvt_pk_bf16(y0, y1); } }
        if (fast) {
#pragma unroll 1
            for (int i = 0; i < 3; ++i) { const int it = tid + 512 * i, tk = it / 96, c8 = (it - tk * 96) * 8; const size_t row = row0 + tk; const bf16_t* zr = z + row * DIN + c8;
                u32x4 qa[3], qc[3], qb;
#pragma unroll
                for (int q = 0; q < 3; ++q) { qa[q] = *(const u32x4*)(zr - (2 - q) * DIN); qc[q] = *(const u32x4*)(zr - (2 - q) * DIN + 1536); }
                qb = *(const u32x4*)(zr + 768);
                float y[8], t[8], w[8];
#pragma unroll
                for (int e = 0; e < 8; ++e) y[e] = 0.f;
#pragma unroll
                for (int q = 0; q < 3; ++q) { ld8_f32(caw + q * DA + c8, w);
                    t[0] = bf_lo(qa[q].x) * bf_lo(qc[q].x); t[1] = bf_hi(qa[q].x) * bf_hi(qc[q].x); t[2] = bf_lo(qa[q].y) * bf_lo(qc[q].y); t[3] = bf_hi(qa[q].y) * bf_hi(qc[q].y);
                    t[4] = bf_lo(qa[q].z) * bf_lo(qc[q].z); t[5] = bf_hi(qa[q].z) * bf_hi(qc[q].z); t[6] = bf_lo(qa[q].w) * bf_lo(qc[q].w); t[7] = bf_hi(qa[q].w) * bf_hi(qc[q].w);
#pragma unroll
                    for (int e = 0; e < 8; ++e) y[e] += w[e] * t[e]; }
                y[0] *= bf_lo(qb.x); y[1] *= bf_hi(qb.x); y[2] *= bf_lo(qb.y); y[3] *= bf_hi(qb.y); y[4] *= bf_lo(qb.z); y[5] *= bf_hi(qb.z); y[6] *= bf_lo(qb.w); y[7] *= bf_hi(qb.w);
                st8_bf16(cat + row * DM + c8, y);
                if (lastc && tk >= TOK - 2) st8_f32(out_a + (size_t)(tk - (TOK - 2)) * DA + c8, t); }
#pragma unroll 1
            for (int i = 0; i < 2; ++i) { const int it = tid + 512 * i, tk = it >> 6, c8 = (it & 63) * 8; const size_t row = row0 + tk; const int w = 2 << (c8 >> 7);
                const bf16_t* zr = z + row * DIN + 3840 + c8;
                u32x4 r[16];
#pragma unroll
                for (int q = 0; q < 16; ++q) { r[q] = (u32x4){0u, 0u, 0u, 0u}; if (q < w) r[q] = *(const u32x4*)(zr - (size_t)q * DIN); }
                float sm[8], u0[8];
                u0[0] = bf_lo(r[0].x); u0[1] = bf_hi(r[0].x); u0[2] = bf_lo(r[0].y); u0[3] = bf_hi(r[0].y); u0[4] = bf_lo(r[0].z); u0[5] = bf_hi(r[0].z); u0[6] = bf_lo(r[0].w); u0[7] = bf_hi(r[0].w);
#pragma unroll
                for (int e = 0; e < 8; ++e) sm[e] = u0[e];
#pragma unroll
                for (int q = 1; q < 16; ++q) { sm[0] += bf_lo(r[q].x); sm[1] += bf_hi(r[q].x); sm[2] += bf_lo(r[q].y); sm[3] += bf_hi(r[q].y); sm[4] += bf_lo(r[q].z); sm[5] += bf_hi(r[q].z); sm[6] += bf_lo(r[q].w); sm[7] += bf_hi(r[q].w); }
                const float rc = 1.f / (float)w; float d[8];
#pragma unroll
                for (int e = 0; e < 8; ++e) d[e] = sm[e] * rc - u0[e];
                st8_bf16(cat + row * DM + 1536 + c8, d);
                if (lastc && tk >= 1) st8_f32(out_p + (size_t)(tk - 1) * DC + c8, u0); }
        } else {
#pragma unroll 1
        for (int it = tid; it < TOK * 96; it += 512) {
            const int tk = it / 96, c8 = (it - tk * 96) * 8, l = l0 + tk; const size_t row = row0 + tk;
            float t[8], y[8], b[8];
#pragma unroll
            for (int i = 0; i < 8; ++i) y[i] = 0.f;
#pragma unroll
            for (int q = 0; q < 3; ++q) { const int lq = l - 2 + q;
                if (lq >= 0) { const bf16_t* zr = z + (row - 2 + q) * DIN; float a[8], c[8]; ld8_bf16(zr + c8, a); ld8_bf16(zr + 1536 + c8, c);
#pragma unroll
                    for (int i = 0; i < 8; ++i) t[i] = a[i] * c[i]; }
                else if (samp) ld8_f32(hist_a + (size_t)(2 + lq) * DA + c8, t);
                else {
#pragma unroll
                    for (int i = 0; i < 8; ++i) t[i] = 0.f; }
                float w[8]; ld8_f32(caw + q * DA + c8, w);
#pragma unroll
                for (int i = 0; i < 8; ++i) y[i] += w[i] * t[i]; }
            ld8_bf16(z + row * DIN + 768 + c8, b);
#pragma unroll
            for (int i = 0; i < 8; ++i) y[i] *= b[i];
            st8_bf16(cat + row * DM + c8, y);
            if (lastc && tk >= TOK - 2) st8_f32(out_a + (size_t)(tk - (TOK - 2)) * DA + c8, t);
        }
#pragma unroll 1
        for (int it = tid; it < TOK * 64; it += 512) {
            const int tk = it >> 6, c8 = (it & 63) * 8, l = l0 + tk; const size_t row = row0 + tk;
            const int w = 2 << (c8 >> 7);
            float u0[8], s[8];
            ld8_bf16(z + row * DIN + 3840 + c8, u0);
#pragma unroll
            for (int i = 0; i < 8; ++i) s[i] = u0[i];
#pragma unroll 1
            for (int q = 1; q < w; ++q) { const int lq = l - q; float uq[8];
                if (lq >= 0) ld8_bf16(z + (row - q) * DIN + 3840 + c8, uq);
                else if (samp) ld8_f32(hist_p + (size_t)(15 + lq) * DC + c8, uq);
                else break;
#pragma unroll
                for (int i = 0; i < 8; ++i) s[i] += uq[i]; }
            const int cnt = samp ? w : (l + 1 < w ? l + 1 : w);
            const float rc = 1.f / (float)cnt; float d[8];
#pragma unroll
            for (int i = 0; i < 8; ++i) d[i] = s[i] * rc - u0[i];
            st8_bf16(cat + row * DM + 1536 + c8, d);
            if (lastc && tk >= 1) st8_f32(out_p + (size_t)(tk - 1) * DC + c8, u0);
        }
        }
        __syncthreads();
    }
}

__device__ __forceinline__ void sample_fixup(const Params& p, int G, float* ss_out) {
    int tid = threadIdx.x; asm volatile("" : "+v"(tid));
    const int lane = tid & 63, wave = __builtin_amdgcn_readfirstlane(tid >> 6);
    bf16_t* hb = (bf16_t*)(p.ws + WS_HB);
    const float* slab = (const float*)(p.ws + WS_SLAB);
    for (int m = blockIdx.x * 8 + wave; m < MS; m += G * 8) {
        bf16_t* hr = hb + (size_t)(MP + m) * DM; float s = 0.f;
#pragma unroll
        for (int j = 0; j < 4; ++j) { const int c = j * 512 + lane * 8; float b[8]; ld8_bf16(hr + c, b);
            f32x4 v0 = (f32x4){b[0], b[1], b[2], b[3]}, v1 = (f32x4){b[4], b[5], b[6], b[7]};
#pragma unroll
            for (int q = 0; q < 4; ++q) { const float* sr = slab + (size_t)q * (MS * DM) + (size_t)m * DM + c; v0 += *(const f32x4*)sr; v1 += *(const f32x4*)(sr + 4); }
            u32x4 w; w.x = cvt_pk_bf16(v0[0], v0[1]); w.y = cvt_pk_bf16(v0[2], v0[3]); w.z = cvt_pk_bf16(v1[0], v1[1]); w.w = cvt_pk_bf16(v1[2], v1[3]);
            *(u32x4*)(hr + c) = w;
            const float r[8] = {bf_lo(w.x), bf_hi(w.x), bf_lo(w.y), bf_hi(w.y), bf_lo(w.z), bf_hi(w.z), bf_lo(w.w), bf_hi(w.w)};
#pragma unroll
            for (int e = 0; e < 8; ++e) s += r[e] * r[e]; }
        s = wave_sum(s);
        if (lane == 0) ss_out[MP + m] = s;
    }
    const float* ssp = (const float*)(p.ws + WS_SSP);
    for (int r2 = blockIdx.x * 8 + wave; r2 < MP / 2; r2 += G * 8) {
        const int row = r2 * 2 + (lane >> 5);
        float v = ssp[(size_t)row * 32 + (lane & 31)];
#pragma unroll
        for (int o = 1; o < 32; o <<= 1) v += __shfl_xor(v, o);
        if ((lane & 31) == 0) ss_out[row] = v;
    }
}

__device__ __forceinline__ void final_norm(const Params& p, int G) {
    int tid = threadIdx.x; asm volatile("" : "+v"(tid));
    const int lane = tid & 63, wave = __builtin_amdgcn_readfirstlane(tid >> 6);
    const int gw = blockIdx.x * 8 + wave, NGW = G * 8;
    const float* ss = (const float*)(p.ws + WS_SS) + 6 * MT;
    const float* gn = p.in[I_NF];
    const bf16_t* hb = (const bf16_t*)(p.ws + WS_HB);
    for (int m = gw; m < MT; m += NGW) {
        const float rinv = __builtin_amdgcn_rsqf(ss[m] * (1.f / DM) + EPS);
        float* orow = p.out + (size_t)m * DM;
#pragma unroll
        for (int j = 0; j < 4; ++j) { const int c = j * 512 + lane * 8; float b[8], g[8]; ld8_bf16(hb + (size_t)m * DM + c, b); ld8_f32(gn + c, g);
#pragma unroll
            for (int e = 0; e < 8; ++e) b[e] = b[e] * rinv * g[e];
            st8_f32(orow + c, b); }
    }
}

__device__ __forceinline__ void final_fused(const Params& p, int G) {
    int tid = threadIdx.x; asm volatile("" : "+v"(tid));
    const int lane = tid & 63, wave = __builtin_amdgcn_readfirstlane(tid >> 6);
    const int gw = blockIdx.x * 8 + wave, NGW = G * 8;
    const float* gn = p.in[I_NF];
    const bf16_t* hb = (const bf16_t*)(p.ws + WS_HB);
    const float* ssp = (const float*)(p.ws + WS_SSP);
    const float* slab = (const float*)(p.ws + WS_SLAB);
    for (int m = gw; m < MT; m += NGW) {
        float b[4][8]; float s;
#pragma unroll
        for (int j = 0; j < 4; ++j) ld8_bf16(hb + (size_t)m * DM + j * 512 + lane * 8, b[j]);
        if (m < MP) {
            float v = ssp[(size_t)m * 32 + (lane & 31)];
#pragma unroll
            for (int o = 1; o < 32; o <<= 1) v += __shfl_xor(v, o);
            s = v;
        } else {
            s = 0.f;
#pragma unroll
            for (int j = 0; j < 4; ++j) {
#pragma unroll
                for (int q = 0; q < 4; ++q) { float t[8]; ld8_f32(slab + (size_t)q * (MS * DM) + (size_t)(m - MP) * DM + j * 512 + lane * 8, t);
#pragma unroll
                    for (int e = 0; e < 8; ++e) b[j][e] += t[e]; }
#pragma unroll
                for (int e = 0; e < 8; ++e) s += b[j][e] * b[j][e]; }
            s = wave_sum(s);
        }
        const float rinv = __builtin_amdgcn_rsqf(s * (1.f / DM) + EPS);
        float* orow = p.out + (size_t)m * DM;
#pragma unroll
        for (int j = 0; j < 4; ++j) { const int c = j * 512 + lane * 8; float g[8]; ld8_f32(gn + c, g);
#pragma unroll
            for (int e = 0; e < 8; ++e) b[j][e] = b[j][e] * rinv * g[e];
            st8_f32(orow + c, b[j]); }
    }
}

#define XB_TMO      128
#define XB_XCNT(j)  (256  + 64 * (j))
#define XB_XSUB(j)  (1280 + 64 * (j))
#define XB_XGEN(j)  (2304 + 64 * (j))
#define XB_TOP      3328
#define XB_TOPGEN   3392
#define XCD_BAR_WORDS 3456
#define XB_SPIN_CAP (1u << 22)
__device__ __forceinline__ unsigned xb_ld(unsigned* p)              { return __hip_atomic_load(p, __ATOMIC_RELAXED, __HIP_MEMORY_SCOPE_AGENT); }
__device__ __forceinline__ unsigned xb_add(unsigned* p, unsigned v) { return __hip_atomic_fetch_add(p, v, __ATOMIC_RELAXED, __HIP_MEMORY_SCOPE_AGENT); }
__device__ __forceinline__ unsigned xb_xcc_id() { return (unsigned)__builtin_amdgcn_s_getreg((3 << 11) | 20) & 0xFu; }
#define XB_SPIN(cond, bar) do { unsigned _sp = 0; while (cond) { __builtin_amdgcn_s_sleep(1); \
    if ((++_sp & 255u) == 0u) { if (xb_ld(&(bar)[XB_TMO])) break; if (_sp > XB_SPIN_CAP) { atomicAdd(&(bar)[XB_TMO], 1u); break; } } } } while (0)
struct XcdBarrier { unsigned* bar; unsigned x; volatile LAS unsigned* st; };
__device__ __forceinline__ XcdBarrier xcd_barrier_post(unsigned* bar, volatile LAS unsigned* st) {
    XcdBarrier b; b.bar = bar; b.x = xb_xcc_id(); b.st = st;
    if (threadIdx.x == 0) (void)xb_add(&bar[XB_XCNT(b.x)], 1u);
    return b;
}
__device__ __forceinline__ void xcd_barrier_complete(unsigned* bar, unsigned x, unsigned& nloc, unsigned& nx) {
    const unsigned G = gridDim.x * gridDim.y * gridDim.z;
    unsigned sum, cnt, mine, sp = 0u;
    for (;;) {
        sum = 0u; cnt = 0u; mine = 0u;
#pragma unroll
        for (unsigned j = 0; j < 16; ++j) { const unsigned c = xb_ld(&bar[XB_XCNT(j)]); sum += c; cnt += (c > 0u) ? 1u : 0u; mine = (j == x) ? c : mine; }
        if (sum == G) break;
        __builtin_amdgcn_s_sleep(1);
        if ((++sp & 255u) == 0u) { if (xb_ld(&bar[XB_TMO])) break; if (sp > XB_SPIN_CAP) { atomicAdd(&bar[XB_TMO], 1u); break; } }
    }
    nloc = mine > 0u ? mine : 1u; nx = cnt > 0u ? cnt : 1u;
}
__device__ __forceinline__ void xcd_barrier(const XcdBarrier& b) {
    asm volatile("s_waitcnt vmcnt(0)" ::: "memory");
    __syncthreads();
    if (threadIdx.x == 0) {
        unsigned* bar = b.bar;
        __builtin_amdgcn_s_waitcnt(0);
        unsigned nloc = b.st[0], nx = b.st[1];
        if (nloc == 0u) { xcd_barrier_complete(bar, b.x, nloc, nx); b.st[0] = nloc; b.st[1] = nx; }
        const unsigned old = xb_add(&bar[XB_XSUB(b.x)], 1u);
        const unsigned gen = old / nloc;
        if (old + 1u == (gen + 1u) * nloc) {
            __builtin_amdgcn_fence(__ATOMIC_RELEASE, "agent");
            asm volatile("s_waitcnt vmcnt(0)" ::: "memory");
            const unsigned og = xb_add(&bar[XB_TOP], 1u);
            const unsigned tg = og / nx;
            if (og + 1u == (tg + 1u) * nx) xb_add(&bar[XB_TOPGEN], 1u);
            else XB_SPIN(xb_ld(&bar[XB_TOPGEN]) == tg, bar);
            __builtin_amdgcn_fence(__ATOMIC_ACQUIRE, "agent");
            xb_add(&bar[XB_XGEN(b.x)], 1u);
            asm volatile("s_waitcnt vmcnt(0)" ::: "memory");
        } else {
            XB_SPIN(xb_ld(&bar[XB_XGEN(b.x)]) == gen, bar);
            __builtin_amdgcn_fence(__ATOMIC_ACQUIRE, "agent");
            asm volatile("s_waitcnt vmcnt(0)" ::: "memory");
        }
    }
    __syncthreads();
}

__global__ void __launch_bounds__(512, 2) fwd_megakernel(Params p) {
    extern __shared__ __attribute__((aligned(16))) unsigned char lds_raw[];
    LAS unsigned char* lds = (LAS unsigned char*)lds_raw;
    cg::grid_group grid = cg::this_grid();
    const int G = gridDim.x;
    float* ssb = (float*)(p.ws + WS_SS);
    bf16_t* hb = (bf16_t*)(p.ws + WS_HB);
    bf16_t* act = (bf16_t*)(p.ws + WS_ACT);
    bf16_t* cat = (bf16_t*)(p.ws + WS_CAT);

    volatile LAS unsigned* misc = (volatile LAS unsigned*)(lds + MISC_OFF);
    if (threadIdx.x < 2) misc[threadIdx.x] = 0u;
    __syncthreads();
    const XcdBarrier xbar = xcd_barrier_post((unsigned*)(p.ws + WS_BAR), misc);
#pragma unroll 1
    for (int rep = 0; rep < REP_PRO; ++rep)
    prologue(p, lds, G);
    grid.sync();
#define GRID_BAR() xcd_barrier(xbar)

    for (int st = 0; st < 6; ++st) {
        const int layer = st / 3, sub = st - layer * 3;
        unsigned char* wl = p.ws + WS_W + (size_t)layer * W_LAYER;
        if (sub != 1) {
            const int f = sub >> 1;
            const float* ss_in = ssb + (size_t)(layer * 3 + (f ? 2 : 0)) * MT;
            float* ss_out = ssb + (size_t)(layer * 3 + (f ? 3 : 1)) * MT;
            const bf16_t* wgu = (const bf16_t*)(wl + (f ? W_GU2 : W_GU1));
            const bf16_t* wd = (const bf16_t*)(wl + (f ? W_D2 : W_D1));
            { pg8::Gemm g{hb, wgu, MT, 2 * DFF, DM, DM / 64}; pg8::StaticOrder S; S.init(MT, 2 * DFF, G, (int)blockIdx.x);
              pg8::EpiSwiGLU E{act, ss_in};
#pragma unroll 1
              for (int rep = 0; rep < REP_GU; ++rep)
              pg8::gemm_phase<pg8::EpiSwiGLU, pg8::StaticOrder, true, true>(lds, g, S, E); }
            GRID_BAR();
            { const bool first = (st == 0);
              { pg8::Gemm g{act, wd, MP, DM, DFF, DFF / 64}; pg8::StaticOrder S; S.init(MP, DM, G, (int)blockIdx.x);
                pg8::EpiResid E{hb, (float*)(p.ws + WS_SSP), 0.5f};
                pg8::gemm_phase<pg8::EpiResid, pg8::StaticOrder, true, true>(lds, g, S, E); }
              { pg8::Gemm g{act, wd, MT, DM, DFF, DFF / 256}; pg8::SplitOrder S{(int)blockIdx.x, (DFF / 4) * 2};
                pg8::EpiSlab E{(float*)(p.ws + WS_SLAB), 0.5f, (DFF / 4) * 2};
                pg8::gemm_phase<pg8::EpiSlab, pg8::SplitOrder, true, true>(lds, g, S, E); } }
            GRID_BAR();
            if (st != 5) { sample_fixup(p, G, ss_out); GRID_BAR(); }
        } else {
            const float* ss_in = ssb + (size_t)(layer * 3 + 1) * MT;
            float* ss_out = ssb + (size_t)(layer * 3 + 2) * MT;
            { pg8::Gemm g{hb, (const bf16_t*)(wl + W_IN), MT, DIN, DM, DM / 64}; pg8::StaticOrder S; S.init(MT, DIN, G, (int)blockIdx.x);
              pg8::EpiScaleBf16 E{act, DIN, ss_in};
#pragma unroll 1
              for (int rep = 0; rep < REP_WIN; ++rep)
              pg8::gemm_phase<pg8::EpiScaleBf16, pg8::StaticOrder, true, true>(lds, g, S, E); }
            GRID_BAR();
#pragma unroll 1
            for (int rep = 0; rep < REP_MIX; ++rep)
            mixer_mid(p, lds, G, layer);
            GRID_BAR();
            { pg8::Gemm g{cat, (const bf16_t*)(wl + W_OUT), MP, DM, DM, DM / 64}; pg8::StaticOrder S; S.init(MP, DM, G, (int)blockIdx.x);
              pg8::EpiResid E{hb, (float*)(p.ws + WS_SSP), 1.0f};
              pg8::gemm_phase<pg8::EpiResid, pg8::StaticOrder, true, true>(lds, g, S, E); }
            { pg8::Gemm g{cat, (const bf16_t*)(wl + W_OUT), MT, DM, DM, DM / 256}; pg8::SplitOrder S{(int)blockIdx.x, (DM / 4) * 2};
              pg8::EpiSlab E{(float*)(p.ws + WS_SLAB), 1.0f, (DM / 4) * 2};
              pg8::gemm_phase<pg8::EpiSlab, pg8::SplitOrder, true, true>(lds, g, S, E); }
            GRID_BAR();
            sample_fixup(p, G, ss_out);
            GRID_BAR();
        }
    }
    final_fused(p, G);
}

extern "C" void kernel_launch(void* const* d_in, const int* in_sizes, int n_in, void* d_out, int out_size, void* d_ws, size_t ws_size, hipStream_t stream) {
    static int grid = 0;
    if (grid == 0) {
        if (n_in != 24 || ws_size < WS_END) { fprintf(stderr, "kernel_launch: need 24 inputs and >= %zu bytes of workspace (got %d, %zu)\n", (size_t)WS_END, n_in, ws_size); grid = -1; return; }
        int dev = 0, cus = 0, per_cu = 0;
        hipGetDevice(&dev);
        hipDeviceGetAttribute(&cus, hipDeviceAttributeMultiprocessorCount, dev);
        hipFuncSetAttribute((const void*)fwd_megakernel, hipFuncAttributeMaxDynamicSharedMemorySize, LDS_BYTES);
        hipOccupancyMaxActiveBlocksPerMultiprocessor(&per_cu, (const void*)fwd_megakernel, 512, LDS_BYTES);
        if (per_cu < 1) { fprintf(stderr, "kernel_launch: occupancy query returned %d\n", per_cu); per_cu = 1; }
        grid = cus * per_cu;
    }
    if (grid < 0) return;
    if (hipMemsetAsync((char*)d_ws + WS_BAR, 0, WS_BAR_BYTES, stream) != hipSuccess) { fprintf(stderr, "kernel_launch: memset failed\n"); return; }
    Params p{};
    for (int i = 0; i < 24; ++i) p.in[i] = (const float*)d_in[i];
    p.out = (float*)d_out; p.ws = (unsigned char*)d_ws;
    void* args[] = {&p};
    hipError_t e = hipLaunchCooperativeKernel((void*)fwd_megakernel, dim3(grid), dim3(512), args, LDS_BYTES, stream);
    if (e != hipSuccess) fprintf(stderr, "cooperative launch failed: %s (grid %d)\n", hipGetErrorString(e), grid);
}
```

```cpp
#include <hip/hip_runtime.h>
#include <hip/hip_cooperative_groups.h>
#include <cstdio>
#include <cstdint>
namespace cg = cooperative_groups;

#define LAS __attribute__((address_space(3)))
typedef unsigned short bf16_t;
typedef short bf16x8 __attribute__((ext_vector_type(8)));
typedef float f32x4 __attribute__((ext_vector_type(4)));
typedef float f32x2 __attribute__((ext_vector_type(2)));
typedef unsigned u32x4 __attribute__((ext_vector_type(4)));
typedef unsigned u32x2 __attribute__((ext_vector_type(2)));

constexpr int DM = 2048, DFF = 5632, DIN = 4352, DA = 768, DB = 768, DC = 512;
constexpr int MP = 16384, MS = 512, MT = MP + MS;
constexpr float EPS = 1e-6f;
constexpr size_t MiB = 1u << 20;
constexpr size_t WS_SS = 0, WS_W = 1 * MiB, W_LAYER = 157 * MiB;
constexpr size_t W_GU1 = 0, W_D1 = 44 * MiB, W_IN = 66 * MiB, W_OUT = 83 * MiB, W_GU2 = 91 * MiB, W_D2 = 135 * MiB;
constexpr size_t WS_HB = 315 * MiB, WS_ACT = 381 * MiB, WS_CAT = 563 * MiB, WS_SLAB = 629 * MiB, WS_SSP = 645 * MiB, WS_END = 648 * MiB;
constexpr int OFF_A_P = 34603008, OFF_B_P = OFF_A_P + 6144, OFF_P_P = OFF_B_P + 92160, OFF_A_S = OFF_P_P + 30720, OFF_B_S = OFF_A_S + 24576, OFF_P_S = OFF_B_S + 368640;
#ifndef REP_GU
#define REP_GU 1
#endif
#ifndef REP_WIN
#define REP_WIN 1
#endif
#ifndef REP_MIX
#define REP_MIX 1
#endif
#ifndef REP_PRO
#define REP_PRO 1
#endif
constexpr int LDS_BYTES = 147456, MISC_OFF = 139264;
constexpr size_t WS_BAR = 512 * 1024, WS_BAR_BYTES = 16384;

#define LDS_WAIT() asm volatile("s_waitcnt lgkmcnt(0)" ::: "memory")

__device__ __forceinline__ unsigned cvt_pk_bf16(float lo, float hi) { unsigned r; asm volatile("v_cvt_pk_bf16_f32 %0, %1, %2" : "=v"(r) : "v"(lo), "v"(hi)); return r; }
__device__ __forceinline__ float bf_lo(unsigned w) { return __uint_as_float(w << 16); }
__device__ __forceinline__ float bf_hi(unsigned w) { return __uint_as_float(w & 0xffff0000u); }
__device__ __forceinline__ float sigmoidf_(float x) { return __builtin_amdgcn_rcpf(1.f + __builtin_amdgcn_exp2f(-1.44269504f * x)); }
__device__ __forceinline__ float siluf_(float x) { return x * sigmoidf_(x); }
__device__ __forceinline__ float wave_sum(float v) {
#pragma unroll
    for (int o = 1; o < 64; o <<= 1) v += __shfl_xor(v, o);
    return v;
}

namespace pg8 {
constexpr int BM = 256, BK = 64, HALF = 128, HTB = HALF * BK * 2, STAGE_BYTES = 8 * HTB, NXCD = 8, WGM = 4;
__host__ __device__ __forceinline__ int lds_byte(int r, int c) { const int st = (r >> 4) * 2 + (c >> 5), rr = r & 15, cc = c & 31, ob = rr * 64 + cc * 2; return st * 1024 + (ob ^ (((ob >> 9) & 1) << 5)); }
__host__ __device__ __forceinline__ void stage_rc(int b, int& R, int& C) { const int st = b / 1024, sb = b % 1024, swz = sb ^ (((sb >> 9) & 1) << 5); R = (st >> 1) * 16 + swz / 64; C = (st & 1) * 32 + (swz % 64) / 2; }
__host__ __device__ __forceinline__ int perm32(int rho) { const int n = rho >> 4, i = rho & 15; return 8 * (i >> 2) + 4 * n + (i & 3); }

struct Unit { int pm, pn, kb; };
struct Gemm { const bf16_t* A; const bf16_t* Bt; int M, N, K, nt; };

struct StaticOrder {
    int nM, nN, nwg, G, c;
    __device__ void init(int M, int N, int G_, int c_) { nM = M / BM; nN = N / BM; nwg = nM * nN; G = G_; c = c_; }
    __device__ __forceinline__ bool next(int i, Unit& u) const {
        const long L = (long)i * G + c; if (L >= nwg) return false;
        int wgid = (int)L; { const int q = nwg / NXCD, r = nwg % NXCD, xcd = wgid % NXCD, off = wgid / NXCD; wgid = (xcd < r ? xcd * (q + 1) : r * (q + 1) + (xcd - r) * q) + off; }
        const int nig = WGM * nN, gid = wgid / nig, fm = gid * WGM, gsz = (nM - fm) < WGM ? (nM - fm) : WGM;
        u.pm = fm + ((wgid % nig) % gsz); u.pn = (wgid % nig) / gsz; u.kb = 0; return true;
    }
    __device__ __forceinline__ void a_ready(const Unit&) const {}
    __device__ __forceinline__ void done(const Unit&) const {}
};

struct EpiSwiGLU {
    static constexpr bool PERM = true, AFTER_DRAIN = false, PREF = true;
    bf16_t* O; const float* ss;
    __device__ __forceinline__ void prefetch(const Unit& u, int wr, int fr, float (&sv)[8]) const {
        const int row0 = u.pm * BM + wr * 64 + fr;
#pragma unroll
        for (int ai = 0; ai < 2; ++ai)
#pragma unroll
            for (int m = 0; m < 4; ++m) sv[ai * 4 + m] = ss[row0 + ai * HALF + m * 16];
    }
    __device__ __forceinline__ void operator()(const f32x4 (&acc)[2][2][4][2], const Unit& u, int wr, int wc, int fr, int fq, const float (&sv)[8]) const {
        const int row0 = u.pm * BM + wr * 64 + fr, col0 = u.pn * HALF + wc * 32 + 8 * fq;
#pragma unroll
        for (int ai = 0; ai < 2; ++ai)
#pragma unroll
            for (int m = 0; m < 4; ++m) {
                const int row = row0 + ai * HALF + m * 16;
                const float rinv = __builtin_amdgcn_rsqf(sv[ai * 4 + m] * (1.f / DM) + EPS), rneg = rinv * -1.44269504f, r2 = rinv * rinv;
                const f32x4 g0 = acc[ai][0][m][0], g1 = acc[ai][0][m][1], u0 = acc[ai][1][m][0], u1 = acc[ai][1][m][1];
                f32x4 e0, e1;
#pragma unroll
                for (int j = 0; j < 4; ++j) { e0[j] = __builtin_amdgcn_rcpf(1.f + __builtin_amdgcn_exp2f(g0[j] * rneg)); e1[j] = __builtin_amdgcn_rcpf(1.f + __builtin_amdgcn_exp2f(g1[j] * rneg)); }
                const f32x4 a0 = (g0 * u0) * (e0 * r2), a1 = (g1 * u1) * (e1 * r2);
                u32x4 w;
                w.x = cvt_pk_bf16(a0[0], a0[1]); w.y = cvt_pk_bf16(a0[2], a0[3]); w.z = cvt_pk_bf16(a1[0], a1[1]); w.w = cvt_pk_bf16(a1[2], a1[3]);
                *(u32x4*)(O + (size_t)row * DFF + col0) = w;
            }
    }
};
struct EpiScaleBf16 {
    static constexpr bool PERM = true, AFTER_DRAIN = false, PREF = true;
    bf16_t* O; int ldc; const float* ss;
    __device__ __forceinline__ void prefetch(const Unit& u, int wr, int fr, float (&sv)[8]) const {
        const int row0 = u.pm * BM + wr * 64 + fr;
#pragma unroll
        for (int ai = 0; ai < 2; ++ai)
#pragma unroll
            for (int m = 0; m < 4; ++m) sv[ai * 4 + m] = ss[row0 + ai * HALF + m * 16];
    }
    __device__ __forceinline__ void operator()(const f32x4 (&acc)[2][2][4][2], const Unit& u, int wr, int wc, int fr, int fq, const float (&sv)[8]) const {
        const int row0 = u.pm * BM + wr * 64 + fr, col0 = u.pn * BM + wc * 32 + 8 * fq;
#pragma unroll
        for (int ai = 0; ai < 2; ++ai)
#pragma unroll
            for (int m = 0; m < 4; ++m) {
                const int row = row0 + ai * HALF + m * 16;
                const float rinv = __builtin_amdgcn_rsqf(sv[ai * 4 + m] * (1.f / DM) + EPS);
                bf16_t* rowp = O + (size_t)row * ldc + col0;
#pragma unroll
                for (int bj = 0; bj < 2; ++bj) { const f32x4 v0 = acc[ai][bj][m][0] * rinv, v1 = acc[ai][bj][m][1] * rinv;
                    u32x4 w; w.x = cvt_pk_bf16(v0[0], v0[1]); w.y = cvt_pk_bf16(v0[2], v0[3]); w.z = cvt_pk_bf16(v1[0], v1[1]); w.w = cvt_pk_bf16(v1[2], v1[3]);
                    *(u32x4*)(rowp + bj * HALF) = w; }
            }
    }
};
struct EpiResid {
    static constexpr bool PERM = true, AFTER_DRAIN = false, PREF = false;
    bf16_t* hb; float* ssn; float scale;
    __device__ __forceinline__ void prefetch(const Unit&, int, int, float (&)[8]) const {}
    __device__ __forceinline__ void operator()(const f32x4 (&acc)[2][2][4][2], const Unit& u, int wr, int wc, int fr, int fq, const float (&)[8]) const {
        const int row0 = u.pm * BM + wr * 64 + fr, col0 = u.pn * BM + wc * 32 + 8 * fq;
        bf16_t* bp0 = hb + (size_t)row0 * DM + col0;
        u32x4 b[2][4][2];
#pragma unroll
        for (int ai = 0; ai < 2; ++ai)
#pragma unroll
            for (int m = 0; m < 4; ++m)
#pragma unroll
                for (int bj = 0; bj < 2; ++bj) b[ai][m][bj] = *(const u32x4*)(bp0 + (size_t)(ai * HALF + m * 16) * DM + bj * HALF);
#pragma unroll
        for (int ai = 0; ai < 2; ++ai) {
#pragma unroll
            for (int m = 0; m < 4; ++m) {
                const int row = row0 + ai * HALF + m * 16;
                float s = 0.f;
#pragma unroll
                for (int bj = 0; bj < 2; ++bj) { const u32x4 bb = b[ai][m][bj];
                    const f32x4 b0 = (f32x4){bf_lo(bb.x), bf_hi(bb.x), bf_lo(bb.y), bf_hi(bb.y)}, b1 = (f32x4){bf_lo(bb.z), bf_hi(bb.z), bf_lo(bb.w), bf_hi(bb.w)};
                    const f32x4 h0 = b0 + acc[ai][bj][m][0] * scale, h1 = b1 + acc[ai][bj][m][1] * scale;
                    u32x4 w; w.x = cvt_pk_bf16(h0[0], h0[1]); w.y = cvt_pk_bf16(h0[2], h0[3]); w.z = cvt_pk_bf16(h1[0], h1[1]); w.w = cvt_pk_bf16(h1[2], h1[3]);
                    *(u32x4*)(bp0 + (size_t)(ai * HALF + m * 16) * DM + bj * HALF) = w;
                    const f32x4 r0 = (f32x4){bf_lo(w.x), bf_hi(w.x), bf_lo(w.y), bf_hi(w.y)}, r1 = (f32x4){bf_lo(w.z), bf_hi(w.z), bf_lo(w.w), bf_hi(w.w)};
                    s += (r0[0] * r0[0] + r0[1] * r0[1]) + (r0[2] * r0[2] + r0[3] * r0[3]) + (r1[0] * r1[0] + r1[1] * r1[1]) + (r1[2] * r1[2] + r1[3] * r1[3]); }
                s += __shfl_xor(s, 16); s += __shfl_xor(s, 32);
                if (fq == 0) ssn[(size_t)row * 32 + u.pn * 4 + wc] = s;
            }
        }
    }
};

struct SplitOrder {
    int c, kslice;
    __device__ __forceinline__ bool next(int i, Unit& u) const {
        if (i != 0 || c >= 64) return false;
        u.pm = 64 + (c & 1); u.pn = (c >> 1) & 7; u.kb = (c >> 4) * kslice; return true;
    }
    __device__ __forceinline__ void a_ready(const Unit&) const {}
    __device__ __forceinline__ void done(const Unit&) const {}
};
struct EpiSlab {
    static constexpr bool PERM = true, AFTER_DRAIN = false;
    static constexpr bool PREF = false;
    float* slab; float scale; int kslice;
    __device__ __forceinline__ void prefetch(const Unit&, int, int, float (&)[8]) const {}
    __device__ __forceinline__ void operator()(const f32x4 (&acc)[2][2][4][2], const Unit& u, int wr, int wc, int fr, int fq, const float (&)[8]) const {
        const int row0 = (u.pm - 64) * BM + wr * 64 + fr, col0 = u.pn * BM + wc * 32 + 8 * fq;
        float* sp = slab + (size_t)(u.kb / kslice) * (MS * DM);
#pragma unroll
        for (int ai = 0; ai < 2; ++ai)
#pragma unroll
            for (int m = 0; m < 4; ++m) { float* rp = sp + (size_t)(row0 + ai * HALF + m * 16) * DM + col0;
#pragma unroll
                for (int bj = 0; bj < 2; ++bj)
#pragma unroll
                    for (int n = 0; n < 2; ++n) *(f32x4*)(rp + bj * HALF + n * 4) = acc[ai][bj][m][n] * scale; }
    }
};

template <class Epi, class Sched, bool ALIGN_EPI = false, bool SP2 = false>
__device__ __forceinline__ void gemm_phase(LAS unsigned char* lds, const Gemm g, const Sched& S, const Epi& E) {
    int tid = threadIdx.x; asm volatile("" : "+v"(tid));
    const int wid = __builtin_amdgcn_readfirstlane(tid >> 6), lane = tid & 63, wr = wid >> 2, wc = wid & 3, fr = lane & 15, fq = lane >> 4;
    const int K = g.K, nt = g.nt;
    unsigned voffA[2], voffB[2];
#pragma unroll
    for (int i = 0; i < 2; ++i) { int R, C; stage_rc(tid * 16 + i * 8192, R, C); const int Rb = Epi::PERM ? ((R & ~31) + perm32(R & 31)) : R;
        voffA[i] = (unsigned)(R * K + C) * 2u; voffB[i] = (unsigned)(Rb * K + C) * 2u; }
    const size_t kstep = (size_t)(BK * 2);
    const size_t hstep = (size_t)HALF * K * 2;
    const size_t tstep = 2 * hstep;
    const unsigned ldsw = (unsigned)wid * 1024u;
    const int aoff = lds_byte(wr * 64 + fr, fq * 8), boff = lds_byte(wc * 32 + fr, fq * 8);
#define PG8_SA(b, h) (((b) * 2 + (h)) * HTB)
#define PG8_SB(b, h) ((4 + (b) * 2 + (h)) * HTB)
#define PG8_STAGE(bufoff, gbase, voff) do { _Pragma("unroll") for (int _i = 0; _i < 2; ++_i) \
        __builtin_amdgcn_global_load_lds((const unsigned*)((const char*)(gbase) + (voff)[_i]), (LAS unsigned*)(lds + (bufoff) + ldsw + _i * 8192), 16, 0, 0); } while (0)
#define PG8_LDA(dst, b, h) do { _Pragma("unroll") for (int m = 0; m < 4; ++m) _Pragma("unroll") for (int k = 0; k < 2; ++k) dst[m][k] = *(const LAS bf16x8*)(lds + PG8_SA(b, h) + aoff + m * 2048 + k * 1024); } while (0)
#define PG8_LDB(dst, b, h) do { _Pragma("unroll") for (int n = 0; n < 2; ++n) _Pragma("unroll") for (int k = 0; k < 2; ++k) dst[n][k] = *(const LAS bf16x8*)(lds + PG8_SB(b, h) + boff + n * 2048 + k * 1024); } while (0)
#define PG8_MMA(ai, bj, At, Bt) do { __builtin_amdgcn_s_setprio(1); _Pragma("unroll") for (int m = 0; m < 4; ++m) _Pragma("unroll") for (int n = 0; n < 2; ++n) _Pragma("unroll") for (int k = 0; k < 2; ++k) \
        acc[ai][bj][m][n] = __builtin_amdgcn_mfma_f32_16x16x32_bf16(Bt[n][k], At[m][k], acc[ai][bj][m][n], 0, 0, 0); __builtin_amdgcn_s_setprio(0); } while (0)
#define PG8_WAIT_V(n) asm volatile("s_waitcnt vmcnt(" #n ")" ::: "memory")
#define PG8_WAIT_L(n) asm volatile("s_waitcnt lgkmcnt(" #n ")" ::: "memory")
#define PG8_BAR __builtin_amdgcn_s_barrier()
#define PG8_SCHED __builtin_amdgcn_sched_barrier(0)
    Unit cur, nxt; int ui = 0;
    if (!S.next(0, cur)) return;
    f32x4 acc[2][2][4][2];
#pragma unroll
    for (int a = 0; a < 2; ++a)
#pragma unroll
        for (int b = 0; b < 2; ++b)
#pragma unroll
            for (int m = 0; m < 4; ++m)
#pragma unroll
                for (int n = 0; n < 2; ++n) acc[a][b][m][n] = (f32x4){0.f, 0.f, 0.f, 0.f};
    bf16x8 At[4][2], B0[2][2], B1[2][2];
    const char* cA = (const char*)g.A + (size_t)cur.pm * tstep + cur.kb; const char* cB = (const char*)g.Bt + (size_t)cur.pn * tstep + cur.kb;
    S.a_ready(cur);
    float sv[8];
#define PG8_SS_DMA(u, buf) do { if constexpr (Epi::PREF) { if (wid == 0) __builtin_amdgcn_global_load_lds((const unsigned*)(E.ss + (size_t)(u).pm * BM + 4 * lane), (LAS unsigned*)(lds + STAGE_BYTES + (buf) * 1024), 16, 0, 0); } } while (0)
    PG8_SS_DMA(cur, 0);
    if constexpr (SP2) {
        PG8_STAGE(PG8_SB(0, 0), cB, voffB); PG8_STAGE(PG8_SB(0, 1), cB + hstep, voffB); PG8_STAGE(PG8_SA(0, 0), cA, voffA); PG8_STAGE(PG8_SA(0, 1), cA + hstep, voffA);
        if (wr == 1) PG8_BAR;
        PG8_WAIT_V(2); PG8_BAR;
        PG8_STAGE(PG8_SB(1, 0), cB + kstep, voffB); PG8_STAGE(PG8_SA(1, 0), cA + kstep, voffA); PG8_STAGE(PG8_SB(1, 1), cB + hstep + kstep, voffB);
        PG8_WAIT_V(6); PG8_BAR;
    } else {
        PG8_STAGE(PG8_SB(0, 0), cB, voffB); PG8_STAGE(PG8_SA(0, 0), cA, voffA); PG8_STAGE(PG8_SB(0, 1), cB + hstep, voffB); PG8_STAGE(PG8_SA(0, 1), cA + hstep, voffA);
        if (wr == 1) PG8_BAR;
        PG8_WAIT_V(4); PG8_BAR;
        PG8_STAGE(PG8_SB(1, 0), cB + kstep, voffB); PG8_STAGE(PG8_SA(1, 0), cA + kstep, voffA); PG8_STAGE(PG8_SB(1, 1), cB + hstep + kstep, voffB);
        PG8_WAIT_V(6); PG8_BAR;
    }
    for (;;) {
        const bool has_next = S.next(ui + 1, nxt);
        const char* nA = has_next ? (const char*)g.A + (size_t)nxt.pm * tstep + nxt.kb : cA; const char* nB = has_next ? (const char*)g.Bt + (size_t)nxt.pn * tstep + nxt.kb : cB;
        for (int t = 0; t < nt; t += 2) {
            const bool last = (t == nt - 2);
            const char* a1 = cA + (size_t)(t + 1) * kstep;
            const char* a2 = last ? nA : cA + (size_t)(t + 2) * kstep; const char* b2 = last ? nB : cB + (size_t)(t + 2) * kstep;
            const char* a3 = a2 + kstep; const char* b3 = b2 + kstep;
            if (last && has_next) S.a_ready(nxt);
            if constexpr (SP2) {
            PG8_LDB(B0, 0, 0); PG8_LDB(B1, 0, 1); PG8_SCHED; PG8_LDA(At, 0, 0); PG8_STAGE(PG8_SA(1, 1), a1 + hstep, voffA);
            PG8_WAIT_V(8); PG8_WAIT_L(0); PG8_BAR; PG8_MMA(0, 0, At, B0); PG8_MMA(0, 1, At, B1); PG8_BAR; PG8_SCHED;
            PG8_LDA(At, 0, 1); PG8_STAGE(PG8_SB(0, 0), b2, voffB); PG8_STAGE(PG8_SB(0, 1), b2 + hstep, voffB); PG8_STAGE(PG8_SA(0, 0), a2, voffA);
            PG8_WAIT_V(8); PG8_WAIT_L(0); PG8_BAR; PG8_MMA(1, 0, At, B0); PG8_MMA(1, 1, At, B1); PG8_BAR; PG8_SCHED;
            PG8_LDB(B0, 1, 0); PG8_LDB(B1, 1, 1); PG8_SCHED; PG8_LDA(At, 1, 0); PG8_STAGE(PG8_SA(0, 1), a2 + hstep, voffA);
            PG8_WAIT_V(8); PG8_WAIT_L(0); PG8_BAR; PG8_MMA(0, 0, At, B0); PG8_MMA(0, 1, At, B1); PG8_BAR; PG8_SCHED;
            PG8_LDA(At, 1, 1); PG8_STAGE(PG8_SB(1, 0), b3, voffB); PG8_STAGE(PG8_SB(1, 1), b3 + hstep, voffB); PG8_STAGE(PG8_SA(1, 0), a3, voffA);
            PG8_WAIT_V(8); PG8_WAIT_L(0); PG8_BAR; PG8_MMA(1, 0, At, B0); PG8_MMA(1, 1, At, B1); PG8_BAR; PG8_SCHED;
            } else {
            PG8_LDB(B0, 0, 0); PG8_SCHED; PG8_LDA(At, 0, 0); PG8_STAGE(PG8_SA(1, 1), a1 + hstep, voffA);
            PG8_WAIT_L(8); PG8_BAR; PG8_WAIT_L(0); PG8_MMA(0, 0, At, B0); PG8_BAR; PG8_SCHED;
            PG8_LDB(B1, 0, 1); PG8_STAGE(PG8_SB(0, 0), b2, voffB);
            PG8_BAR; PG8_WAIT_L(0); PG8_MMA(0, 1, At, B1); PG8_BAR;
            PG8_LDA(At, 0, 1); PG8_STAGE(PG8_SA(0, 0), a2, voffA);
            PG8_BAR; PG8_WAIT_L(0); PG8_MMA(1, 0, At, B0); PG8_BAR; PG8_SCHED;
            PG8_STAGE(PG8_SB(0, 1), b2 + hstep, voffB);
            PG8_WAIT_V(6); PG8_BAR; PG8_MMA(1, 1, At, B1); PG8_BAR;
            PG8_LDB(B0, 1, 0); PG8_SCHED; PG8_LDA(At, 1, 0); PG8_STAGE(PG8_SA(0, 1), a2 + hstep, voffA);
            PG8_WAIT_L(8); PG8_BAR; PG8_WAIT_L(0); PG8_MMA(0, 0, At, B0); PG8_BAR; PG8_SCHED;
            PG8_LDB(B1, 1, 1); PG8_STAGE(PG8_SB(1, 0), b3, voffB);
            PG8_BAR; PG8_WAIT_L(0); PG8_MMA(0, 1, At, B1); PG8_BAR;
            PG8_LDA(At, 1, 1); PG8_STAGE(PG8_SA(1, 0), a3, voffA);
            PG8_BAR; PG8_WAIT_L(0); PG8_MMA(1, 0, At, B0); PG8_BAR; PG8_SCHED;
            PG8_STAGE(PG8_SB(1, 1), b3 + hstep, voffB);
            PG8_WAIT_V(6); PG8_BAR; PG8_MMA(1, 1, At, B1); PG8_BAR;
            }
        }
        if constexpr (ALIGN_EPI) { if (wr == 0) PG8_BAR; }
        if constexpr (Epi::PREF) {
#pragma unroll
            for (int ai = 0; ai < 2; ++ai)
#pragma unroll
                for (int m = 0; m < 4; ++m) sv[ai * 4 + m] = *(const LAS float*)(lds + STAGE_BYTES + (ui & 1) * 1024 + 4 * (ai * HALF + wr * 64 + m * 16 + fr));
        }
        if constexpr (!Epi::AFTER_DRAIN) { E(acc, cur, wr, wc, fr, fq, sv); S.done(cur); }
        if (!has_next) break;
#pragma unroll
        for (int a = 0; a < 2; ++a)
#pragma unroll
            for (int b = 0; b < 2; ++b)
#pragma unroll
                for (int m = 0; m < 4; ++m)
#pragma unroll
                    for (int n = 0; n < 2; ++n) acc[a][b][m][n] = (f32x4){0.f, 0.f, 0.f, 0.f};
        cur = nxt; cA = nA; cB = nB; ++ui;
        PG8_SS_DMA(cur, ui & 1);
        if constexpr (ALIGN_EPI) { if (wr == 1) PG8_BAR; }
    }
    PG8_WAIT_V(0);
    if constexpr (!ALIGN_EPI) { if (wr == 0) PG8_BAR; }
    PG8_BAR;
#undef PG8_SS_DMA
#undef PG8_SA
#undef PG8_SB
#undef PG8_STAGE
#undef PG8_LDA
#undef PG8_LDB
#undef PG8_MMA
#undef PG8_WAIT_V
#undef PG8_WAIT_L
#undef PG8_BAR
#undef PG8_SCHED
}
}

struct Params { const float* in[24]; float* out; unsigned char* ws; };
enum { I_XP = 0, I_XS, I_CA, I_CB, I_CP, I_N1, I_WG1, I_WU1, I_WD1, I_NM, I_WIN, I_CAW, I_CBW, I_CBB, I_LNG, I_LNB, I_PW, I_PS, I_WOUT, I_N2, I_WG2, I_WU2, I_WD2, I_NF };

__device__ __forceinline__ void tr_item(const float* W, int N, const float* gk, bf16_t* WT, int ldk, int drow0, int k0, int n0, LAS float* scr, int lane) {
    const int l16 = lane & 15, kq = lane >> 4;
    f32x4 v[16];
#pragma unroll
    for (int i = 0; i < 16; ++i) v[i] = *(const f32x4*)(W + (size_t)(k0 + 4 * i + kq) * N + n0 + 4 * l16);
    if (gk) {
#pragma unroll
        for (int i = 0; i < 16; ++i) v[i] = v[i] * gk[k0 + 4 * i + kq]; }
#pragma unroll
    for (int i = 0; i < 16; ++i) { LAS float* d = scr + (4 * i + kq) * 65 + 4 * l16; d[0] = v[i][0]; d[1] = v[i][1]; d[2] = v[i][2]; d[3] = v[i][3]; }
    LDS_WAIT(); asm volatile("" ::: "memory");
    const int c = lane & 7;
#pragma unroll
    for (int j = 0; j < 8; ++j) { const int n = (lane >> 3) + 8 * j; const LAS float* s = scr + (8 * c) * 65 + n;
        u32x4 o; o.x = cvt_pk_bf16(s[0 * 65], s[1 * 65]); o.y = cvt_pk_bf16(s[2 * 65], s[3 * 65]); o.z = cvt_pk_bf16(s[4 * 65], s[5 * 65]); o.w = cvt_pk_bf16(s[6 * 65], s[7 * 65]);
        *(u32x4*)(WT + (size_t)(drow0 + n) * ldk + k0 + 8 * c) = o; }
    LDS_WAIT(); asm volatile("" ::: "memory");
}

__device__ __forceinline__ void prologue(const Params& p, LAS unsigned char* lds, int G) {
    const int tid = threadIdx.x, lane = tid & 63, wave = __builtin_amdgcn_readfirstlane(tid >> 6);
    const int gw = blockIdx.x * 8 + wave, NGW = G * 8;
    float* ss = (float*)(p.ws + WS_SS);
    for (int b = blockIdx.x; b < 256; b += G) {
        const int layer = b >> 7, g = (b >> 5) & 3, n0 = (b & 31) * 64;
        LAS float* Bs = (LAS float*)lds;
        LAS float* As = (LAS float*)(lds + 32768);
        const float* wo = p.in[I_WOUT] + (size_t)layer * DM * DM + (size_t)(1536 + g * 128) * DM + n0;
        const float* ps = p.in[I_PS] + layer * DC + g * 128;
        const float* pw = p.in[I_PW] + (size_t)(layer * 4 + g) * 128 * 128;
#pragma unroll
        for (int i = 0; i < 4; ++i) { const int e = (i * 512 + tid) * 4, d = e >> 6, n = e & 63; const f32x4 v = *(const f32x4*)(wo + (size_t)d * DM + n) * ps[d]; *(LAS f32x4*)(Bs + d * 64 + n) = v; }
#pragma unroll
        for (int i = 0; i < 8; ++i) { const int e = (i * 512 + tid) * 4, c = e >> 7, d = e & 127; const f32x4 v = *(const f32x4*)(pw + e); LAS float* dp = As + c * 129 + d; dp[0] = v[0]; dp[1] = v[1]; dp[2] = v[2]; dp[3] = v[3]; }
        __syncthreads();
        float a[16];
#pragma unroll
        for (int i = 0; i < 16; ++i) a[i] = 0.f;
        for (int d = 0; d < 128; ++d) { const float bv = Bs[d * 64 + lane];
#pragma unroll
            for (int i = 0; i < 16; ++i) a[i] += As[(wave * 16 + i) * 129 + d] * bv; }
        bf16_t* dst = (bf16_t*)(p.ws + WS_W + (size_t)layer * W_LAYER + W_OUT) + (size_t)(n0 + lane) * DM + 1536 + g * 128 + wave * 16;
        u32x4 o0, o1;
        o0.x = cvt_pk_bf16(a[0], a[1]); o0.y = cvt_pk_bf16(a[2], a[3]); o0.z = cvt_pk_bf16(a[4], a[5]); o0.w = cvt_pk_bf16(a[6], a[7]);
        o1.x = cvt_pk_bf16(a[8], a[9]); o1.y = cvt_pk_bf16(a[10], a[11]); o1.z = cvt_pk_bf16(a[12], a[13]); o1.w = cvt_pk_bf16(a[14], a[15]);
        *(u32x4*)dst = o0; *(u32x4*)(dst + 8) = o1;
        __syncthreads();
    }
    LAS float* scr = (LAS float*)(lds + wave * 16640);
    constexpr int PER_LAYER = 2816 * 6 + 2176 + 768;
#pragma unroll 1
    for (int it = gw; it < 2 * PER_LAYER; it += NGW) {
        const int layer = it >= PER_LAYER ? 1 : 0; int r = it - layer * PER_LAYER;
        unsigned char* wl = p.ws + WS_W + (size_t)layer * W_LAYER;
        const float* W; const float* gk = nullptr; bf16_t* WT; int N, ldk, nnb, kind = 0;
        if (r < 2816) { W = p.in[I_WG1] + (size_t)layer * DM * DFF; gk = p.in[I_N1] + layer * DM; WT = (bf16_t*)(wl + W_GU1); N = DFF; ldk = DM; nnb = 88; kind = 1; }
        else if ((r -= 2816) < 2816) { W = p.in[I_WU1] + (size_t)layer * DM * DFF; gk = p.in[I_N1] + layer * DM; WT = (bf16_t*)(wl + W_GU1); N = DFF; ldk = DM; nnb = 88; kind = 2; }
        else if ((r -= 2816) < 2816) { W = p.in[I_WD1] + (size_t)layer * DFF * DM; WT = (bf16_t*)(wl + W_D1); N = DM; ldk = DFF; nnb = 32; }
        else if ((r -= 2816) < 2176) { W = p.in[I_WIN] + (size_t)layer * DM * DIN; gk = p.in[I_NM] + layer * DM; WT = (bf16_t*)(wl + W_IN); N = DIN; ldk = DM; nnb = 68; }
        else if ((r -= 2176) < 768) { W = p.in[I_WOUT] + (size_t)layer * DM * DM; WT = (bf16_t*)(wl + W_OUT); N = DM; ldk = DM; nnb = 32; }
        else if ((r -= 768) < 2816) { W = p.in[I_WG2] + (size_t)layer * DM * DFF; gk = p.in[I_N2] + layer * DM; WT = (bf16_t*)(wl + W_GU2); N = DFF; ldk = DM; nnb = 88; kind = 1; }
        else if ((r -= 2816) < 2816) { W = p.in[I_WU2] + (size_t)layer * DM * DFF; gk = p.in[I_N2] + layer * DM; WT = (bf16_t*)(wl + W_GU2); N = DFF; ldk = DM; nnb = 88; kind = 2; }
        else { r -= 2816; W = p.in[I_WD2] + (size_t)layer * DFF * DM; WT = (bf16_t*)(wl + W_D2); N = DM; ldk = DFF; nnb = 32; }
        const int kb = r / nnb, nb = r - kb * nnb, k0 = kb * 64, n0 = nb * 64;
        const int drow0 = kind ? ((n0 >> 7) * 256 + (kind - 1) * 128 + (n0 & 127)) : n0;
        tr_item(W, N, gk, WT, ldk, drow0, k0, n0, scr, lane);
    }
    bf16_t* hb = (bf16_t*)(p.ws + WS_HB);
    for (int m = gw; m < MT; m += NGW) {
        const float* xr = (m < MP) ? p.in[I_XP] + (size_t)m * DM : p.in[I_XS] + (size_t)(m - MP) * DM;
        float s = 0.f;
#pragma unroll
        for (int j = 0; j < 4; ++j) { const f32x4 v0 = *(const f32x4*)(xr + j * 512 + lane * 8), v1 = *(const f32x4*)(xr + j * 512 + lane * 8 + 4);
            s += (v0[0] * v0[0] + v0[1] * v0[1]) + (v0[2] * v0[2] + v0[3] * v0[3]) + (v1[0] * v1[0] + v1[1] * v1[1]) + (v1[2] * v1[2] + v1[3] * v1[3]);
            u32x4 w; w.x = cvt_pk_bf16(v0[0], v0[1]); w.y = cvt_pk_bf16(v0[2], v0[3]); w.z = cvt_pk_bf16(v1[0], v1[1]); w.w = cvt_pk_bf16(v1[2], v1[3]);
            *(u32x4*)(hb + (size_t)m * DM + j * 512 + lane * 8) = w; }
        s = wave_sum(s);
        if (lane == 0) ss[m] = s;
    }
}

__device__ __forceinline__ void ld8_bf16(const bf16_t* p, float (&v)[8]) {
    const u32x4 w = *(const u32x4*)p;
    v[0] = bf_lo(w.x); v[1] = bf_hi(w.x); v[2] = bf_lo(w.y); v[3] = bf_hi(w.y); v[4] = bf_lo(w.z); v[5] = bf_hi(w.z); v[6] = bf_lo(w.w); v[7] = bf_hi(w.w);
}
__device__ __forceinline__ void ld8_f32(const float* p, float (&v)[8]) {
    const f32x4 a = *(const f32x4*)p, b = *(const f32x4*)(p + 4);
    v[0] = a[0]; v[1] = a[1]; v[2] = a[2]; v[3] = a[3]; v[4] = b[0]; v[5] = b[1]; v[6] = b[2]; v[7] = b[3];
}
__device__ __forceinline__ void st8_f32(float* p, const float (&v)[8]) {
    *(f32x4*)p = (f32x4){v[0], v[1], v[2], v[3]}; *(f32x4*)(p + 4) = (f32x4){v[4], v[5], v[6], v[7]};
}
__device__ __forceinline__ void st8_bf16(bf16_t* p, const float (&v)[8]) {
    u32x4 w; w.x = cvt_pk_bf16(v[0], v[1]); w.y = cvt_pk_bf16(v[2], v[3]); w.z = cvt_pk_bf16(v[4], v[5]); w.w = cvt_pk_bf16(v[6], v[7]);
    *(u32x4*)p = w;
}

constexpr int TOK = 16, HALO = 30, VROWS = TOK + HALO, CH = 384;
__device__ __forceinline__ void mixer_mid(const Params& p, LAS unsigned char* lds, int G, int layer) {
    int tid = threadIdx.x; asm volatile("" : "+v"(tid));
    const int lane = tid & 63, wave = __builtin_amdgcn_readfirstlane(tid >> 6);
    LAS float* vt = (LAS float*)lds;
    LAS float* cb = (LAS float*)(lds + VROWS * CH * 4);
    const bf16_t* z = (const bf16_t*)(p.ws + WS_ACT);
    bf16_t* cat = (bf16_t*)(p.ws + WS_CAT);
    const float* caw = p.in[I_CAW] + layer * 3 * DA;
    const float* cbw = p.in[I_CBW] + layer * 31 * DB;
    const float* cbb = p.in[I_CBB] + layer * DB;
    const float* lng = p.in[I_LNG] + layer * DB;
    const float* lnb = p.in[I_LNB] + layer * DB;
    constexpr int NCH = MT / TOK, NCH_X = NCH / 8;
    static_assert(NCH % 8 == 0, "chunks divide over the XCDs");
    const int mx_x = (G % 8 == 0) ? (int)(blockIdx.x & 7) : 0, mx_r = (G % 8 == 0) ? (int)(blockIdx.x >> 3) : (int)blockIdx.x, mx_n = (G % 8 == 0) ? G / 8 : G, mx_tot = (G % 8 == 0) ? NCH_X : NCH;
    for (int ci = mx_r; ci < mx_tot; ci += mx_n) {
        const int ch = mx_x * NCH_X + ci;
        const bool samp = ch >= MP / TOK;
        int seq, l0, L;
        if (!samp) { seq = ch >> 9; l0 = (ch & 511) * TOK; L = 8192; } else { const int cs = ch - MP / TOK; seq = cs >> 2; l0 = (cs & 3) * TOK; L = 64; }
        const int row0 = ch * TOK;
        const bool lastc = (l0 + TOK == L), fast = (l0 >= 32);
        const float* hist_a = p.in[I_CA] + (size_t)(layer * 8 + seq) * 2 * DA;
        const float* hist_b = p.in[I_CB] + (size_t)(layer * 8 + seq) * 30 * DB;
        const float* hist_p = p.in[I_CP] + (size_t)(layer * 8 + seq) * 15 * DC;
        float* out_a = p.out + (samp ? OFF_A_S + (layer * 8 + seq) * 2 * DA : OFF_A_P + (layer * 2 + seq) * 2 * DA);
        float* out_b = p.out + (samp ? OFF_B_S + (layer * 8 + seq) * 30 * DB : OFF_B_P + (layer * 2 + seq) * 30 * DB);
        float* out_p = p.out + (samp ? OFF_P_S + (layer * 8 + seq) * 15 * DC : OFF_P_P + (layer * 2 + seq) * 15 * DC);
        u32x4 ra[5], rg[5];
#define MIX_VLOAD(hc_) do { _Pragma("unroll") for (int i = 0; i < 5; ++i) { const int it = tid + 512 * i; if (it < VROWS * (CH / 8)) { const int j = it / (CH / 8), cl = (it - j * (CH / 8)) * 8; \
            const bf16_t* zr = z + (size_t)(row0 - HALO + j) * DIN + (hc_) * CH + cl; ra[i] = *(const u32x4*)(zr + 2304); rg[i] = *(const u32x4*)(zr + 3072); } } } while (0)
        if (fast) MIX_VLOAD(0);
#pragma unroll 1
        for (int hc = 0; hc < 2; ++hc) {
            if (fast) {
#pragma unroll
                for (int i = 0; i < 5; ++i) { const int it = tid + 512 * i; if (it < VROWS * (CH / 8)) { const int j = it / (CH / 8), cl = (it - j * (CH / 8)) * 8, c8 = hc * CH + cl;
                    float v[8];
                    v[0] = bf_lo(ra[i].x) * sigmoidf_(bf_lo(rg[i].x)); v[1] = bf_hi(ra[i].x) * sigmoidf_(bf_hi(rg[i].x));
                    v[2] = bf_lo(ra[i].y) * sigmoidf_(bf_lo(rg[i].y)); v[3] = bf_hi(ra[i].y) * sigmoidf_(bf_hi(rg[i].y));
                    v[4] = bf_lo(ra[i].z) * sigmoidf_(bf_lo(rg[i].z)); v[5] = bf_hi(ra[i].z) * sigmoidf_(bf_hi(rg[i].z));
                    v[6] = bf_lo(ra[i].w) * sigmoidf_(bf_lo(rg[i].w)); v[7] = bf_hi(ra[i].w) * sigmoidf_(bf_hi(rg[i].w));
                    *(LAS f32x4*)(vt + j * CH + cl) = (f32x4){v[0], v[1], v[2], v[3]}; *(LAS f32x4*)(vt + j * CH + cl + 4) = (f32x4){v[4], v[5], v[6], v[7]};
                    if (lastc && j >= TOK) st8_f32(out_b + (size_t)(j - TOK) * DB + c8, v); } }
                if (hc == 0) MIX_VLOAD(1);
            } else
#pragma unroll 1
            for (int it = tid; it < VROWS * (CH / 8); it += 512) {
                const int j = it / (CH / 8), cl = (it - j * (CH / 8)) * 8, c8 = hc * CH + cl, l = l0 - HALO + j;
                float v[8];
                if (l >= 0) { const bf16_t* zr = z + (size_t)(row0 - HALO + j) * DIN; float a[8], g[8]; ld8_bf16(zr + 2304 + c8, a); ld8_bf16(zr + 3072 + c8, g);
#pragma unroll
                    for (int i = 0; i < 8; ++i) v[i] = a[i] * sigmoidf_(g[i]); }
                else if (samp) ld8_f32(hist_b + (size_t)(30 + l) * DB + c8, v);
                else {
#pragma unroll
                    for (int i = 0; i < 8; ++i) v[i] = 0.f; }
                *(LAS f32x4*)(vt + j * CH + cl) = (f32x4){v[0], v[1], v[2], v[3]}; *(LAS f32x4*)(vt + j * CH + cl + 4) = (f32x4){v[4], v[5], v[6], v[7]};
                if (lastc && j >= TOK) st8_f32(out_b + (size_t)(j - TOK) * DB + c8, v);
            }
            __syncthreads();
            if (tid < CH) {
                const int c = hc * CH + tid;
                float wv[31];
#pragma unroll
                for (int k = 0; k < 31; ++k) wv[k] = cbw[k * DB + c];
                const float bias = cbb[c];
                float o[TOK];
#pragma unroll
                for (int i = 0; i < TOK; ++i) o[i] = bias;
                const LAS float* vp = vt + tid;
#pragma unroll
                for (int jj = 0; jj < VROWS; ++jj) { const float x = vp[jj * CH];
#pragma unroll
                    for (int i = 0; i < TOK; ++i) { if (jj - i >= 0 && jj - i <= 30) o[i] += wv[(jj - i >= 0 && jj - i <= 30) ? jj - i : 0] * x; } }
#pragma unroll
                for (int i = 0; i < TOK; ++i) cb[i * DB + c] = o[i];
            }
            __syncthreads();
        }
#pragma unroll 1
        for (int tt = 0; tt < 2; ++tt) { const int tk = wave * 2 + tt; f32x2 x[6]; float s = 0.f;
#pragma unroll
            for (int i = 0; i < 6; ++i) { x[i] = *(const LAS f32x2*)(cb + tk * DB + 128 * i + 2 * lane); s += x[i].x + x[i].y; }
            const float mean = wave_sum(s) * (1.f / DB); float q2 = 0.f;
#pragma unroll
            for (int i = 0; i < 6; ++i) { x[i].x -= mean; x[i].y -= mean; q2 += x[i].x * x[i].x + x[i].y * x[i].y; }
            const float rstd = __builtin_amdgcn_rsqf(wave_sum(q2) * (1.f / DB) + EPS);
#pragma unroll
            for (int i = 0; i < 6; ++i) { const int c = 128 * i + 2 * lane; const f32x2 gg = *(const f32x2*)(lng + c), bb = *(const f32x2*)(lnb + c);
                const float y0 = siluf_(x[i].x * rstd * gg.x + bb.x), y1 = siluf_(x[i].y * rstd * gg.y + bb.y);
                *(unsigned*)(cat + (size_t)(row0 + tk) * DM + DA + c) = cvt_pk_bf16(y0, y1); } }
        if (fast) {
#pragma unroll 1
            for (int i = 0; i < 3; ++i) { const int it = tid + 512 * i, tk = it / 96, c8 = (it - tk * 96) * 8; const size_t row = row0 + tk; const bf16_t* zr = z + row * DIN + c8;
                u32x4 qa[3], qc[3], qb;
#pragma unroll
                for (int q = 0; q < 3; ++q) { qa[q] = *(const u32x4*)(zr - (2 - q) * DIN); qc[q] = *(const u32x4*)(zr - (2 - q) * DIN + 1536); }
                qb = *(const u32x4*)(zr + 768);
                float y[8], t[8], w[8];
#pragma unroll
                for (int e = 0; e < 8; ++e) y[e] = 0.f;
#pragma unroll
                for (int q = 0; q < 3; ++q) { ld8_f32(caw + q * DA + c8, w);
                    t[0] = bf_lo(qa[q].x) * bf_lo(qc[q].x); t[1] = bf_hi(qa[q].x) * bf_hi(qc[q].x); t[2] = bf_lo(qa[q].y) * bf_lo(qc[q].y); t[3] = bf_hi(qa[q].y) * bf_hi(qc[q].y);
                    t[4] = bf_lo(qa[q].z) * bf_lo(qc[q].z); t[5] = bf_hi(qa[q].z) * bf_hi(qc[q].z); t[6] = bf_lo(qa[q].w) * bf_lo(qc[q].w); t[7] = bf_hi(qa[q].w) * bf_hi(qc[q].w);
#pragma unroll
                    for (int e = 0; e < 8; ++e) y[e] += w[e] * t[e]; }
                y[0] *= bf_lo(qb.x); y[1] *= bf_hi(qb.x); y[2] *= bf_lo(qb.y); y[3] *= bf_hi(qb.y); y[4] *= bf_lo(qb.z); y[5] *= bf_hi(qb.z); y[6] *= bf_lo(qb.w); y[7] *= bf_hi(qb.w);
                st8_bf16(cat + row * DM + c8, y);
                if (lastc && tk >= TOK - 2) st8_f32(out_a + (size_t)(tk - (TOK - 2)) * DA + c8, t); }
#pragma unroll 1
            for (int i = 0; i < 2; ++i) { const int it = tid + 512 * i, tk = it >> 6, c8 = (it & 63) * 8; const size_t row = row0 + tk; const int w = 2 << (c8 >> 7);
                const bf16_t* zr = z + row * DIN + 3840 + c8;
                u32x4 r[16];
#pragma unroll
                for (int q = 0; q < 16; ++q) { r[q] = (u32x4){0u, 0u, 0u, 0u}; if (q < w) r[q] = *(const u32x4*)(zr - (size_t)q * DIN); }
                float sm[8], u0[8];
                u0[0] = bf_lo(r[0].x); u0[1] = bf_hi(r[0].x); u0[2] = bf_lo(r[0].y); u0[3] = bf_hi(r[0].y); u0[4] = bf_lo(r[0].z); u0[5] = bf_hi(r[0].z); u0[6] = bf_lo(r[0].w); u0[7] = bf_hi(r[0].w);
#pragma unroll
                for (int e = 0; e < 8; ++e) sm[e] = u0[e];
#pragma unroll
                for (int q = 1; q < 16; ++q) { sm[0] += bf_lo(r[q].x); sm[1] += bf_hi(r[q].x); sm[2] += bf_lo(r[q].y); sm[3] += bf_hi(r[q].y); sm[4] += bf_lo(r[q].z); sm[5] += bf_hi(r[q].z); sm[6] += bf_lo(r[q].w); sm[7] += bf_hi(r[q].w); }
                const float rc = 1.f / (float)w; float d[8];
#pragma unroll
                for (int e = 0; e < 8; ++e) d[e] = sm[e] * rc - u0[e];
                st8_bf16(cat + row * DM + 1536 + c8, d);
                if (lastc && tk >= 1) st8_f32(out_p + (size_t)(tk - 1) * DC + c8, u0); }
        } else {
#pragma unroll 1
        for (int it = tid; it < TOK * 96; it += 512) {
            const int tk = it / 96, c8 = (it - tk * 96) * 8, l = l0 + tk; const size_t row = row0 + tk;
            float t[8], y[8], b[8];
#pragma unroll
            for (int i = 0; i < 8; ++i) y[i] = 0.f;
#pragma unroll
            for (int q = 0; q < 3; ++q) { const int lq = l - 2 + q;
                if (lq >= 0) { const bf16_t* zr = z + (row - 2 + q) * DIN; float a[8], c[8]; ld8_bf16(zr + c8, a); ld8_bf16(zr + 1536 + c8, c);
#pragma unroll
                    for (int i = 0; i < 8; ++i) t[i] = a[i] * c[i]; }
                else if (samp) ld8_f32(hist_a + (size_t)(2 + lq) * DA + c8, t);
                else {
#pragma unroll
                    for (int i = 0; i < 8; ++i) t[i] = 0.f; }
                float w[8]; ld8_f32(caw + q * DA + c8, w);
#pragma unroll
                for (int i = 0; i < 8; ++i) y[i] += w[i] * t[i]; }
            ld8_bf16(z + row * DIN + 768 + c8, b);
#pragma unroll
            for (int i = 0; i < 8; ++i) y[i] *= b[i];
            st8_bf16(cat + row * DM + c8, y);
            if (lastc && tk >= TOK - 2) st8_f32(out_a + (size_t)(tk - (TOK - 2)) * DA + c8, t);
        }
#pragma unroll 1
        for (int it = tid; it < TOK * 64; it += 512) {
            const int tk = it >> 6, c8 = (it & 63) * 8, l = l0 + tk; const size_t row = row0 + tk;
            const int w = 2 << (c8 >> 7);
            float u0[8], s[8];
            ld8_bf16(z + row * DIN + 3840 + c8, u0);
#pragma unroll
            for (int i = 0; i < 8; ++i) s[i] = u0[i];
#pragma unroll 1
            for (int q = 1; q < w; ++q) { const int lq = l - q; float uq[8];
                if (lq >= 0) ld8_bf16(z + (row - q) * DIN + 3840 + c8, uq);
                else if (samp) ld8_f32(hist_p + (size_t)(15 + lq) * DC + c8, uq);
                else break;
#pragma unroll
                for (int i = 0; i < 8; ++i) s[i] += uq[i]; }
            const int cnt = samp ? w : (l + 1 < w ? l + 1 : w);
            const float rc = 1.f / (float)cnt; float d[8];
#pragma unroll
            for (int i = 0; i < 8; ++i) d[i] = s[i] * rc - u0[i];
            st8_bf16(cat + row * DM + 1536 + c8, d);
            if (lastc && tk >= 1) st8_f32(out_p + (size_t)(tk - 1) * DC + c8, u0);
        }
        }
        __syncthreads();
    }
}

__device__ __forceinline__ void sample_fixup(const Params& p, int G, float* ss_out) {
    int tid = threadIdx.x; asm volatile("" : "+v"(tid));
    const int lane = tid & 63, wave = __builtin_amdgcn_readfirstlane(tid >> 6);
    bf16_t* hb = (bf16_t*)(p.ws + WS_HB);
    const float* slab = (const float*)(p.ws + WS_SLAB);
    for (int m = blockIdx.x * 8 + wave; m < MS; m += G * 8) {
        bf16_t* hr = hb + (size_t)(MP + m) * DM; float s = 0.f;
#pragma unroll
        for (int j = 0; j < 4; ++j) { const int c = j * 512 + lane * 8; float b[8]; ld8_bf16(hr + c, b);
            f32x4 v0 = (f32x4){b[0], b[1], b[2], b[3]}, v1 = (f32x4){b[4], b[5], b[6], b[7]};
#pragma unroll
            for (int q = 0; q < 4; ++q) { const float* sr = slab + (size_t)q * (MS * DM) + (size_t)m * DM + c; v0 += *(const f32x4*)sr; v1 += *(const f32x4*)(sr + 4); }
            u32x4 w; w.x = cvt_pk_bf16(v0[0], v0[1]); w.y = cvt_pk_bf16(v0[2], v0[3]); w.z = cvt_pk_bf16(v1[0], v1[1]); w.w = cvt_pk_bf16(v1[2], v1[3]);
            *(u32x4*)(hr + c) = w;
            const float r[8] = {bf_lo(w.x), bf_hi(w.x), bf_lo(w.y), bf_hi(w.y), bf_lo(w.z), bf_hi(w.z), bf_lo(w.w), bf_hi(w.w)};
#pragma unroll
            for (int e = 0; e < 8; ++e) s += r[e] * r[e]; }
        s = wave_sum(s);
        if (lane == 0) ss_out[MP + m] = s;
    }
    const float* ssp = (const float*)(p.ws + WS_SSP);
    for (int r2 = blockIdx.x * 8 + wave; r2 < MP / 2; r2 += G * 8) {
        const int row = r2 * 2 + (lane >> 5);
        float v = ssp[(size_t)row * 32 + (lane & 31)];
#pragma unroll
        for (int o = 1; o < 32; o <<= 1) v += __shfl_xor(v, o);
        if ((lane & 31) == 0) ss_out[row] = v;
    }
}

__device__ __forceinline__ void final_norm(const Params& p, int G) {
    int tid = threadIdx.x; asm volatile("" : "+v"(tid));
    const int lane = tid & 63, wave = __builtin_amdgcn_readfirstlane(tid >> 6);
    const int gw = blockIdx.x * 8 + wave, NGW = G * 8;
    const float* ss = (const float*)(p.ws + WS_SS) + 6 * MT;
    const float* gn = p.in[I_NF];
    const bf16_t* hb = (const bf16_t*)(p.ws + WS_HB);
    for (int m = gw; m < MT; m += NGW) {
        const float rinv = __builtin_amdgcn_rsqf(ss[m] * (1.f / DM) + EPS);
        float* orow = p.out + (size_t)m * DM;
#pragma unroll
        for (int j = 0; j < 4; ++j) { const int c = j * 512 + lane * 8; float b[8], g[8]; ld8_bf16(hb + (size_t)m * DM + c, b); ld8_f32(gn + c, g);
#pragma unroll
            for (int e = 0; e < 8; ++e) b[e] = b[e] * rinv * g[e];
            st8_f32(orow + c, b); }
    }
}

__device__ __forceinline__ void final_fused(const Params& p, int G) {
    int tid = threadIdx.x; asm volatile("" : "+v"(tid));
    const int lane = tid & 63, wave = __builtin_amdgcn_readfirstlane(tid >> 6);
    const int gw = blockIdx.x * 8 + wave, NGW = G * 8;
    const float* gn = p.in[I_NF];
    const bf16_t* hb = (const bf16_t*)(p.ws + WS_HB);
    const float* ssp = (const float*)(p.ws + WS_SSP);
    const float* slab = (const float*)(p.ws + WS_SLAB);
    for (int m = gw; m < MT; m += NGW) {
        float b[4][8]; float s;
#pragma unroll
        for (int j = 0; j < 4; ++j) ld8_bf16(hb + (size_t)m * DM + j * 512 + lane * 8, b[j]);
        if (m < MP) {
            float v = ssp[(size_t)m * 32 + (lane & 31)];
#pragma unroll
            for (int o = 1; o < 32; o <<= 1) v += __shfl_xor(v, o);
            s = v;
        } else {
            s = 0.f;
#pragma unroll
            for (int j = 0; j < 4; ++j) {
#pragma unroll
                for (int q = 0; q < 4; ++q) { float t[8]; ld8_f32(slab + (size_t)q * (MS * DM) + (size_t)(m - MP) * DM + j * 512 + lane * 8, t);
#pragma unroll
                    for (int e = 0; e < 8; ++e) b[j][e] += t[e]; }
#pragma unroll
                for (int e = 0; e < 8; ++e) s += b[j][e] * b[j][e]; }
            s = wave_sum(s);
        }
        const float rinv = __builtin_amdgcn_rsqf(s * (1.f / DM) + EPS);
        float* orow = p.out + (size_t)m * DM;
#pragma unroll
        for (int j = 0; j < 4; ++j) { const int c = j * 512 + lane * 8; float g[8]; ld8_f32(gn + c, g);
#pragma unroll
            for (int e = 0; e < 8; ++e) b[j][e] = b[j][e] * rinv * g[e];
            st8_f32(orow + c, b[j]); }
    }
}

#define XB_TMO      128
#define XB_XCNT(j)  (256  + 64 * (j))
#define XB_XSUB(j)  (1280 + 64 * (j))
#define XB_XGEN(j)  (2304 + 64 * (j))
#define XB_TOP      3328
#define XB_TOPGEN   3392
#define XCD_BAR_WORDS 3456
#define XB_SPIN_CAP (1u << 22)
__device__ __forceinline__ unsigned xb_ld(unsigned* p)              { return __hip_atomic_load(p, __ATOMIC_RELAXED, __HIP_MEMORY_SCOPE_AGENT); }
__device__ __forceinline__ unsigned xb_add(unsigned* p, unsigned v) { return __hip_atomic_fetch_add(p, v, __ATOMIC_RELAXED, __HIP_MEMORY_SCOPE_AGENT); }
__device__ __forceinline__ unsigned xb_xcc_id() { return (unsigned)__builtin_amdgcn_s_getreg((3 << 11) | 20) & 0xFu; }
#define XB_SPIN(cond, bar) do { unsigned _sp = 0; while (cond) { __builtin_amdgcn_s_sleep(1); \
    if ((++_sp & 255u) == 0u) { if (xb_ld(&(bar)[XB_TMO])) break; if (_sp > XB_SPIN_CAP) { atomicAdd(&(bar)[XB_TMO], 1u); break; } } } } while (0)
struct XcdBarrier { unsigned* bar; unsigned x; volatile LAS unsigned* st; };
__device__ __forceinline__ XcdBarrier xcd_barrier_post(unsigned* bar, volatile LAS unsigned* st) {
    XcdBarrier b; b.bar = bar; b.x = xb_xcc_id(); b.st = st;
    if (threadIdx.x == 0) (void)xb_add(&bar[XB_XCNT(b.x)], 1u);
    return b;
}
__device__ __forceinline__ void xcd_barrier_complete(unsigned* bar, unsigned x, unsigned& nloc, unsigned& nx) {
    const unsigned G = gridDim.x * gridDim.y * gridDim.z;
    unsigned sum, cnt, mine, sp = 0u;
    for (;;) {
        sum = 0u; cnt = 0u; mine = 0u;
#pragma unroll
        for (unsigned j = 0; j < 16; ++j) { const unsigned c = xb_ld(&bar[XB_XCNT(j)]); sum += c; cnt += (c > 0u) ? 1u : 0u; mine = (j == x) ? c : mine; }
        if (sum == G) break;
        __builtin_amdgcn_s_sleep(1);
        if ((++sp & 255u) == 0u) { if (xb_ld(&bar[XB_TMO])) break; if (sp > XB_SPIN_CAP) { atomicAdd(&bar[XB_TMO], 1u); break; } }
    }
    nloc = mine > 0u ? mine : 1u; nx = cnt > 0u ? cnt : 1u;
}
__device__ __forceinline__ void xcd_barrier(const XcdBarrier& b) {
    asm volatile("s_waitcnt vmcnt(0)" ::: "memory");
    __syncthreads();
    if (threadIdx.x == 0) {
        unsigned* bar = b.bar;
        __builtin_amdgcn_s_waitcnt(0);
        unsigned nloc = b.st[0], nx = b.st[1];
        if (nloc == 0u) { xcd_barrier_complete(bar, b.x, nloc, nx); b.st[0] = nloc; b.st[1] = nx; }
        const unsigned old = xb_add(&bar[XB_XSUB(b.x)], 1u);
        const unsigned gen = old / nloc;
        if (old + 1u == (gen + 1u) * nloc) {
            __builtin_amdgcn_fence(__ATOMIC_RELEASE, "agent");
            asm volatile("s_waitcnt vmcnt(0)" ::: "memory");
            const unsigned og = xb_add(&bar[XB_TOP], 1u);
            const unsigned tg = og / nx;
            if (og + 1u == (tg + 1u) * nx) xb_add(&bar[XB_TOPGEN], 1u);
            else XB_SPIN(xb_ld(&bar[XB_TOPGEN]) == tg, bar);
            __builtin_amdgcn_fence(__ATOMIC_ACQUIRE, "agent");
            xb_add(&bar[XB_XGEN(b.x)], 1u);
            asm volatile("s_waitcnt vmcnt(0)" ::: "memory");
        } else {
            XB_SPIN(xb_ld(&bar[XB_XGEN(b.x)]) == gen, bar);
            __builtin_amdgcn_fence(__ATOMIC_ACQUIRE, "agent");
            asm volatile("s_waitcnt vmcnt(0)" ::: "memory");
        }
    }
    __syncthreads();
}

__global__ void __launch_bounds__(512, 2) fwd_megakernel(Params p) {
    extern __shared__ __attribute__((aligned(16))) unsigned char lds_raw[];
    LAS unsigned char* lds = (LAS unsigned char*)lds_raw;
    cg::grid_group grid = cg::this_grid();
    const int G = gridDim.x;
    float* ssb = (float*)(p.ws + WS_SS);
    bf16_t* hb = (bf16_t*)(p.ws + WS_HB);
    bf16_t* act = (bf16_t*)(p.ws + WS_ACT);
    bf16_t* cat = (bf16_t*)(p.ws + WS_CAT);

    volatile LAS unsigned* misc = (volatile LAS unsigned*)(lds + MISC_OFF);
    if (threadIdx.x < 2) misc[threadIdx.x] = 0u;
    __syncthreads();
    const XcdBarrier xbar = xcd_barrier_post((unsigned*)(p.ws + WS_BAR), misc);
#pragma unroll 1
    for (int rep = 0; rep < REP_PRO; ++rep)
    prologue(p, lds, G);
    grid.sync();
#define GRID_BAR() xcd_barrier(xbar)

    for (int st = 0; st < 6; ++st) {
        const int layer = st / 3, sub = st - layer * 3;
        unsigned char* wl = p.ws + WS_W + (size_t)layer * W_LAYER;
        if (sub != 1) {
            const int f = sub >> 1;
            const float* ss_in = ssb + (size_t)(layer * 3 + (f ? 2 : 0)) * MT;
            float* ss_out = ssb + (size_t)(layer * 3 + (f ? 3 : 1)) * MT;
            const bf16_t* wgu = (const bf16_t*)(wl + (f ? W_GU2 : W_GU1));
            const bf16_t* wd = (const bf16_t*)(wl + (f ? W_D2 : W_D1));
            { pg8::Gemm g{hb, wgu, MT, 2 * DFF, DM, DM / 64}; pg8::StaticOrder S; S.init(MT, 2 * DFF, G, (int)blockIdx.x);
              pg8::EpiSwiGLU E{act, ss_in};
#pragma unroll 1
              for (int rep = 0; rep < REP_GU; ++rep)
              pg8::gemm_phase<pg8::EpiSwiGLU, pg8::StaticOrder, true, true>(lds, g, S, E); }
            GRID_BAR();
            { const bool first = (st == 0);
              { pg8::Gemm g{act, wd, MP, DM, DFF, DFF / 64}; pg8::StaticOrder S; S.init(MP, DM, G, (int)blockIdx.x);
                pg8::EpiResid E{hb, (float*)(p.ws + WS_SSP), 0.5f};
                pg8::gemm_phase<pg8::EpiResid, pg8::StaticOrder, true, true>(lds, g, S, E); }
              { pg8::Gemm g{act, wd, MT, DM, DFF, DFF / 256}; pg8::SplitOrder S{(int)blockIdx.x, (DFF / 4) * 2};
                pg8::EpiSlab E{(float*)(p.ws + WS_SLAB), 0.5f, (DFF / 4) * 2};
                pg8::gemm_phase<pg8::EpiSlab, pg8::SplitOrder, true, true>(lds, g, S, E); } }
            GRID_BAR();
            if (st != 5) { sample_fixup(p, G, ss_out); GRID_BAR(); }
        } else {
            const float* ss_in = ssb + (size_t)(layer * 3 + 1) * MT;
            float* ss_out = ssb + (size_t)(layer * 3 + 2) * MT;
            { pg8::Gemm g{hb, (const bf16_t*)(wl + W_IN), MT, DIN, DM, DM / 64}; pg8::StaticOrder S; S.init(MT, DIN, G, (int)blockIdx.x);
              pg8::EpiScaleBf16 E{act, DIN, ss_in};
#pragma unroll 1
              for (int rep = 0; rep < REP_WIN; ++rep)
              pg8::gemm_phase<pg8::EpiScaleBf16, pg8::StaticOrder, true, true>(lds, g, S, E); }
            GRID_BAR();
#pragma unroll 1
            for (int rep = 0; rep < REP_MIX; ++rep)
            mixer_mid(p, lds, G, layer);
            GRID_BAR();
            { pg8::Gemm g{cat, (const bf16_t*)(wl + W_OUT), MP, DM, DM, DM / 64}; pg8::StaticOrder S; S.init(MP, DM, G, (int)blockIdx.x);
              pg8::EpiResid E{hb, (float*)(p.ws + WS_SSP), 1.0f};
              pg8::gemm_phase<pg8::EpiResid, pg8::StaticOrder, true, true>(lds, g, S, E); }
            { pg8::Gemm g{cat, (const bf16_t*)(wl + W_OUT), MT, DM, DM, DM / 256}; pg8::SplitOrder S{(int)blockIdx.x, (DM / 4) * 2};
              pg8::EpiSlab E{(float*)(p.ws + WS_SLAB), 1.0f, (DM / 4) * 2};
              pg8::gemm_phase<pg8::EpiSlab, pg8::SplitOrder, true, true>(lds, g, S, E); }
            GRID_BAR();
            sample_fixup(p, G, ss_out);
            GRID_BAR();
        }
    }
    final_fused(p, G);
}

extern "C" void kernel_launch(void* const* d_in, const int* in_sizes, int n_in, void* d_out, int out_size, void* d_ws, size_t ws_size, hipStream_t stream) {
    static int grid = 0;
    if (grid == 0) {
        if (n_in != 24 || ws_size < WS_END) { fprintf(stderr, "kernel_launch: need 24 inputs and >= %zu bytes of workspace (got %d, %zu)\n", (size_t)WS_END, n_in, ws_size); grid = -1; return; }
        int dev = 0, cus = 0, per_cu = 0;
        hipGetDevice(&dev);
        hipDeviceGetAttribute(&cus, hipDeviceAttributeMultiprocessorCount, dev);
        hipFuncSetAttribute((const void*)fwd_megakernel, hipFuncAttributeMaxDynamicSharedMemorySize, LDS_BYTES);
        hipOccupancyMaxActiveBlocksPerMultiprocessor(&per_cu, (const void*)fwd_megakernel, 512, LDS_BYTES);
        if (per_cu < 1) { fprintf(stderr, "kernel_launch: occupancy query returned %d\n", per_cu); per_cu = 1; }
        grid = cus * per_cu;
    }
    if (grid < 0) return;
    if (hipMemsetAsync((char*)d_ws + WS_BAR, 0, WS_BAR_BYTES, stream) != hipSuccess) { fprintf(stderr, "kernel_launch: memset failed\n"); return; }
    Params p{};
    for (int i = 0; i < 24; ++i) p.in[i] = (const float*)d_in[i];
    p.out = (float*)d_out; p.ws = (unsigned char*)d_ws;
    void* args[] = {&p};
    hipError_t e = hipLaunchCooperativeKernel((void*)fwd_megakernel, dim3(grid), dim3(512), args, LDS_BYTES, stream);
    if (e != hipSuccess) fprintf(stderr, "cooperative launch failed: %s (grid %d)\n", hipGetErrorString(e), grid);
}
```

```cpp
#include <hip/hip_runtime.h>
#include <hip/hip_cooperative_groups.h>
#include <cstdio>
#include <cstdint>
namespace cg = cooperative_groups;

#define LAS __attribute__((address_space(3)))
typedef unsigned short bf16_t;
typedef short bf16x8 __attribute__((ext_vector_type(8)));
typedef float f32x4 __attribute__((ext_vector_type(4)));
typedef float f32x2 __attribute__((ext_vector_type(2)));
typedef unsigned u32x4 __attribute__((ext_vector_type(4)));
typedef unsigned u32x2 __attribute__((ext_vector_type(2)));

constexpr int DM = 2048, DFF = 5632, DIN = 4352, DA = 768, DB = 768, DC = 512;
constexpr int MP = 16384, MS = 512, MT = MP + MS;
constexpr float EPS = 1e-6f;
constexpr size_t MiB = 1u << 20;
constexpr size_t WS_SS = 0, WS_W = 1 * MiB, W_LAYER = 157 * MiB;
constexpr size_t W_GU1 = 0, W_D1 = 44 * MiB, W_IN = 66 * MiB, W_OUT = 83 * MiB, W_GU2 = 91 * MiB, W_D2 = 135 * MiB;
constexpr size_t WS_HB = 315 * MiB, WS_ACT = 381 * MiB, WS_CAT = 563 * MiB, WS_SLAB = 629 * MiB, WS_SSP = 645 * MiB, WS_END = 648 * MiB;
constexpr int OFF_A_P = 34603008, OFF_B_P = OFF_A_P + 6144, OFF_P_P = OFF_B_P + 92160, OFF_A_S = OFF_P_P + 30720, OFF_B_S = OFF_A_S + 24576, OFF_P_S = OFF_B_S + 368640;
#ifndef REP_GU
#define REP_GU 1
#endif
#ifndef REP_WIN
#define REP_WIN 1
#endif
#ifndef REP_MIX
#define REP_MIX 1
#endif
#ifndef REP_PRO
#define REP_PRO 1
#endif
constexpr int LDS_BYTES = 147456, MISC_OFF = 139264;
constexpr size_t WS_BAR = 512 * 1024, WS_BAR_BYTES = 16384;

#define LDS_WAIT() asm volatile("s_waitcnt lgkmcnt(0)" ::: "memory")

__device__ __forceinline__ unsigned cvt_pk_bf16(float lo, float hi) { unsigned r; asm volatile("v_cvt_pk_bf16_f32 %0, %1, %2" : "=v"(r) : "v"(lo), "v"(hi)); return r; }
__device__ __forceinline__ float bf_lo(unsigned w) { return __uint_as_float(w << 16); }
__device__ __forceinline__ float bf_hi(unsigned w) { return __uint_as_float(w & 0xffff0000u); }
__device__ __forceinline__ float sigmoidf_(float x) { return __builtin_amdgcn_rcpf(1.f + __builtin_amdgcn_exp2f(-1.44269504f * x)); }
__device__ __forceinline__ float siluf_(float x) { return x * sigmoidf_(x); }
__device__ __forceinline__ float wave_sum(float v) {
#pragma unroll
    for (int o = 1; o < 64; o <<= 1) v += __shfl_xor(v, o);
    return v;
}

namespace pg8 {
constexpr int BM = 256, BK = 64, HALF = 128, HTB = HALF * BK * 2, STAGE_BYTES = 8 * HTB, NXCD = 8, WGM = 4;
__host__ __device__ __forceinline__ int lds_byte(int r, int c) { const int st = (r >> 4) * 2 + (c >> 5), rr = r & 15, cc = c & 31, ob = rr * 64 + cc * 2; return st * 1024 + (ob ^ (((ob >> 9) & 1) << 5)); }
__host__ __device__ __forceinline__ void stage_rc(int b, int& R, int& C) { const int st = b / 1024, sb = b % 1024, swz = sb ^ (((sb >> 9) & 1) << 5); R = (st >> 1) * 16 + swz / 64; C = (st & 1) * 32 + (swz % 64) / 2; }
__host__ __device__ __forceinline__ int perm32(int rho) { const int n = rho >> 4, i = rho & 15; return 8 * (i >> 2) + 4 * n + (i & 3); }

struct Unit { int pm, pn, kb; };
struct Gemm { const bf16_t* A; const bf16_t* Bt; int M, N, K, nt; };

struct StaticOrder {
    int nM, nN, nwg, G, c;
    __device__ void init(int M, int N, int G_, int c_) { nM = M / BM; nN = N / BM; nwg = nM * nN; G = G_; c = c_; }
    __device__ __forceinline__ bool next(int i, Unit& u) const {
        const long L = (long)i * G + c; if (L >= nwg) return false;
        int wgid = (int)L; { const int q = nwg / NXCD, r = nwg % NXCD, xcd = wgid % NXCD, off = wgid / NXCD; wgid = (xcd < r ? xcd * (q + 1) : r * (q + 1) + (xcd - r) * q) + off; }
        const int nig = WGM * nN, gid = wgid / nig, fm = gid * WGM, gsz = (nM - fm) < WGM ? (nM - fm) : WGM;
        u.pm = fm + ((wgid % nig) % gsz); u.pn = (wgid % nig) / gsz; u.kb = 0; return true;
    }
    __device__ __forceinline__ void a_ready(const Unit&) const {}
    __device__ __forceinline__ void done(const Unit&) const {}
};

struct EpiSwiGLU {
    static constexpr bool PERM = true, AFTER_DRAIN = false, PREF = true;
    bf16_t* O; const float* ss;
    __device__ __forceinline__ void prefetch(const Unit& u, int wr, int fr, float (&sv)[8]) const {
        const int row0 = u.pm * BM + wr * 64 + fr;
#pragma unroll
        for (int ai = 0; ai < 2; ++ai)
#pragma unroll
            for (int m = 0; m < 4; ++m) sv[ai * 4 + m] = ss[row0 + ai * HALF + m * 16];
    }
    __device__ __forceinline__ void operator()(const f32x4 (&acc)[2][2][4][2], const Unit& u, int wr, int wc, int fr, int fq, const float (&sv)[8]) const {
        const int row0 = u.pm * BM + wr * 64 + fr, col0 = u.pn * HALF + wc * 32 + 8 * fq;
#pragma unroll
        for (int ai = 0; ai < 2; ++ai)
#pragma unroll
            for (int m = 0; m < 4; ++m) {
                const int row = row0 + ai * HALF + m * 16;
                const float rinv = __builtin_amdgcn_rsqf(sv[ai * 4 + m] * (1.f / DM) + EPS), rneg = rinv * -1.44269504f, r2 = rinv * rinv;
                const f32x4 g0 = acc[ai][0][m][0], g1 = acc[ai][0][m][1], u0 = acc[ai][1][m][0], u1 = acc[ai][1][m][1];
                f32x4 e0, e1;
#pragma unroll
                for (int j = 0; j < 4; ++j) { e0[j] = __builtin_amdgcn_rcpf(1.f + __builtin_amdgcn_exp2f(g0[j] * rneg)); e1[j] = __builtin_amdgcn_rcpf(1.f + __builtin_amdgcn_exp2f(g1[j] * rneg)); }
                const f32x4 a0 = (g0 * u0) * (e0 * r2), a1 = (g1 * u1) * (e1 * r2);
                u32x4 w;
                w.x = cvt_pk_bf16(a0[0], a0[1]); w.y = cvt_pk_bf16(a0[2], a0[3]); w.z = cvt_pk_bf16(a1[0], a1[1]); w.w = cvt_pk_bf16(a1[2], a1[3]);
                *(u32x4*)(O + (size_t)row * DFF + col0) = w;
            }
    }
};
struct EpiScaleBf16 {
    static constexpr bool PERM = true, AFTER_DRAIN = false, PREF = true;
    bf16_t* O; int ldc; const float* ss;
    __device__ __forceinline__ void prefetch(const Unit& u, int wr, int fr, float (&sv)[8]) const {
        const int row0 = u.pm * BM + wr * 64 + fr;
#pragma unroll
        for (int ai = 0; ai < 2; ++ai)
#pragma unroll
            for (int m = 0; m < 4; ++m) sv[ai * 4 + m] = ss[row0 + ai * HALF + m * 16];
    }
    __device__ __forceinline__ void operator()(const f32x4 (&acc)[2][2][4][2], const Unit& u, int wr, int wc, int fr, int fq, const float (&sv)[8]) const {
        const int row0 = u.pm * BM + wr * 64 + fr, col0 = u.pn * BM + wc * 32 + 8 * fq;
#pragma unroll
        for (int ai = 0; ai < 2; ++ai)
#pragma unroll
            for (int m = 0; m < 4; ++m) {
                const int row = row0 + ai * HALF + m * 16;
                const float rinv = __builtin_amdgcn_rsqf(sv[ai * 4 + m] * (1.f / DM) + EPS);
                bf16_t* rowp = O + (size_t)row * ldc + col0;
#pragma unroll
                for (int bj = 0; bj < 2; ++bj) { const f32x4 v0 = acc[ai][bj][m][0] * rinv, v1 = acc[ai][bj][m][1] * rinv;
                    u32x4 w; w.x = cvt_pk_bf16(v0[0], v0[1]); w.y = cvt_pk_bf16(v0[2], v0[3]); w.z = cvt_pk_bf16(v1[0], v1[1]); w.w = cvt_pk_bf16(v1[2], v1[3]);
                    *(u32x4*)(rowp + bj * HALF) = w; }
            }
    }
};
struct EpiResid {
    static constexpr bool PERM = true, AFTER_DRAIN = false, PREF = false;
    bf16_t* hb; float* ssn; float scale;
    __device__ __forceinline__ void prefetch(const Unit&, int, int, float (&)[8]) const {}
    __device__ __forceinline__ void operator()(const f32x4 (&acc)[2][2][4][2], const Unit& u, int wr, int wc, int fr, int fq, const float (&)[8]) const {
        const int row0 = u.pm * BM + wr * 64 + fr, col0 = u.pn * BM + wc * 32 + 8 * fq;
        bf16_t* bp0 = hb + (size_t)row0 * DM + col0;
        u32x4 b[2][4][2];
#pragma unroll
        for (int ai = 0; ai < 2; ++ai)
#pragma unroll
            for (int m = 0; m < 4; ++m)
#pragma unroll
                for (int bj = 0; bj < 2; ++bj) b[ai][m][bj] = *(const u32x4*)(bp0 + (size_t)(ai * HALF + m * 16) * DM + bj * HALF);
#pragma unroll
        for (int ai = 0; ai < 2; ++ai) {
#pragma unroll
            for (int m = 0; m < 4; ++m) {
                const int row = row0 + ai * HALF + m * 16;
                float s = 0.f;
#pragma unroll
                for (int bj = 0; bj < 2; ++bj) { const u32x4 bb = b[ai][m][bj];
                    const f32x4 b0 = (f32x4){bf_lo(bb.x), bf_hi(bb.x), bf_lo(bb.y), bf_hi(bb.y)}, b1 = (f32x4){bf_lo(bb.z), bf_hi(bb.z), bf_lo(bb.w), bf_hi(bb.w)};
                    const f32x4 h0 = b0 + acc[ai][bj][m][0] * scale, h1 = b1 + acc[ai][bj][m][1] * scale;
                    u32x4 w; w.x = cvt_pk_bf16(h0[0], h0[1]); w.y = cvt_pk_bf16(h0[2], h0[3]); w.z = cvt_pk_bf16(h1[0], h1[1]); w.w = cvt_pk_bf16(h1[2], h1[3]);
                    *(u32x4*)(bp0 + (size_t)(ai * HALF + m * 16) * DM + bj * HALF) = w;
                    const f32x4 r0 = (f32x4){bf_lo(w.x), bf_hi(w.x), bf_lo(w.y), bf_hi(w.y)}, r1 = (f32x4){bf_lo(w.z), bf_hi(w.z), bf_lo(w.w), bf_hi(w.w)};
                    s += (r0[0] * r0[0] + r0[1] * r0[1]) + (r0[2] * r0[2] + r0[3] * r0[3]) + (r1[0] * r1[0] + r1[1] * r1[1]) + (r1[2] * r1[2] + r1[3] * r1[3]); }
                s += __shfl_xor(s, 16); s += __shfl_xor(s, 32);
                if (fq == 0) ssn[(size_t)row * 32 + u.pn * 4 + wc] = s;
            }
        }
    }
};

struct SplitOrder {
    int c, kslice;
    __device__ __forceinline__ bool next(int i, Unit& u) const {
        if (i != 0 || c >= 64) return false;
        u.pm = 64 + (c & 1); u.pn = (c >> 1) & 7; u.kb = (c >> 4) * kslice; return true;
    }
    __device__ __forceinline__ void a_ready(const Unit&) const {}
    __device__ __forceinline__ void done(const Unit&) const {}
};
struct EpiSlab {
    static constexpr bool PERM = true, AFTER_DRAIN = false;
    static constexpr bool PREF = false;
    float* slab; float scale; int kslice;
    __device__ __forceinline__ void prefetch(const Unit&, int, int, float (&)[8]) const {}
    __device__ __forceinline__ void operator()(const f32x4 (&acc)[2][2][4][2], const Unit& u, int wr, int wc, int fr, int fq, const float (&)[8]) const {
        const int row0 = (u.pm - 64) * BM + wr * 64 + fr, col0 = u.pn * BM + wc * 32 + 8 * fq;
        float* sp = slab + (size_t)(u.kb / kslice) * (MS * DM);
#pragma unroll
        for (int ai = 0; ai < 2; ++ai)
#pragma unroll
            for (int m = 0; m < 4; ++m) { float* rp = sp + (size_t)(row0 + ai * HALF + m * 16) * DM + col0;
#pragma unroll
                for (int bj = 0; bj < 2; ++bj)
#pragma unroll
                    for (int n = 0; n < 2; ++n) *(f32x4*)(rp + bj * HALF + n * 4) = acc[ai][bj][m][n] * scale; }
    }
};

template <class Epi, class Sched, bool ALIGN_EPI = false, bool SP2 = false>
__device__ __forceinline__ void gemm_phase(LAS unsigned char* lds, const Gemm g, const Sched& S, const Epi& E) {
    int tid = threadIdx.x; asm volatile("" : "+v"(tid));
    const int wid = __builtin_amdgcn_readfirstlane(tid >> 6), lane = tid & 63, wr = wid >> 2, wc = wid & 3, fr = lane & 15, fq = lane >> 4;
    const int K = g.K, nt = g.nt;
    unsigned voffA[2], voffB[2];
#pragma unroll
    for (int i = 0; i < 2; ++i) { int R, C; stage_rc(tid * 16 + i * 8192, R, C); const int Rb = Epi::PERM ? ((R & ~31) + perm32(R & 31)) : R;
        voffA[i] = (unsigned)(R * K + C) * 2u; voffB[i] = (unsigned)(Rb * K + C) * 2u; }
    const size_t kstep = (size_t)(BK * 2);
    const size_t hstep = (size_t)HALF * K * 2;
    const size_t tstep = 2 * hstep;
    const unsigned ldsw = (unsigned)wid * 1024u;
    const int aoff = lds_byte(wr * 64 + fr, fq * 8), boff = lds_byte(wc * 32 + fr, fq * 8);
#define PG8_SA(b, h) (((b) * 2 + (h)) * HTB)
#define PG8_SB(b, h) ((4 + (b) * 2 + (h)) * HTB)
#define PG8_STAGE(bufoff, gbase, voff) do { _Pragma("unroll") for (int _i = 0; _i < 2; ++_i) \
        __builtin_amdgcn_global_load_lds((const unsigned*)((const char*)(gbase) + (voff)[_i]), (LAS unsigned*)(lds + (bufoff) + ldsw + _i * 8192), 16, 0, 0); } while (0)
#define PG8_LDA(dst, b, h) do { _Pragma("unroll") for (int m = 0; m < 4; ++m) _Pragma("unroll") for (int k = 0; k < 2; ++k) dst[m][k] = *(const LAS bf16x8*)(lds + PG8_SA(b, h) + aoff + m * 2048 + k * 1024); } while (0)
#define PG8_LDB(dst, b, h) do { _Pragma("unroll") for (int n = 0; n < 2; ++n) _Pragma("unroll") for (int k = 0; k < 2; ++k) dst[n][k] = *(const LAS bf16x8*)(lds + PG8_SB(b, h) + boff + n * 2048 + k * 1024); } while (0)
#define PG8_MMA(ai, bj, At, Bt) do { __builtin_amdgcn_s_setprio(1); _Pragma("unroll") for (int m = 0; m < 4; ++m) _Pragma("unroll") for (int n = 0; n < 2; ++n) _Pragma("unroll") for (int k = 0; k < 2; ++k) \
        acc[ai][bj][m][n] = __builtin_amdgcn_mfma_f32_16x16x32_bf16(Bt[n][k], At[m][k], acc[ai][bj][m][n], 0, 0, 0); __builtin_amdgcn_s_setprio(0); } while (0)
#define PG8_WAIT_V(n) asm volatile("s_waitcnt vmcnt(" #n ")" ::: "memory")
#define PG8_WAIT_L(n) asm volatile("s_waitcnt lgkmcnt(" #n ")" ::: "memory")
#define PG8_BAR __builtin_amdgcn_s_barrier()
#define PG8_SCHED __builtin_amdgcn_sched_barrier(0)
    Unit cur, nxt; int ui = 0;
    if (!S.next(0, cur)) return;
    f32x4 acc[2][2][4][2];
#pragma unroll
    for (int a = 0; a < 2; ++a)
#pragma unroll
        for (int b = 0; b < 2; ++b)
#pragma unroll
            for (int m = 0; m < 4; ++m)
#pragma unroll
                for (int n = 0; n < 2; ++n) acc[a][b][m][n] = (f32x4){0.f, 0.f, 0.f, 0.f};
    bf16x8 At[4][2], B0[2][2], B1[2][2];
    const char* cA = (const char*)g.A + (size_t)cur.pm * tstep + cur.kb; const char* cB = (const char*)g.Bt + (size_t)cur.pn * tstep + cur.kb;
    S.a_ready(cur);
    float sv[8];
#define PG8_SS_DMA(u, buf) do { if constexpr (Epi::PREF) { if (wid == 0) __builtin_amdgcn_global_load_lds((const unsigned*)(E.ss + (size_t)(u).pm * BM + 4 * lane), (LAS unsigned*)(lds + STAGE_BYTES + (buf) * 1024), 16, 0, 0); } } while (0)
    PG8_SS_DMA(cur, 0);
    if constexpr (SP2) {
        PG8_STAGE(PG8_SB(0, 0), cB, voffB); PG8_STAGE(PG8_SB(0, 1), cB + hstep, voffB); PG8_STAGE(PG8_SA(0, 0), cA, voffA); PG8_STAGE(PG8_SA(0, 1), cA + hstep, voffA);
        if (wr == 1) PG8_BAR;
        PG8_WAIT_V(2); PG8_BAR;
        PG8_STAGE(PG8_SB(1, 0), cB + kstep, voffB); PG8_STAGE(PG8_SA(1, 0), cA + kstep, voffA); PG8_STAGE(PG8_SB(1, 1), cB + hstep + kstep, voffB);
        PG8_WAIT_V(6); PG8_BAR;
    } else {
        PG8_STAGE(PG8_SB(0, 0), cB, voffB); PG8_STAGE(PG8_SA(0, 0), cA, voffA); PG8_STAGE(PG8_SB(0, 1), cB + hstep, voffB); PG8_STAGE(PG8_SA(0, 1), cA + hstep, voffA);
        if (wr == 1) PG8_BAR;
        PG8_WAIT_V(4); PG8_BAR;
        PG8_STAGE(PG8_SB(1, 0), cB + kstep, voffB); PG8_STAGE(PG8_SA(1, 0), cA + kstep, voffA); PG8_STAGE(PG8_SB(1, 1), cB + hstep + kstep, voffB);
        PG8_WAIT_V(6); PG8_BAR;
    }
    for (;;) {
        const bool has_next = S.next(ui + 1, nxt);
        const char* nA = has_next ? (const char*)g.A + (size_t)nxt.pm * tstep + nxt.kb : cA; const char* nB = has_next ? (const char*)g.Bt + (size_t)nxt.pn * tstep + nxt.kb : cB;
        for (int t = 0; t < nt; t += 2) {
            const bool last = (t == nt - 2);
            const char* a1 = cA + (size_t)(t + 1) * kstep;
            const char* a2 = last ? nA : cA + (size_t)(t + 2) * kstep; const char* b2 = last ? nB : cB + (size_t)(t + 2) * kstep;
            const char* a3 = a2 + kstep; const char* b3 = b2 + kstep;
            if (last && has_next) S.a_ready(nxt);
            if constexpr (SP2) {
            PG8_LDB(B0, 0, 0); PG8_LDB(B1, 0, 1); PG8_SCHED; PG8_LDA(At, 0, 0); PG8_STAGE(PG8_SA(1, 1), a1 + hstep, voffA);
            PG8_WAIT_V(8); PG8_WAIT_L(0); PG8_BAR; PG8_MMA(0, 0, At, B0); PG8_MMA(0, 1, At, B1); PG8_BAR; PG8_SCHED;
            PG8_LDA(At, 0, 1); PG8_STAGE(PG8_SB(0, 0), b2, voffB); PG8_STAGE(PG8_SB(0, 1), b2 + hstep, voffB); PG8_STAGE(PG8_SA(0, 0), a2, voffA);
            PG8_WAIT_V(8); PG8_WAIT_L(0); PG8_BAR; PG8_MMA(1, 0, At, B0); PG8_MMA(1, 1, At, B1); PG8_BAR; PG8_SCHED;
            PG8_LDB(B0, 1, 0); PG8_LDB(B1, 1, 1); PG8_SCHED; PG8_LDA(At, 1, 0); PG8_STAGE(PG8_SA(0, 1), a2 + hstep, voffA);
            PG8_WAIT_V(8); PG8_WAIT_L(0); PG8_BAR; PG8_MMA(0, 0, At, B0); PG8_MMA(0, 1, At, B1); PG8_BAR; PG8_SCHED;
            PG8_LDA(At, 1, 1); PG8_STAGE(PG8_SB(1, 0), b3, voffB); PG8_STAGE(PG8_SB(1, 1), b3 + hstep, voffB); PG8_STAGE(PG8_SA(1, 0), a3, voffA);
            PG8_WAIT_V(8); PG8_WAIT_L(0); PG8_BAR; PG8_MMA(1, 0, At, B0); PG8_MMA(1, 1, At, B1); PG8_BAR; PG8_SCHED;
            } else {
            PG8_LDB(B0, 0, 0); PG8_SCHED; PG8_LDA(At, 0, 0); PG8_STAGE(PG8_SA(1, 1), a1 + hstep, voffA);
            PG8_WAIT_L(8); PG8_BAR; PG8_WAIT_L(0); PG8_MMA(0, 0, At, B0); PG8_BAR; PG8_SCHED;
            PG8_LDB(B1, 0, 1); PG8_STAGE(PG8_SB(0, 0), b2, voffB);
            PG8_BAR; PG8_WAIT_L(0); PG8_MMA(0, 1, At, B1); PG8_BAR;
            PG8_LDA(At, 0, 1); PG8_STAGE(PG8_SA(0, 0), a2, voffA);
            PG8_BAR; PG8_WAIT_L(0); PG8_MMA(1, 0, At, B0); PG8_BAR; PG8_SCHED;
            PG8_STAGE(PG8_SB(0, 1), b2 + hstep, voffB);
            PG8_WAIT_V(6); PG8_BAR; PG8_MMA(1, 1, At, B1); PG8_BAR;
            PG8_LDB(B0, 1, 0); PG8_SCHED; PG8_LDA(At, 1, 0); PG8_STAGE(PG8_SA(0, 1), a2 + hstep, voffA);
            PG8_WAIT_L(8); PG8_BAR; PG8_WAIT_L(0); PG8_MMA(0, 0, At, B0); PG8_BAR; PG8_SCHED;
            PG8_LDB(B1, 1, 1); PG8_STAGE(PG8_SB(1, 0), b3, voffB);
            PG8_BAR; PG8_WAIT_L(0); PG8_MMA(0, 1, At, B1); PG8_BAR;
            PG8_LDA(At, 1, 1); PG8_STAGE(PG8_SA(1, 0), a3, voffA);
            PG8_BAR; PG8_WAIT_L(0); PG8_MMA(1, 0, At, B0); PG8_BAR; PG8_SCHED;
            PG8_STAGE(PG8_SB(1, 1), b3 + hstep, voffB);
            PG8_WAIT_V(6); PG8_BAR; PG8_MMA(1, 1, At, B1); PG8_BAR;
            }
        }
        if constexpr (ALIGN_EPI) { if (wr == 0) PG8_BAR; }
        if constexpr (Epi::PREF) {
#pragma unroll
            for (int ai = 0; ai < 2; ++ai)
#pragma unroll
                for (int m = 0; m < 4; ++m) sv[ai * 4 + m] = *(const LAS float*)(lds + STAGE_BYTES + (ui & 1) * 1024 + 4 * (ai * HALF + wr * 64 + m * 16 + fr));
        }
        if constexpr (!Epi::AFTER_DRAIN) { E(acc, cur, wr, wc, fr, fq, sv); S.done(cur); }
        if (!has_next) break;
#pragma unroll
        for (int a = 0; a < 2; ++a)
#pragma unroll
            for (int b = 0; b < 2; ++b)
#pragma unroll
                for (int m = 0; m < 4; ++m)
#pragma unroll
                    for (int n = 0; n < 2; ++n) acc[a][b][m][n] = (f32x4){0.f, 0.f, 0.f, 0.f};
        cur = nxt; cA = nA; cB = nB; ++ui;
        PG8_SS_DMA(cur, ui & 1);
        if constexpr (ALIGN_EPI) { if (wr == 1) PG8_BAR; }
    }
    PG8_WAIT_V(0);
    if constexpr (!ALIGN_EPI) { if (wr == 0) PG8_BAR; }
    PG8_BAR;
#undef PG8_SS_DMA
#undef PG8_SA
#undef PG8_SB
#undef PG8_STAGE
#undef PG8_LDA
#undef PG8_LDB
#undef PG8_MMA
#undef PG8_WAIT_V
#undef PG8_WAIT_L
#undef PG8_BAR
#undef PG8_SCHED
}
}

struct Params { const float* in[24]; float* out; unsigned char* ws; };
enum { I_XP = 0, I_XS, I_CA, I_CB, I_CP, I_N1, I_WG1, I_WU1, I_WD1, I_NM, I_WIN, I_CAW, I_CBW, I_CBB, I_LNG, I_LNB, I_PW, I_PS, I_WOUT, I_N2, I_WG2, I_WU2, I_WD2, I_NF };

__device__ __forceinline__ void tr_item(const float* W, int N, const float* gk, bf16_t* WT, int ldk, int drow0, int k0, int n0, LAS float* scr, int lane) {
    const int l16 = lane & 15, kq = lane >> 4;
    f32x4 v[16];
#pragma unroll
    for (int i = 0; i < 16; ++i) v[i] = *(const f32x4*)(W + (size_t)(k0 + 4 * i + kq) * N + n0 + 4 * l16);
    if (gk) {
#pragma unroll
        for (int i = 0; i < 16; ++i) v[i] = v[i] * gk[k0 + 4 * i + kq]; }
#pragma unroll
    for (int i = 0; i < 16; ++i) { LAS float* d = scr + (4 * i + kq) * 65 + 4 * l16; d[0] = v[i][0]; d[1] = v[i][1]; d[2] = v[i][2]; d[3] = v[i][3]; }
    LDS_WAIT(); asm volatile("" ::: "memory");
    const int c = lane & 7;
#pragma unroll
    for (int j = 0; j < 8; ++j) { const int n = (lane >> 3) + 8 * j; const LAS float* s = scr + (8 * c) * 65 + n;
        u32x4 o; o.x = cvt_pk_bf16(s[0 * 65], s[1 * 65]); o.y = cvt_pk_bf16(s[2 * 65], s[3 * 65]); o.z = cvt_pk_bf16(s[4 * 65], s[5 * 65]); o.w = cvt_pk_bf16(s[6 * 65], s[7 * 65]);
        *(u32x4*)(WT + (size_t)(drow0 + n) * ldk + k0 + 8 * c) = o; }
    LDS_WAIT(); asm volatile("" ::: "memory");
}

__device__ __forceinline__ void prologue(const Params& p, LAS unsigned char* lds, int G) {
    const int tid = threadIdx.x, lane = tid & 63, wave = __builtin_amdgcn_readfirstlane(tid >> 6);
    const int gw = blockIdx.x * 8 + wave, NGW = G * 8;
    float* ss = (float*)(p.ws + WS_SS);
    for (int b = blockIdx.x; b < 256; b += G) {
        const int layer = b >> 7, g = (b >> 5) & 3, n0 = (b & 31) * 64;
        LAS float* Bs = (LAS float*)lds;
        LAS float* As = (LAS float*)(lds + 32768);
        const float* wo = p.in[I_WOUT] + (size_t)layer * DM * DM + (size_t)(1536 + g * 128) * DM + n0;
        const float* ps = p.in[I_PS] + layer * DC + g * 128;
        const float* pw = p.in[I_PW] + (size_t)(layer * 4 + g) * 128 * 128;
#pragma unroll
        for (int i = 0; i < 4; ++i) { const int e = (i * 512 + tid) * 4, d = e >> 6, n = e & 63; const f32x4 v = *(const f32x4*)(wo + (size_t)d * DM + n) * ps[d]; *(LAS f32x4*)(Bs + d * 64 + n) = v; }
#pragma unroll
        for (int i = 0; i < 8; ++i) { const int e = (i * 512 + tid) * 4, c = e >> 7, d = e & 127; const f32x4 v = *(const f32x4*)(pw + e); LAS float* dp = As + c * 129 + d; dp[0] = v[0]; dp[1] = v[1]; dp[2] = v[2]; dp[3] = v[3]; }
        __syncthreads();
        float a[16];
#pragma unroll
        for (int i = 0; i < 16; ++i) a[i] = 0.f;
        for (int d = 0; d < 128; ++d) { const float bv = Bs[d * 64 + lane];
#pragma unroll
            for (int i = 0; i < 16; ++i) a[i] += As[(wave * 16 + i) * 129 + d] * bv; }
        bf16_t* dst = (bf16_t*)(p.ws + WS_W + (size_t)layer * W_LAYER + W_OUT) + (size_t)(n0 + lane) * DM + 1536 + g * 128 + wave * 16;
        u32x4 o0, o1;
        o0.x = cvt_pk_bf16(a[0], a[1]); o0.y = cvt_pk_bf16(a[2], a[3]); o0.z = cvt_pk_bf16(a[4], a[5]); o0.w = cvt_pk_bf16(a[6], a[7]);
        o1.x = cvt_pk_bf16(a[8], a[9]); o1.y = cvt_pk_bf16(a[10], a[11]); o1.z = cvt_pk_bf16(a[12], a[13]); o1.w = cvt_pk_bf16(a[14], a[15]);
        *(u32x4*)dst = o0; *(u32x4*)(dst + 8) = o1;
        __syncthreads();
    }
    LAS float* scr = (LAS float*)(lds + wave * 16640);
    constexpr int PER_LAYER = 2816 * 6 + 2176 + 768;
#pragma unroll 1
    for (int it = gw; it < 2 * PER_LAYER; it += NGW) {
        const int layer = it >= PER_LAYER ? 1 : 0; int r = it - layer * PER_LAYER;
        unsigned char* wl = p.ws + WS_W + (size_t)layer * W_LAYER;
        const float* W; const float* gk = nullptr; bf16_t* WT; int N, ldk, nnb, kind = 0;
        if (r < 2816) { W = p.in[I_WG1] + (size_t)layer * DM * DFF; gk = p.in[I_N1] + layer * DM; WT = (bf16_t*)(wl + W_GU1); N = DFF; ldk = DM; nnb = 88; kind = 1; }
        else if ((r -= 2816) < 2816) { W = p.in[I_WU1] + (size_t)layer * DM * DFF; gk = p.in[I_N1] + layer * DM; WT = (bf16_t*)(wl + W_GU1); N = DFF; ldk = DM; nnb = 88; kind = 2; }
        else if ((r -= 2816) < 2816) { W = p.in[I_WD1] + (size_t)layer * DFF * DM; WT = (bf16_t*)(wl + W_D1); N = DM; ldk = DFF; nnb = 32; }
        else if ((r -= 2816) < 2176) { W = p.in[I_WIN] + (size_t)layer * DM * DIN; gk = p.in[I_NM] + layer * DM; WT = (bf16_t*)(wl + W_IN); N = DIN; ldk = DM; nnb = 68; }
        else if ((r -= 2176) < 768) { W = p.in[I_WOUT] + (size_t)layer * DM * DM; WT = (bf16_t*)(wl + W_OUT); N = DM; ldk = DM; nnb = 32; }
        else if ((r -= 768) < 2816) { W = p.in[I_WG2] + (size_t)layer * DM * DFF; gk = p.in[I_N2] + layer * DM; WT = (bf16_t*)(wl + W_GU2); N = DFF; ldk = DM; nnb = 88; kind = 1; }
        else if ((r -= 2816) < 2816) { W = p.in[I_WU2] + (size_t)layer * DM * DFF; gk = p.in[I_N2] + layer * DM; WT = (bf16_t*)(wl + W_GU2); N = DFF; ldk = DM; nnb = 88; kind = 2; }
        else { r -= 2816; W = p.in[I_WD2] + (size_t)layer * DFF * DM; WT = (bf16_t*)(wl + W_D2); N = DM; ldk = DFF; nnb = 32; }
        const int kb = r / nnb, nb = r - kb * nnb, k0 = kb * 64, n0 = nb * 64;
        const int drow0 = kind ? ((n0 >> 7) * 256 + (kind - 1) * 128 + (n0 & 127)) : n0;
        tr_item(W, N, gk, WT, ldk, drow0, k0, n0, scr, lane);
    }
    bf16_t* hb = (bf16_t*)(p.ws + WS_HB);
    for (int m = gw; m < MT; m += NGW) {
        const float* xr = (m < MP) ? p.in[I_XP] + (size_t)m * DM : p.in[I_XS] + (size_t)(m - MP) * DM;
        float s = 0.f;
#pragma unroll
        for (int j = 0; j < 4; ++j) { const f32x4 v0 = *(const f32x4*)(xr + j * 512 + lane * 8), v1 = *(const f32x4*)(xr + j * 512 + lane * 8 + 4);
            s += (v0[0] * v0[0] + v0[1] * v0[1]) + (v0[2] * v0[2] + v0[3] * v0[3]) + (v1[0] * v1[0] + v1[1] * v1[1]) + (v1[2] * v1[2] + v1[3] * v1[3]);
            u32x4 w; w.x = cvt_pk_bf16(v0[0], v0[1]); w.y = cvt_pk_bf16(v0[2], v0[3]); w.z = cvt_pk_bf16(v1[0], v1[1]); w.w = cvt_pk_bf16(v1[2], v1[3]);
            *(u32x4*)(hb + (size_t)m * DM + j * 512 + lane * 8) = w; }
        s = wave_sum(s);
        if (lane == 0) ss[m] = s;
    }
}

__device__ __forceinline__ void ld8_bf16(const bf16_t* p, float (&v)[8]) {
    const u32x4 w = *(const u32x4*)p;
    v[0] = bf_lo(w.x); v[1] = bf_hi(w.x); v[2] = bf_lo(w.y); v[3] = bf_hi(w.y); v[4] = bf_lo(w.z); v[5] = bf_hi(w.z); v[6] = bf_lo(w.w); v[7] = bf_hi(w.w);
}
__device__ __forceinline__ void ld8_f32(const float* p, float (&v)[8]) {
    const f32x4 a = *(const f32x4*)p, b = *(const f32x4*)(p + 4);
    v[0] = a[0]; v[1] = a[1]; v[2] = a[2]; v[3] = a[3]; v[4] = b[0]; v[5] = b[1]; v[6] = b[2]; v[7] = b[3];
}
__device__ __forceinline__ void st8_f32(float* p, const float (&v)[8]) {
    *(f32x4*)p = (f32x4){v[0], v[1], v[2], v[3]}; *(f32x4*)(p + 4) = (f32x4){v[4], v[5], v[6], v[7]};
}
__device__ __forceinline__ void st8_bf16(bf16_t* p, const float (&v)[8]) {
    u32x4 w; w.x = cvt_pk_bf16(v[0], v[1]); w.y = cvt_pk_bf16(v[2], v[3]); w.z = cvt_pk_bf16(v[4], v[5]); w.w = cvt_pk_bf16(v[6], v[7]);
    *(u32x4*)p = w;
}

constexpr int TOK = 16, HALO = 30, VROWS = TOK + HALO, CH = 384;
__device__ __forceinline__ void mixer_mid(const Params& p, LAS unsigned char* lds, int G, int layer) {
    int tid = threadIdx.x; asm volatile("" : "+v"(tid));
    const int lane = tid & 63, wave = __builtin_amdgcn_readfirstlane(tid >> 6);
    LAS float* vt = (LAS float*)lds;
    LAS float* cb = (LAS float*)(lds + VROWS * CH * 4);
    const bf16_t* z = (const bf16_t*)(p.ws + WS_ACT);
    bf16_t* cat = (bf16_t*)(p.ws + WS_CAT);
    const float* caw = p.in[I_CAW] + layer * 3 * DA;
    const float* cbw = p.in[I_CBW] + layer * 31 * DB;
    const float* cbb = p.in[I_CBB] + layer * DB;
    const float* lng = p.in[I_LNG] + layer * DB;
    const float* lnb = p.in[I_LNB] + layer * DB;
    constexpr int NCH = MT / TOK, NCH_X = NCH / 8;
    static_assert(NCH % 8 == 0, "chunks divide over the XCDs");
    const int mx_x = (G % 8 == 0) ? (int)(blockIdx.x & 7) : 0, mx_r = (G % 8 == 0) ? (int)(blockIdx.x >> 3) : (int)blockIdx.x, mx_n = (G % 8 == 0) ? G / 8 : G, mx_tot = (G % 8 == 0) ? NCH_X : NCH;
    u32x4 ra[5], rg[5]; bool preloaded = false;
#define MIX_VLOAD(hc_, row0_) do { _Pragma("unroll") for (int i = 0; i < 5; ++i) { const int it = tid + 512 * i; if (it < VROWS * (CH / 8)) { const int j = it / (CH / 8), cl = (it - j * (CH / 8)) * 8; \
            const bf16_t* zr = z + ((ptrdiff_t)(row0_) - HALO + j) * DIN + (hc_) * CH + cl; ra[i] = *(const u32x4*)(zr + 2304); rg[i] = *(const u32x4*)(zr + 3072); } } } while (0)
    for (int ci = mx_r; ci < mx_tot; ci += mx_n) {
        const int ch = mx_x * NCH_X + ci;
        const bool samp = ch >= MP / TOK;
        int seq, l0, L;
        if (!samp) { seq = ch >> 9; l0 = (ch & 511) * TOK; L = 8192; } else { const int cs = ch - MP / TOK; seq = cs >> 2; l0 = (cs & 3) * TOK; L = 64; }
        const int row0 = ch * TOK;
        const bool lastc = (l0 + TOK == L), edge = (l0 < 32);
        const float* hist_a = p.in[I_CA] + (size_t)(layer * 8 + seq) * 2 * DA;
        const float* hist_b = p.in[I_CB] + (size_t)(layer * 8 + seq) * 30 * DB;
        const float* hist_p = p.in[I_CP] + (size_t)(layer * 8 + seq) * 15 * DC;
        float* out_a = p.out + (samp ? OFF_A_S + (layer * 8 + seq) * 2 * DA : OFF_A_P + (layer * 2 + seq) * 2 * DA);
        float* out_b = p.out + (samp ? OFF_B_S + (layer * 8 + seq) * 30 * DB : OFF_B_P + (layer * 2 + seq) * 30 * DB);
        float* out_p = p.out + (samp ? OFF_P_S + (layer * 8 + seq) * 15 * DC : OFF_P_P + (layer * 2 + seq) * 15 * DC);
        if (!preloaded) MIX_VLOAD(0, row0);
        preloaded = false;
#pragma unroll 1
        for (int hc = 0; hc < 2; ++hc) {
#pragma unroll
            for (int i = 0; i < 5; ++i) { const int it = tid + 512 * i; if (it < VROWS * (CH / 8)) { const int j = it / (CH / 8), cl = (it - j * (CH / 8)) * 8, c8 = hc * CH + cl;
                float v[8];
                v[0] = bf_lo(ra[i].x) * sigmoidf_(bf_lo(rg[i].x)); v[1] = bf_hi(ra[i].x) * sigmoidf_(bf_hi(rg[i].x));
                v[2] = bf_lo(ra[i].y) * sigmoidf_(bf_lo(rg[i].y)); v[3] = bf_hi(ra[i].y) * sigmoidf_(bf_hi(rg[i].y));
                v[4] = bf_lo(ra[i].z) * sigmoidf_(bf_lo(rg[i].z)); v[5] = bf_hi(ra[i].z) * sigmoidf_(bf_hi(rg[i].z));
                v[6] = bf_lo(ra[i].w) * sigmoidf_(bf_lo(rg[i].w)); v[7] = bf_hi(ra[i].w) * sigmoidf_(bf_hi(rg[i].w));
                if (edge) { const int l = l0 - HALO + j;
                    if (l < 0) { if (samp) ld8_f32(hist_b + (size_t)(30 + l) * DB + c8, v); else {
#pragma unroll
                        for (int e = 0; e < 8; ++e) v[e] = 0.f; } } }
                *(LAS f32x4*)(vt + j * CH + cl) = (f32x4){v[0], v[1], v[2], v[3]}; *(LAS f32x4*)(vt + j * CH + cl + 4) = (f32x4){v[4], v[5], v[6], v[7]};
                if (lastc && j >= TOK) st8_f32(out_b + (size_t)(j - TOK) * DB + c8, v); } }
            if (hc == 0) MIX_VLOAD(1, row0);
            else {
#pragma unroll
                for (int i = 0; i < 4; ++i) { const int it = tid + 512 * i; if (it < 31 * 64) { const int j = it >> 6, c8 = (it & 63) * 8; ra[i] = *(const u32x4*)(z + ((ptrdiff_t)row0 - 15 + j) * DIN + 3840 + c8); } } }
            __syncthreads();
            if (tid < CH) {
                const int c = hc * CH + tid;
                float wv[31];
#pragma unroll
                for (int k = 0; k < 31; ++k) wv[k] = cbw[k * DB + c];
                const float bias = cbb[c];
                float o[TOK];
#pragma unroll
                for (int i = 0; i < TOK; ++i) o[i] = bias;
                const LAS float* vp = vt + tid;
#pragma unroll
                for (int jj = 0; jj < VROWS; ++jj) { const float x = vp[jj * CH];
#pragma unroll
                    for (int i = 0; i < TOK; ++i) { if (jj - i >= 0 && jj - i <= 30) o[i] += wv[(jj - i >= 0 && jj - i <= 30) ? jj - i : 0] * x; } }
#pragma unroll
                for (int i = 0; i < TOK; ++i) cb[i * DB + c] = o[i];
            }
            __syncthreads();
        }
#pragma unroll
        for (int i = 0; i < 4; ++i) { const int it = tid + 512 * i; if (it < 31 * 64) { const int j = it >> 6, c8 = (it & 63) * 8; const u32x4 r = ra[i];
            float u[8] = {bf_lo(r.x), bf_hi(r.x), bf_lo(r.y), bf_hi(r.y), bf_lo(r.z), bf_hi(r.z), bf_lo(r.w), bf_hi(r.w)};
            if (edge) { const int l = l0 - 15 + j;
                if (l < 0) { if (samp) ld8_f32(hist_p + (size_t)(15 + l) * DC + c8, u); else {
#pragma unroll
                    for (int e = 0; e < 8; ++e) u[e] = 0.f; } } }
            *(LAS f32x4*)(vt + j * DC + c8) = (f32x4){u[0], u[1], u[2], u[3]}; *(LAS f32x4*)(vt + j * DC + c8 + 4) = (f32x4){u[4], u[5], u[6], u[7]}; } }
        { const int cin = ci + mx_n;
          if (cin < mx_tot) { MIX_VLOAD(0, (mx_x * NCH_X + cin) * TOK); preloaded = true; } }
#pragma unroll 1
        for (int tt = 0; tt < 2; ++tt) { const int tk = wave * 2 + tt; f32x2 x[6]; float s = 0.f;
#pragma unroll
            for (int i = 0; i < 6; ++i) { x[i] = *(const LAS f32x2*)(cb + tk * DB + 128 * i + 2 * lane); s += x[i].x + x[i].y; }
            const float mean = wave_sum(s) * (1.f / DB); float q2 = 0.f;
#pragma unroll
            for (int i = 0; i < 6; ++i) { x[i].x -= mean; x[i].y -= mean; q2 += x[i].x * x[i].x + x[i].y * x[i].y; }
            const float rstd = __builtin_amdgcn_rsqf(wave_sum(q2) * (1.f / DB) + EPS);
#pragma unroll
            for (int i = 0; i < 6; ++i) { const int c = 128 * i + 2 * lane; const f32x2 gg = *(const f32x2*)(lng + c), bb = *(const f32x2*)(lnb + c);
                const float y0 = siluf_(x[i].x * rstd * gg.x + bb.x), y1 = siluf_(x[i].y * rstd * gg.y + bb.y);
                *(unsigned*)(cat + (size_t)(row0 + tk) * DM + DA + c) = cvt_pk_bf16(y0, y1); } }
#pragma unroll 1
        for (int i = 0; i < 3; ++i) { const int it = tid + 512 * i, tk = it / 96, c8 = (it - tk * 96) * 8, l = l0 + tk; const size_t row = row0 + tk; const bf16_t* zr = z + row * DIN + c8;
            u32x4 qa[3], qc[3], qb;
#pragma unroll
            for (int q = 0; q < 3; ++q) { qa[q] = *(const u32x4*)(zr - (ptrdiff_t)(2 - q) * DIN); qc[q] = *(const u32x4*)(zr - (ptrdiff_t)(2 - q) * DIN + 1536); }
            qb = *(const u32x4*)(zr + 768);
            float y[8], t[8], w[8];
#pragma unroll
            for (int e = 0; e < 8; ++e) y[e] = 0.f;
#pragma unroll
            for (int q = 0; q < 3; ++q) { ld8_f32(caw + q * DA + c8, w);
                t[0] = bf_lo(qa[q].x) * bf_lo(qc[q].x); t[1] = bf_hi(qa[q].x) * bf_hi(qc[q].x); t[2] = bf_lo(qa[q].y) * bf_lo(qc[q].y); t[3] = bf_hi(qa[q].y) * bf_hi(qc[q].y);
                t[4] = bf_lo(qa[q].z) * bf_lo(qc[q].z); t[5] = bf_hi(qa[q].z) * bf_hi(qc[q].z); t[6] = bf_lo(qa[q].w) * bf_lo(qc[q].w); t[7] = bf_hi(qa[q].w) * bf_hi(qc[q].w);
                if (edge) { const int lq = l - 2 + q;
                    if (lq < 0) { if (samp) ld8_f32(hist_a + (size_t)(2 + lq) * DA + c8, t); else {
#pragma unroll
                        for (int e = 0; e < 8; ++e) t[e] = 0.f; } } }
#pragma unroll
                for (int e = 0; e < 8; ++e) y[e] += w[e] * t[e]; }
            y[0] *= bf_lo(qb.x); y[1] *= bf_hi(qb.x); y[2] *= bf_lo(qb.y); y[3] *= bf_hi(qb.y); y[4] *= bf_lo(qb.z); y[5] *= bf_hi(qb.z); y[6] *= bf_lo(qb.w); y[7] *= bf_hi(qb.w);
            st8_bf16(cat + row * DM + c8, y);
            if (lastc && tk >= TOK - 2) st8_f32(out_a + (size_t)(tk - (TOK - 2)) * DA + c8, t); }
        __syncthreads();
#pragma unroll 1
        for (int i = 0; i < 2; ++i) { const int it = tid + 512 * i, tk = it >> 6, c8 = (it & 63) * 8, l = l0 + tk; const size_t row = row0 + tk; const int w = 2 << (c8 >> 7);
            const LAS float* up = vt + (15 + tk) * DC + c8;
            const f32x4 u0a = *(const LAS f32x4*)up, u0b = *(const LAS f32x4*)(up + 4);
            f32x4 sa = u0a, sb = u0b;
            for (int q = 1; q < w; ++q) { sa += *(const LAS f32x4*)(up - q * DC); sb += *(const LAS f32x4*)(up - q * DC + 4); }
            const int cnt = (samp || l + 1 >= w) ? w : l + 1;
            const float rc = 1.f / (float)cnt; float d[8], u0[8];
#pragma unroll
            for (int e = 0; e < 4; ++e) { u0[e] = u0a[e]; u0[4 + e] = u0b[e]; d[e] = sa[e] * rc - u0a[e]; d[4 + e] = sb[e] * rc - u0b[e]; }
            st8_bf16(cat + row * DM + 1536 + c8, d);
            if (lastc && tk >= 1) st8_f32(out_p + (size_t)(tk - 1) * DC + c8, u0); }
        __syncthreads();
    }
#undef MIX_VLOAD
}

__device__ __forceinline__ void sample_fixup(const Params& p, int G, float* ss_out) {
    int tid = threadIdx.x; asm volatile("" : "+v"(tid));
    const int lane = tid & 63, wave = __builtin_amdgcn_readfirstlane(tid >> 6);
    bf16_t* hb = (bf16_t*)(p.ws + WS_HB);
    const float* slab = (const float*)(p.ws + WS_SLAB);
    for (int m = blockIdx.x * 8 + wave; m < MS; m += G * 8) {
        bf16_t* hr = hb + (size_t)(MP + m) * DM; float s = 0.f;
#pragma unroll
        for (int j = 0; j < 4; ++j) { const int c = j * 512 + lane * 8; float b[8]; ld8_bf16(hr + c, b);
            f32x4 v0 = (f32x4){b[0], b[1], b[2], b[3]}, v1 = (f32x4){b[4], b[5], b[6], b[7]};
#pragma unroll
            for (int q = 0; q < 4; ++q) { const float* sr = slab + (size_t)q * (MS * DM) + (size_t)m * DM + c; v0 += *(const f32x4*)sr; v1 += *(const f32x4*)(sr + 4); }
            u32x4 w; w.x = cvt_pk_bf16(v0[0], v0[1]); w.y = cvt_pk_bf16(v0[2], v0[3]); w.z = cvt_pk_bf16(v1[0], v1[1]); w.w = cvt_pk_bf16(v1[2], v1[3]);
            *(u32x4*)(hr + c) = w;
            const float r[8] = {bf_lo(w.x), bf_hi(w.x), bf_lo(w.y), bf_hi(w.y), bf_lo(w.z), bf_hi(w.z), bf_lo(w.w), bf_hi(w.w)};
#pragma unroll
            for (int e = 0; e < 8; ++e) s += r[e] * r[e]; }
        s = wave_sum(s);
        if (lane == 0) ss_out[MP + m] = s;
    }
    const float* ssp = (const float*)(p.ws + WS_SSP);
    for (int r2 = blockIdx.x * 8 + wave; r2 < MP / 2; r2 += G * 8) {
        const int row = r2 * 2 + (lane >> 5);
        float v = ssp[(size_t)row * 32 + (lane & 31)];
#pragma unroll
        for (int o = 1; o < 32; o <<= 1) v += __shfl_xor(v, o);
        if ((lane & 31) == 0) ss_out[row] = v;
    }
}

__device__ __forceinline__ void final_norm(const Params& p, int G) {
    int tid = threadIdx.x; asm volatile("" : "+v"(tid));
    const int lane = tid & 63, wave = __builtin_amdgcn_readfirstlane(tid >> 6);
    const int gw = blockIdx.x * 8 + wave, NGW = G * 8;
    const float* ss = (const float*)(p.ws + WS_SS) + 6 * MT;
    const float* gn = p.in[I_NF];
    const bf16_t* hb = (const bf16_t*)(p.ws + WS_HB);
    for (int m = gw; m < MT; m += NGW) {
        const float rinv = __builtin_amdgcn_rsqf(ss[m] * (1.f / DM) + EPS);
        float* orow = p.out + (size_t)m * DM;
#pragma unroll
        for (int j = 0; j < 4; ++j) { const int c = j * 512 + lane * 8; float b[8], g[8]; ld8_bf16(hb + (size_t)m * DM + c, b); ld8_f32(gn + c, g);
#pragma unroll
            for (int e = 0; e < 8; ++e) b[e] = b[e] * rinv * g[e];
            st8_f32(orow + c, b); }
    }
}

__device__ __forceinline__ void final_fused(const Params& p, int G) {
    int tid = threadIdx.x; asm volatile("" : "+v"(tid));
    const int lane = tid & 63, wave = __builtin_amdgcn_readfirstlane(tid >> 6);
    const int gw = blockIdx.x * 8 + wave, NGW = G * 8;
    const float* gn = p.in[I_NF];
    const bf16_t* hb = (const bf16_t*)(p.ws + WS_HB);
    const float* ssp = (const float*)(p.ws + WS_SSP);
    const float* slab = (const float*)(p.ws + WS_SLAB);
    for (int m = gw; m < MT; m += NGW) {
        float b[4][8]; float s;
#pragma unroll
        for (int j = 0; j < 4; ++j) ld8_bf16(hb + (size_t)m * DM + j * 512 + lane * 8, b[j]);
        if (m < MP) {
            float v = ssp[(size_t)m * 32 + (lane & 31)];
#pragma unroll
            for (int o = 1; o < 32; o <<= 1) v += __shfl_xor(v, o);
            s = v;
        } else {
            s = 0.f;
#pragma unroll
            for (int j = 0; j < 4; ++j) {
#pragma unroll
                for (int q = 0; q < 4; ++q) { float t[8]; ld8_f32(slab + (size_t)q * (MS * DM) + (size_t)(m - MP) * DM + j * 512 + lane * 8, t);
#pragma unroll
                    for (int e = 0; e < 8; ++e) b[j][e] += t[e]; }
#pragma unroll
                for (int e = 0; e < 8; ++e) s += b[j][e] * b[j][e]; }
            s = wave_sum(s);
        }
        const float rinv = __builtin_amdgcn_rsqf(s * (1.f / DM) + EPS);
        float* orow = p.out + (size_t)m * DM;
#pragma unroll
        for (int j = 0; j < 4; ++j) { const int c = j * 512 + lane * 8; float g[8]; ld8_f32(gn + c, g);
#pragma unroll
            for (int e = 0; e < 8; ++e) b[j][e] = b[j][e] * rinv * g[e];
            st8_f32(orow + c, b[j]); }
    }
}

#define XB_TMO      128
#define XB_XCNT(j)  (256  + 64 * (j))
#define XB_XSUB(j)  (1280 + 64 * (j))
#define XB_XGEN(j)  (2304 + 64 * (j))
#define XB_TOP      3328
#define XB_TOPGEN   3392
#define XCD_BAR_WORDS 3456
#define XB_SPIN_CAP (1u << 22)
__device__ __forceinline__ unsigned xb_ld(unsigned* p)              { return __hip_atomic_load(p, __ATOMIC_RELAXED, __HIP_MEMORY_SCOPE_AGENT); }
__device__ __forceinline__ unsigned xb_add(unsigned* p, unsigned v) { return __hip_atomic_fetch_add(p, v, __ATOMIC_RELAXED, __HIP_MEMORY_SCOPE_AGENT); }
__device__ __forceinline__ unsigned xb_xcc_id() { return (unsigned)__builtin_amdgcn_s_getreg((3 << 11) | 20) & 0xFu; }
#define XB_SPIN(cond, bar) do { unsigned _sp = 0; while (cond) { __builtin_amdgcn_s_sleep(1); \
    if ((++_sp & 255u) == 0u) { if (xb_ld(&(bar)[XB_TMO])) break; if (_sp > XB_SPIN_CAP) { atomicAdd(&(bar)[XB_TMO], 1u); break; } } } } while (0)
struct XcdBarrier { unsigned* bar; unsigned x; volatile LAS unsigned* st; };
__device__ __forceinline__ XcdBarrier xcd_barrier_post(unsigned* bar, volatile LAS unsigned* st) {
    XcdBarrier b; b.bar = bar; b.x = xb_xcc_id(); b.st = st;
    if (threadIdx.x == 0) (void)xb_add(&bar[XB_XCNT(b.x)], 1u);
    return b;
}
__device__ __forceinline__ void xcd_barrier_complete(unsigned* bar, unsigned x, unsigned& nloc, unsigned& nx) {
    const unsigned G = gridDim.x * gridDim.y * gridDim.z;
    unsigned sum, cnt, mine, sp = 0u;
    for (;;) {
        sum = 0u; cnt = 0u; mine = 0u;
#pragma unroll
        for (unsigned j = 0; j < 16; ++j) { const unsigned c = xb_ld(&bar[XB_XCNT(j)]); sum += c; cnt += (c > 0u) ? 1u : 0u; mine = (j == x) ? c : mine; }
        if (sum == G) break;
        __builtin_amdgcn_s_sleep(1);
        if ((++sp & 255u) == 0u) { if (xb_ld(&bar[XB_TMO])) break; if (sp > XB_SPIN_CAP) { atomicAdd(&bar[XB_TMO], 1u); break; } }
    }
    nloc = mine > 0u ? mine : 1u; nx = cnt > 0u ? cnt : 1u;
}
__device__ __forceinline__ void xcd_barrier(const XcdBarrier& b) {
    asm volatile("s_waitcnt vmcnt(0)" ::: "memory");
    __syncthreads();
    if (threadIdx.x == 0) {
        unsigned* bar = b.bar;
        __builtin_amdgcn_s_waitcnt(0);
        unsigned nloc = b.st[0], nx = b.st[1];
        if (nloc == 0u) { xcd_barrier_complete(bar, b.x, nloc, nx); b.st[0] = nloc; b.st[1] = nx; }
        const unsigned old = xb_add(&bar[XB_XSUB(b.x)], 1u);
        const unsigned gen = old / nloc;
        if (old + 1u == (gen + 1u) * nloc) {
            __builtin_amdgcn_fence(__ATOMIC_RELEASE, "agent");
            asm volatile("s_waitcnt vmcnt(0)" ::: "memory");
            const unsigned og = xb_add(&bar[XB_TOP], 1u);
            const unsigned tg = og / nx;
            if (og + 1u == (tg + 1u) * nx) xb_add(&bar[XB_TOPGEN], 1u);
            else XB_SPIN(xb_ld(&bar[XB_TOPGEN]) == tg, bar);
            __builtin_amdgcn_fence(__ATOMIC_ACQUIRE, "agent");
            xb_add(&bar[XB_XGEN(b.x)], 1u);
            asm volatile("s_waitcnt vmcnt(0)" ::: "memory");
        } else {
            XB_SPIN(xb_ld(&bar[XB_XGEN(b.x)]) == gen, bar);
            __builtin_amdgcn_fence(__ATOMIC_ACQUIRE, "agent");
            asm volatile("s_waitcnt vmcnt(0)" ::: "memory");
        }
    }
    __syncthreads();
}

__global__ void __launch_bounds__(512, 2) fwd_megakernel(Params p) {
    extern __shared__ __attribute__((aligned(16))) unsigned char lds_raw[];
    LAS unsigned char* lds = (LAS unsigned char*)lds_raw;
    cg::grid_group grid = cg::this_grid();
    const int G = gridDim.x;
    float* ssb = (float*)(p.ws + WS_SS);
    bf16_t* hb = (bf16_t*)(p.ws + WS_HB);
    bf16_t* act = (bf16_t*)(p.ws + WS_ACT);
    bf16_t* cat = (bf16_t*)(p.ws + WS_CAT);

    volatile LAS unsigned* misc = (volatile LAS unsigned*)(lds + MISC_OFF);
    if (threadIdx.x < 2) misc[threadIdx.x] = 0u;
    __syncthreads();
    const XcdBarrier xbar = xcd_barrier_post((unsigned*)(p.ws + WS_BAR), misc);
#pragma unroll 1
    for (int rep = 0; rep < REP_PRO; ++rep)
    prologue(p, lds, G);
    grid.sync();
#define GRID_BAR() xcd_barrier(xbar)

    for (int st = 0; st < 6; ++st) {
        const int layer = st / 3, sub = st - layer * 3;
        unsigned char* wl = p.ws + WS_W + (size_t)layer * W_LAYER;
        if (sub != 1) {
            const int f = sub >> 1;
            const float* ss_in = ssb + (size_t)(layer * 3 + (f ? 2 : 0)) * MT;
            float* ss_out = ssb + (size_t)(layer * 3 + (f ? 3 : 1)) * MT;
            const bf16_t* wgu = (const bf16_t*)(wl + (f ? W_GU2 : W_GU1));
            const bf16_t* wd = (const bf16_t*)(wl + (f ? W_D2 : W_D1));
            { pg8::Gemm g{hb, wgu, MT, 2 * DFF, DM, DM / 64}; pg8::StaticOrder S; S.init(MT, 2 * DFF, G, (int)blockIdx.x);
              pg8::EpiSwiGLU E{act, ss_in};
#pragma unroll 1
              for (int rep = 0; rep < REP_GU; ++rep)
              pg8::gemm_phase<pg8::EpiSwiGLU, pg8::StaticOrder, true, true>(lds, g, S, E); }
            GRID_BAR();
            { const bool first = (st == 0);
              { pg8::Gemm g{act, wd, MP, DM, DFF, DFF / 64}; pg8::StaticOrder S; S.init(MP, DM, G, (int)blockIdx.x);
                pg8::EpiResid E{hb, (float*)(p.ws + WS_SSP), 0.5f};
                pg8::gemm_phase<pg8::EpiResid, pg8::StaticOrder, true, true>(lds, g, S, E); }
              { pg8::Gemm g{act, wd, MT, DM, DFF, DFF / 256}; pg8::SplitOrder S{(int)blockIdx.x, (DFF / 4) * 2};
                pg8::EpiSlab E{(float*)(p.ws + WS_SLAB), 0.5f, (DFF / 4) * 2};
                pg8::gemm_phase<pg8::EpiSlab, pg8::SplitOrder, true, true>(lds, g, S, E); } }
            GRID_BAR();
            if (st != 5) { sample_fixup(p, G, ss_out); GRID_BAR(); }
        } else {
            const float* ss_in = ssb + (size_t)(layer * 3 + 1) * MT;
            float* ss_out = ssb + (size_t)(layer * 3 + 2) * MT;
            { pg8::Gemm g{hb, (const bf16_t*)(wl + W_IN), MT, DIN, DM, DM / 64}; pg8::StaticOrder S; S.init(MT, DIN, G, (int)blockIdx.x);
              pg8::EpiScaleBf16 E{act, DIN, ss_in};
#pragma unroll 1
              for (int rep = 0; rep < REP_WIN; ++rep)
              pg8::gemm_phase<pg8::EpiScaleBf16, pg8::StaticOrder, true, true>(lds, g, S, E); }
            GRID_BAR();
#pragma unroll 1
            for (int rep = 0; rep < REP_MIX; ++rep)
            mixer_mid(p, lds, G, layer);
            GRID_BAR();
            { pg8::Gemm g{cat, (const bf16_t*)(wl + W_OUT), MP, DM, DM, DM / 64}; pg8::StaticOrder S; S.init(MP, DM, G, (int)blockIdx.x);
              pg8::EpiResid E{hb, (float*)(p.ws + WS_SSP), 1.0f};
              pg8::gemm_phase<pg8::EpiResid, pg8::StaticOrder, true, true>(lds, g, S, E); }
            { pg8::Gemm g{cat, (const bf16_t*)(wl + W_OUT), MT, DM, DM, DM / 256}; pg8::SplitOrder S{(int)blockIdx.x, (DM / 4) * 2};
              pg8::EpiSlab E{(float*)(p.ws + WS_SLAB), 1.0f, (DM / 4) * 2};
              pg8::gemm_phase<pg8::EpiSlab, pg8::SplitOrder, true, true>(lds, g, S, E); }
            GRID_BAR();
            sample_fixup(p, G, ss_out);
            GRID_BAR();
        }
    }
    final_fused(p, G);
}

extern "C" void kernel_launch(void* const* d_in, const int* in_sizes, int n_in, void* d_out, int out_size, void* d_ws, size_t ws_size, hipStream_t stream) {
    static int grid = 0;
    if (grid == 0) {
        if (n_in != 24 || ws_size < WS_END) { fprintf(stderr, "kernel_launch: need 24 inputs and >= %zu bytes of workspace (got %d, %zu)\n", (size_t)WS_END, n_in, ws_size); grid = -1; return; }
        int dev = 0, cus = 0, per_cu = 0;
        hipGetDevice(&dev);
        hipDeviceGetAttribute(&cus, hipDeviceAttributeMultiprocessorCount, dev);
        hipFuncSetAttribute((const void*)fwd_megakernel, hipFuncAttributeMaxDynamicSharedMemorySize, LDS_BYTES);
        hipOccupancyMaxActiveBlocksPerMultiprocessor(&per_cu, (const void*)fwd_megakernel, 512, LDS_BYTES);
        if (per_cu < 1) { fprintf(stderr, "kernel_launch: occupancy query returned %d\n", per_cu); per_cu = 1; }
        grid = cus * per_cu;
    }
    if (grid < 0) return;
    if (hipMemsetAsync((char*)d_ws + WS_BAR, 0, WS_BAR_BYTES, stream) != hipSuccess) { fprintf(stderr, "kernel_launch: memset failed\n"); return; }
    Params p{};
    for (int i = 0; i < 24; ++i) p.in[i] = (const float*)d_in[i];
    p.out = (float*)d_out; p.ws = (unsigned char*)d_ws;
    void* args[] = {&p};
    hipError_t e = hipLaunchCooperativeKernel((void*)fwd_megakernel, dim3(grid), dim3(512), args, LDS_BYTES, stream);
    if (e != hipSuccess) fprintf(stderr, "cooperative launch failed: %s (grid %d)\n", hipGetErrorString(e), grid);
}
```

```cpp
#include <hip/hip_runtime.h>
#include <hip/hip_cooperative_groups.h>
#include <cstdio>
#include <cstdint>
namespace cg = cooperative_groups;

#define LAS __attribute__((address_space(3)))
typedef unsigned short bf16_t;
typedef short bf16x8 __attribute__((ext_vector_type(8)));
typedef float f32x4 __attribute__((ext_vector_type(4)));
typedef float f32x2 __attribute__((ext_vector_type(2)));
typedef unsigned u32x4 __attribute__((ext_vector_type(4)));
typedef unsigned u32x2 __attribute__((ext_vector_type(2)));

constexpr int DM = 2048, DFF = 5632, DIN = 4352, DA = 768, DB = 768, DC = 512;
constexpr int MP = 16384, MS = 512, MT = MP + MS;
constexpr float EPS = 1e-6f;
constexpr size_t MiB = 1u << 20;
constexpr size_t WS_SS = 0, WS_W = 1 * MiB, W_LAYER = 157 * MiB;
constexpr size_t W_GU1 = 0, W_D1 = 44 * MiB, W_IN = 66 * MiB, W_OUT = 83 * MiB, W_GU2 = 91 * MiB, W_D2 = 135 * MiB;
constexpr size_t WS_HB = 315 * MiB, WS_ACT = 381 * MiB, WS_CAT = 563 * MiB, WS_SLAB = 629 * MiB, WS_SSP = 645 * MiB, WS_END = 648 * MiB;
constexpr int OFF_A_P = 34603008, OFF_B_P = OFF_A_P + 6144, OFF_P_P = OFF_B_P + 92160, OFF_A_S = OFF_P_P + 30720, OFF_B_S = OFF_A_S + 24576, OFF_P_S = OFF_B_S + 368640;
#ifndef REP_GU
#define REP_GU 1
#endif
#ifndef REP_WIN
#define REP_WIN 1
#endif
#ifndef REP_MIX
#define REP_MIX 1
#endif
#ifndef REP_PRO
#define REP_PRO 1
#endif
constexpr int LDS_BYTES = 147456, MISC_OFF = 139264;
constexpr size_t WS_BAR = 512 * 1024, WS_BAR_BYTES = 16384;

#define LDS_WAIT() asm volatile("s_waitcnt lgkmcnt(0)" ::: "memory")

__device__ __forceinline__ unsigned cvt_pk_bf16(float lo, float hi) { unsigned r; asm volatile("v_cvt_pk_bf16_f32 %0, %1, %2" : "=v"(r) : "v"(lo), "v"(hi)); return r; }
__device__ __forceinline__ float bf_lo(unsigned w) { return __uint_as_float(w << 16); }
__device__ __forceinline__ float bf_hi(unsigned w) { return __uint_as_float(w & 0xffff0000u); }
__device__ __forceinline__ float sigmoidf_(float x) { return __builtin_amdgcn_rcpf(1.f + __builtin_amdgcn_exp2f(-1.44269504f * x)); }
__device__ __forceinline__ float siluf_(float x) { return x * sigmoidf_(x); }
__device__ __forceinline__ float wave_sum(float v) {
#pragma unroll
    for (int o = 1; o < 64; o <<= 1) v += __shfl_xor(v, o);
    return v;
}

namespace pg8 {
constexpr int BM = 256, BK = 64, HALF = 128, HTB = HALF * BK * 2, STAGE_BYTES = 8 * HTB, NXCD = 8, WGM = 4;
__host__ __device__ __forceinline__ int lds_byte(int r, int c) { const int st = (r >> 4) * 2 + (c >> 5), rr = r & 15, cc = c & 31, ob = rr * 64 + cc * 2; return st * 1024 + (ob ^ (((ob >> 9) & 1) << 5)); }
__host__ __device__ __forceinline__ void stage_rc(int b, int& R, int& C) { const int st = b / 1024, sb = b % 1024, swz = sb ^ (((sb >> 9) & 1) << 5); R = (st >> 1) * 16 + swz / 64; C = (st & 1) * 32 + (swz % 64) / 2; }
__host__ __device__ __forceinline__ int perm32(int rho) { const int n = rho >> 4, i = rho & 15; return 8 * (i >> 2) + 4 * n + (i & 3); }

struct Unit { int pm, pn, kb; };
struct Gemm { const bf16_t* A; const bf16_t* Bt; int M, N, K, nt; };

struct StaticOrder {
    int nM, nN, nwg, G, c;
    __device__ void init(int M, int N, int G_, int c_) { nM = M / BM; nN = N / BM; nwg = nM * nN; G = G_; c = c_; }
    __device__ __forceinline__ bool next(int i, Unit& u) const {
        const long L = (long)i * G + c; if (L >= nwg) return false;
        int wgid = (int)L; { const int q = nwg / NXCD, r = nwg % NXCD, xcd = wgid % NXCD, off = wgid / NXCD; wgid = (xcd < r ? xcd * (q + 1) : r * (q + 1) + (xcd - r) * q) + off; }
        const int nig = WGM * nN, gid = wgid / nig, fm = gid * WGM, gsz = (nM - fm) < WGM ? (nM - fm) : WGM;
        u.pm = fm + ((wgid % nig) % gsz); u.pn = (wgid % nig) / gsz; u.kb = 0; return true;
    }
    __device__ __forceinline__ void a_ready(const Unit&) const {}
    __device__ __forceinline__ void done(const Unit&) const {}
};

struct EpiSwiGLU {
    static constexpr bool PERM = true, AFTER_DRAIN = false, PREF = true;
    bf16_t* O; const float* ss;
    __device__ __forceinline__ void prefetch(const Unit& u, int wr, int fr, float (&sv)[8]) const {
        const int row0 = u.pm * BM + wr * 64 + fr;
#pragma unroll
        for (int ai = 0; ai < 2; ++ai)
#pragma unroll
            for (int m = 0; m < 4; ++m) sv[ai * 4 + m] = ss[row0 + ai * HALF + m * 16];
    }
    __device__ __forceinline__ void operator()(const f32x4 (&acc)[2][2][4][2], const Unit& u, int wr, int wc, int fr, int fq, const float (&sv)[8]) const {
        const int row0 = u.pm * BM + wr * 64 + fr, col0 = u.pn * HALF + wc * 32 + 8 * fq;
#pragma unroll
        for (int ai = 0; ai < 2; ++ai)
#pragma unroll
            for (int m = 0; m < 4; ++m) {
                const int row = row0 + ai * HALF + m * 16;
                const float rinv = __builtin_amdgcn_rsqf(sv[ai * 4 + m] * (1.f / DM) + EPS), rneg = rinv * -1.44269504f, r2 = rinv * rinv;
                const f32x4 g0 = acc[ai][0][m][0], g1 = acc[ai][0][m][1], u0 = acc[ai][1][m][0], u1 = acc[ai][1][m][1];
                f32x4 e0, e1;
#pragma unroll
                for (int j = 0; j < 4; ++j) { e0[j] = __builtin_amdgcn_rcpf(1.f + __builtin_amdgcn_exp2f(g0[j] * rneg)); e1[j] = __builtin_amdgcn_rcpf(1.f + __builtin_amdgcn_exp2f(g1[j] * rneg)); }
                const f32x4 a0 = (g0 * u0) * (e0 * r2), a1 = (g1 * u1) * (e1 * r2);
                u32x4 w;
                w.x = cvt_pk_bf16(a0[0], a0[1]); w.y = cvt_pk_bf16(a0[2], a0[3]); w.z = cvt_pk_bf16(a1[0], a1[1]); w.w = cvt_pk_bf16(a1[2], a1[3]);
                *(u32x4*)(O + (size_t)row * DFF + col0) = w;
            }
    }
};
struct EpiScaleBf16 {
    static constexpr bool PERM = true, AFTER_DRAIN = false, PREF = true;
    bf16_t* O; int ldc; const float* ss;
    __device__ __forceinline__ void prefetch(const Unit& u, int wr, int fr, float (&sv)[8]) const {
        const int row0 = u.pm * BM + wr * 64 + fr;
#pragma unroll
        for (int ai = 0; ai < 2; ++ai)
#pragma unroll
            for (int m = 0; m < 4; ++m) sv[ai * 4 + m] = ss[row0 + ai * HALF + m * 16];
    }
    __device__ __forceinline__ void operator()(const f32x4 (&acc)[2][2][4][2], const Unit& u, int wr, int wc, int fr, int fq, const float (&sv)[8]) const {
        const int row0 = u.pm * BM + wr * 64 + fr, col0 = u.pn * BM + wc * 32 + 8 * fq;
#pragma unroll
        for (int ai = 0; ai < 2; ++ai)
#pragma unroll
            for (int m = 0; m < 4; ++m) {
                const int row = row0 + ai * HALF + m * 16;
                const float rinv = __builtin_amdgcn_rsqf(sv[ai * 4 + m] * (1.f / DM) + EPS);
                bf16_t* rowp = O + (size_t)row * ldc + col0;
#pragma unroll
                for (int bj = 0; bj < 2; ++bj) { const f32x4 v0 = acc[ai][bj][m][0] * rinv, v1 = acc[ai][bj][m][1] * rinv;
                    u32x4 w; w.x = cvt_pk_bf16(v0[0], v0[1]); w.y = cvt_pk_bf16(v0[2], v0[3]); w.z = cvt_pk_bf16(v1[0], v1[1]); w.w = cvt_pk_bf16(v1[2], v1[3]);
                    *(u32x4*)(rowp + bj * HALF) = w; }
            }
    }
};
struct EpiResid {
    static constexpr bool PERM = true, AFTER_DRAIN = false, PREF = false;
    bf16_t* hb; float* ssn; float scale;
    __device__ __forceinline__ void prefetch(const Unit&, int, int, float (&)[8]) const {}
    __device__ __forceinline__ void operator()(const f32x4 (&acc)[2][2][4][2], const Unit& u, int wr, int wc, int fr, int fq, const float (&)[8]) const {
        const int row0 = u.pm * BM + wr * 64 + fr, col0 = u.pn * BM + wc * 32 + 8 * fq;
        bf16_t* bp0 = hb + (size_t)row0 * DM + col0;
        u32x4 b[2][4][2];
#pragma unroll
        for (int ai = 0; ai < 2; ++ai)
#pragma unroll
            for (int m = 0; m < 4; ++m)
#pragma unroll
                for (int bj = 0; bj < 2; ++bj) b[ai][m][bj] = *(const u32x4*)(bp0 + (size_t)(ai * HALF + m * 16) * DM + bj * HALF);
#pragma unroll
        for (int ai = 0; ai < 2; ++ai) {
#pragma unroll
            for (int m = 0; m < 4; ++m) {
                const int row = row0 + ai * HALF + m * 16;
                float s = 0.f;
#pragma unroll
                for (int bj = 0; bj < 2; ++bj) { const u32x4 bb = b[ai][m][bj];
                    const f32x4 b0 = (f32x4){bf_lo(bb.x), bf_hi(bb.x), bf_lo(bb.y), bf_hi(bb.y)}, b1 = (f32x4){bf_lo(bb.z), bf_hi(bb.z), bf_lo(bb.w), bf_hi(bb.w)};
                    const f32x4 h0 = b0 + acc[ai][bj][m][0] * scale, h1 = b1 + acc[ai][bj][m][1] * scale;
                    u32x4 w; w.x = cvt_pk_bf16(h0[0], h0[1]); w.y = cvt_pk_bf16(h0[2], h0[3]); w.z = cvt_pk_bf16(h1[0], h1[1]); w.w = cvt_pk_bf16(h1[2], h1[3]);
                    *(u32x4*)(bp0 + (size_t)(ai * HALF + m * 16) * DM + bj * HALF) = w;
                    const f32x4 r0 = (f32x4){bf_lo(w.x), bf_hi(w.x), bf_lo(w.y), bf_hi(w.y)}, r1 = (f32x4){bf_lo(w.z), bf_hi(w.z), bf_lo(w.w), bf_hi(w.w)};
                    s += (r0[0] * r0[0] + r0[1] * r0[1]) + (r0[2] * r0[2] + r0[3] * r0[3]) + (r1[0] * r1[0] + r1[1] * r1[1]) + (r1[2] * r1[2] + r1[3] * r1[3]); }
                s += __shfl_xor(s, 16); s += __shfl_xor(s, 32);
                if (fq == 0) ssn[(size_t)row * 32 + u.pn * 4 + wc] = s;
            }
        }
    }
};

struct SplitOrder {
    int c, kslice;
    __device__ __forceinline__ bool next(int i, Unit& u) const {
        if (i != 0 || c >= 64) return false;
        u.pm = 64 + (c & 1); u.pn = (c >> 1) & 7; u.kb = (c >> 4) * kslice; return true;
    }
    __device__ __forceinline__ void a_ready(const Unit&) const {}
    __device__ __forceinline__ void done(const Unit&) const {}
};
struct EpiSlab {
    static constexpr bool PERM = true, AFTER_DRAIN = false;
    static constexpr bool PREF = false;
    float* slab; float scale; int kslice;
    __device__ __forceinline__ void prefetch(const Unit&, int, int, float (&)[8]) const {}
    __device__ __forceinline__ void operator()(const f32x4 (&acc)[2][2][4][2], const Unit& u, int wr, int wc, int fr, int fq, const float (&)[8]) const {
        const int row0 = (u.pm - 64) * BM + wr * 64 + fr, col0 = u.pn * BM + wc * 32 + 8 * fq;
        float* sp = slab + (size_t)(u.kb / kslice) * (MS * DM);
#pragma unroll
        for (int ai = 0; ai < 2; ++ai)
#pragma unroll
            for (int m = 0; m < 4; ++m) { float* rp = sp + (size_t)(row0 + ai * HALF + m * 16) * DM + col0;
#pragma unroll
                for (int bj = 0; bj < 2; ++bj)
#pragma unroll
                    for (int n = 0; n < 2; ++n) *(f32x4*)(rp + bj * HALF + n * 4) = acc[ai][bj][m][n] * scale; }
    }
};

template <class Epi, class Sched, bool ALIGN_EPI = false, bool SP2 = false>
__device__ __forceinline__ void gemm_phase(LAS unsigned char* lds, const Gemm g, const Sched& S, const Epi& E) {
    int tid = threadIdx.x; asm volatile("" : "+v"(tid));
    const int wid = __builtin_amdgcn_readfirstlane(tid >> 6), lane = tid & 63, wr = wid >> 2, wc = wid & 3, fr = lane & 15, fq = lane >> 4;
    const int K = g.K, nt = g.nt;
    unsigned voffA[2], voffB[2];
#pragma unroll
    for (int i = 0; i < 2; ++i) { int R, C; stage_rc(tid * 16 + i * 8192, R, C); const int Rb = Epi::PERM ? ((R & ~31) + perm32(R & 31)) : R;
        voffA[i] = (unsigned)(R * K + C) * 2u; voffB[i] = (unsigned)(Rb * K + C) * 2u; }
    const size_t kstep = (size_t)(BK * 2);
    const size_t hstep = (size_t)HALF * K * 2;
    const size_t tstep = 2 * hstep;
    const unsigned ldsw = (unsigned)wid * 1024u;
    const int aoff = lds_byte(wr * 64 + fr, fq * 8), boff = lds_byte(wc * 32 + fr, fq * 8);
#define PG8_SA(b, h) (((b) * 2 + (h)) * HTB)
#define PG8_SB(b, h) ((4 + (b) * 2 + (h)) * HTB)
#define PG8_STAGE(bufoff, gbase, voff) do { _Pragma("unroll") for (int _i = 0; _i < 2; ++_i) \
        __builtin_amdgcn_global_load_lds((const unsigned*)((const char*)(gbase) + (voff)[_i]), (LAS unsigned*)(lds + (bufoff) + ldsw + _i * 8192), 16, 0, 0); } while (0)
#define PG8_LDA(dst, b, h) do { _Pragma("unroll") for (int m = 0; m < 4; ++m) _Pragma("unroll") for (int k = 0; k < 2; ++k) dst[m][k] = *(const LAS bf16x8*)(lds + PG8_SA(b, h) + aoff + m * 2048 + k * 1024); } while (0)
#define PG8_LDB(dst, b, h) do { _Pragma("unroll") for (int n = 0; n < 2; ++n) _Pragma("unroll") for (int k = 0; k < 2; ++k) dst[n][k] = *(const LAS bf16x8*)(lds + PG8_SB(b, h) + boff + n * 2048 + k * 1024); } while (0)
#define PG8_MMA(ai, bj, At, Bt) do { __builtin_amdgcn_s_setprio(1); _Pragma("unroll") for (int m = 0; m < 4; ++m) _Pragma("unroll") for (int n = 0; n < 2; ++n) _Pragma("unroll") for (int k = 0; k < 2; ++k) \
        acc[ai][bj][m][n] = __builtin_amdgcn_mfma_f32_16x16x32_bf16(Bt[n][k], At[m][k], acc[ai][bj][m][n], 0, 0, 0); __builtin_amdgcn_s_setprio(0); } while (0)
#define PG8_WAIT_V(n) asm volatile("s_waitcnt vmcnt(" #n ")" ::: "memory")
#define PG8_WAIT_L(n) asm volatile("s_waitcnt lgkmcnt(" #n ")" ::: "memory")
#define PG8_BAR __builtin_amdgcn_s_barrier()
#define PG8_SCHED __builtin_amdgcn_sched_barrier(0)
    Unit cur, nxt; int ui = 0;
    if (!S.next(0, cur)) return;
    f32x4 acc[2][2][4][2];
#pragma unroll
    for (int a = 0; a < 2; ++a)
#pragma unroll
        for (int b = 0; b < 2; ++b)
#pragma unroll
            for (int m = 0; m < 4; ++m)
#pragma unroll
                for (int n = 0; n < 2; ++n) acc[a][b][m][n] = (f32x4){0.f, 0.f, 0.f, 0.f};
    bf16x8 At[4][2], B0[2][2], B1[2][2];
    const char* cA = (const char*)g.A + (size_t)cur.pm * tstep + cur.kb; const char* cB = (const char*)g.Bt + (size_t)cur.pn * tstep + cur.kb;
    S.a_ready(cur);
    float sv[8];
#define PG8_SS_DMA(u, buf) do { if constexpr (Epi::PREF) { if (wid == 0) __builtin_amdgcn_global_load_lds((const unsigned*)(E.ss + (size_t)(u).pm * BM + 4 * lane), (LAS unsigned*)(lds + STAGE_BYTES + (buf) * 1024), 16, 0, 0); } } while (0)
    PG8_SS_DMA(cur, 0);
    if constexpr (SP2) {
        PG8_STAGE(PG8_SB(0, 0), cB, voffB); PG8_STAGE(PG8_SB(0, 1), cB + hstep, voffB); PG8_STAGE(PG8_SA(0, 0), cA, voffA); PG8_STAGE(PG8_SA(0, 1), cA + hstep, voffA);
        if (wr == 1) PG8_BAR;
        PG8_WAIT_V(2); PG8_BAR;
        PG8_STAGE(PG8_SB(1, 0), cB + kstep, voffB); PG8_STAGE(PG8_SA(1, 0), cA + kstep, voffA); PG8_STAGE(PG8_SB(1, 1), cB + hstep + kstep, voffB);
        PG8_WAIT_V(6); PG8_BAR;
    } else {
        PG8_STAGE(PG8_SB(0, 0), cB, voffB); PG8_STAGE(PG8_SA(0, 0), cA, voffA); PG8_STAGE(PG8_SB(0, 1), cB + hstep, voffB); PG8_STAGE(PG8_SA(0, 1), cA + hstep, voffA);
        if (wr == 1) PG8_BAR;
        PG8_WAIT_V(4); PG8_BAR;
        PG8_STAGE(PG8_SB(1, 0), cB + kstep, voffB); PG8_STAGE(PG8_SA(1, 0), cA + kstep, voffA); PG8_STAGE(PG8_SB(1, 1), cB + hstep + kstep, voffB);
        PG8_WAIT_V(6); PG8_BAR;
    }
    for (;;) {
        const bool has_next = S.next(ui + 1, nxt);
        const char* nA = has_next ? (const char*)g.A + (size_t)nxt.pm * tstep + nxt.kb : cA; const char* nB = has_next ? (const char*)g.Bt + (size_t)nxt.pn * tstep + nxt.kb : cB;
        for (int t = 0; t < nt; t += 2) {
            const bool last = (t == nt - 2);
            const char* a1 = cA + (size_t)(t + 1) * kstep;
            const char* a2 = last ? nA : cA + (size_t)(t + 2) * kstep; const char* b2 = last ? nB : cB + (size_t)(t + 2) * kstep;
            const char* a3 = a2 + kstep; const char* b3 = b2 + kstep;
            if (last && has_next) S.a_ready(nxt);
            if constexpr (SP2) {
            PG8_LDB(B0, 0, 0); PG8_LDB(B1, 0, 1); PG8_SCHED; PG8_LDA(At, 0, 0); PG8_STAGE(PG8_SA(1, 1), a1 + hstep, voffA);
            PG8_WAIT_V(8); PG8_WAIT_L(0); PG8_BAR; PG8_MMA(0, 0, At, B0); PG8_MMA(0, 1, At, B1); PG8_BAR; PG8_SCHED;
            PG8_LDA(At, 0, 1); PG8_STAGE(PG8_SB(0, 0), b2, voffB); PG8_STAGE(PG8_SB(0, 1), b2 + hstep, voffB); PG8_STAGE(PG8_SA(0, 0), a2, voffA);
            PG8_WAIT_V(8); PG8_WAIT_L(0); PG8_BAR; PG8_MMA(1, 0, At, B0); PG8_MMA(1, 1, At, B1); PG8_BAR; PG8_SCHED;
            PG8_LDB(B0, 1, 0); PG8_LDB(B1, 1, 1); PG8_SCHED; PG8_LDA(At, 1, 0); PG8_STAGE(PG8_SA(0, 1), a2 + hstep, voffA);
            PG8_WAIT_V(8); PG8_WAIT_L(0); PG8_BAR; PG8_MMA(0, 0, At, B0); PG8_MMA(0, 1, At, B1); PG8_BAR; PG8_SCHED;
            PG8_LDA(At, 1, 1); PG8_STAGE(PG8_SB(1, 0), b3, voffB); PG8_STAGE(PG8_SB(1, 1), b3 + hstep, voffB); PG8_STAGE(PG8_SA(1, 0), a3, voffA);
            PG8_WAIT_V(8); PG8_WAIT_L(0); PG8_BAR; PG8_MMA(1, 0, At, B0); PG8_MMA(1, 1, At, B1); PG8_BAR; PG8_SCHED;
            } else {
            PG8_LDB(B0, 0, 0); PG8_SCHED; PG8_LDA(At, 0, 0); PG8_STAGE(PG8_SA(1, 1), a1 + hstep, voffA);
            PG8_WAIT_L(8); PG8_BAR; PG8_WAIT_L(0); PG8_MMA(0, 0, At, B0); PG8_BAR; PG8_SCHED;
            PG8_LDB(B1, 0, 1); PG8_STAGE(PG8_SB(0, 0), b2, voffB);
            PG8_BAR; PG8_WAIT_L(0); PG8_MMA(0, 1, At, B1); PG8_BAR;
            PG8_LDA(At, 0, 1); PG8_STAGE(PG8_SA(0, 0), a2, voffA);
            PG8_BAR; PG8_WAIT_L(0); PG8_MMA(1, 0, At, B0); PG8_BAR; PG8_SCHED;
            PG8_STAGE(PG8_SB(0, 1), b2 + hstep, voffB);
            PG8_WAIT_V(6); PG8_BAR; PG8_MMA(1, 1, At, B1); PG8_BAR;
            PG8_LDB(B0, 1, 0); PG8_SCHED; PG8_LDA(At, 1, 0); PG8_STAGE(PG8_SA(0, 1), a2 + hstep, voffA);
            PG8_WAIT_L(8); PG8_BAR; PG8_WAIT_L(0); PG8_MMA(0, 0, At, B0); PG8_BAR; PG8_SCHED;
            PG8_LDB(B1, 1, 1); PG8_STAGE(PG8_SB(1, 0), b3, voffB);
            PG8_BAR; PG8_WAIT_L(0); PG8_MMA(0, 1, At, B1); PG8_BAR;
            PG8_LDA(At, 1, 1); PG8_STAGE(PG8_SA(1, 0), a3, voffA);
            PG8_BAR; PG8_WAIT_L(0); PG8_MMA(1, 0, At, B0); PG8_BAR; PG8_SCHED;
            PG8_STAGE(PG8_SB(1, 1), b3 + hstep, voffB);
            PG8_WAIT_V(6); PG8_BAR; PG8_MMA(1, 1, At, B1); PG8_BAR;
            }
        }
        if constexpr (ALIGN_EPI) { if (wr == 0) PG8_BAR; }
        if constexpr (Epi::PREF) {
#pragma unroll
            for (int ai = 0; ai < 2; ++ai)
#pragma unroll
                for (int m = 0; m < 4; ++m) sv[ai * 4 + m] = *(const LAS float*)(lds + STAGE_BYTES + (ui & 1) * 1024 + 4 * (ai * HALF + wr * 64 + m * 16 + fr));
        }
        if constexpr (!Epi::AFTER_DRAIN) { E(acc, cur, wr, wc, fr, fq, sv); S.done(cur); }
        if (!has_next) break;
#pragma unroll
        for (int a = 0; a < 2; ++a)
#pragma unroll
            for (int b = 0; b < 2; ++b)
#pragma unroll
                for (int m = 0; m < 4; ++m)
#pragma unroll
                    for (int n = 0; n < 2; ++n) acc[a][b][m][n] = (f32x4){0.f, 0.f, 0.f, 0.f};
        cur = nxt; cA = nA; cB = nB; ++ui;
        PG8_SS_DMA(cur, ui & 1);
        if constexpr (ALIGN_EPI) { if (wr == 1) PG8_BAR; }
    }
    PG8_WAIT_V(0);
    if constexpr (!ALIGN_EPI) { if (wr == 0) PG8_BAR; }
    PG8_BAR;
#undef PG8_SS_DMA
#undef PG8_SA
#undef PG8_SB
#undef PG8_STAGE
#undef PG8_LDA
#undef PG8_LDB
#undef PG8_MMA
#undef PG8_WAIT_V
#undef PG8_WAIT_L
#undef PG8_BAR
#undef PG8_SCHED
}
}

struct Params { const float* in[24]; float* out; unsigned char* ws; };
enum { I_XP = 0, I_XS, I_CA, I_CB, I_CP, I_N1, I_WG1, I_WU1, I_WD1, I_NM, I_WIN, I_CAW, I_CBW, I_CBB, I_LNG, I_LNB, I_PW, I_PS, I_WOUT, I_N2, I_WG2, I_WU2, I_WD2, I_NF };

__device__ __forceinline__ void tr_item(const float* W, int N, const float* gk, bf16_t* WT, int ldk, int drow0, int k0, int n0, LAS float* scr, int lane) {
    const int l16 = lane & 15, kq = lane >> 4;
    f32x4 v[16];
#pragma unroll
    for (int i = 0; i < 16; ++i) v[i] = *(const f32x4*)(W + (size_t)(k0 + 4 * i + kq) * N + n0 + 4 * l16);
    if (gk) {
#pragma unroll
        for (int i = 0; i < 16; ++i) v[i] = v[i] * gk[k0 + 4 * i + kq]; }
#pragma unroll
    for (int i = 0; i < 16; ++i) { LAS float* d = scr + (4 * i + kq) * 65 + 4 * l16; d[0] = v[i][0]; d[1] = v[i][1]; d[2] = v[i][2]; d[3] = v[i][3]; }
    LDS_WAIT(); asm volatile("" ::: "memory");
    const int c = lane & 7;
#pragma unroll
    for (int j = 0; j < 8; ++j) { const int n = (lane >> 3) + 8 * j; const LAS float* s = scr + (8 * c) * 65 + n;
        u32x4 o; o.x = cvt_pk_bf16(s[0 * 65], s[1 * 65]); o.y = cvt_pk_bf16(s[2 * 65], s[3 * 65]); o.z = cvt_pk_bf16(s[4 * 65], s[5 * 65]); o.w = cvt_pk_bf16(s[6 * 65], s[7 * 65]);
        *(u32x4*)(WT + (size_t)(drow0 + n) * ldk + k0 + 8 * c) = o; }
    LDS_WAIT(); asm volatile("" ::: "memory");
}

__device__ __forceinline__ void prologue(const Params& p, LAS unsigned char* lds, int G) {
    const int tid = threadIdx.x, lane = tid & 63, wave = __builtin_amdgcn_readfirstlane(tid >> 6);
    const int gw = blockIdx.x * 8 + wave, NGW = G * 8;
    float* ss = (float*)(p.ws + WS_SS);
    for (int b = blockIdx.x; b < 256; b += G) {
        const int layer = b >> 7, g = (b >> 5) & 3, n0 = (b & 31) * 64;
        LAS float* Bs = (LAS float*)lds;
        LAS float* As = (LAS float*)(lds + 32768);
        const float* wo = p.in[I_WOUT] + (size_t)layer * DM * DM + (size_t)(1536 + g * 128) * DM + n0;
        const float* ps = p.in[I_PS] + layer * DC + g * 128;
        const float* pw = p.in[I_PW] + (size_t)(layer * 4 + g) * 128 * 128;
#pragma unroll
        for (int i = 0; i < 4; ++i) { const int e = (i * 512 + tid) * 4, d = e >> 6, n = e & 63; const f32x4 v = *(const f32x4*)(wo + (size_t)d * DM + n) * ps[d]; *(LAS f32x4*)(Bs + d * 64 + n) = v; }
#pragma unroll
        for (int i = 0; i < 8; ++i) { const int e = (i * 512 + tid) * 4, c = e >> 7, d = e & 127; const f32x4 v = *(const f32x4*)(pw + e); LAS float* dp = As + c * 129 + d; dp[0] = v[0]; dp[1] = v[1]; dp[2] = v[2]; dp[3] = v[3]; }
        __syncthreads();
        float a[16];
#pragma unroll
        for (int i = 0; i < 16; ++i) a[i] = 0.f;
        for (int d = 0; d < 128; ++d) { const float bv = Bs[d * 64 + lane];
#pragma unroll
            for (int i = 0; i < 16; ++i) a[i] += As[(wave * 16 + i) * 129 + d] * bv; }
        bf16_t* dst = (bf16_t*)(p.ws + WS_W + (size_t)layer * W_LAYER + W_OUT) + (size_t)(n0 + lane) * DM + 1536 + g * 128 + wave * 16;
        u32x4 o0, o1;
        o0.x = cvt_pk_bf16(a[0], a[1]); o0.y = cvt_pk_bf16(a[2], a[3]); o0.z = cvt_pk_bf16(a[4], a[5]); o0.w = cvt_pk_bf16(a[6], a[7]);
        o1.x = cvt_pk_bf16(a[8], a[9]); o1.y = cvt_pk_bf16(a[10], a[11]); o1.z = cvt_pk_bf16(a[12], a[13]); o1.w = cvt_pk_bf16(a[14], a[15]);
        *(u32x4*)dst = o0; *(u32x4*)(dst + 8) = o1;
        __syncthreads();
    }
    LAS float* scr = (LAS float*)(lds + wave * 16640);
    constexpr int PER_LAYER = 2816 * 6 + 2176 + 768;
#pragma unroll 1
    for (int it = gw; it < 2 * PER_LAYER; it += NGW) {
        const int layer = it >= PER_LAYER ? 1 : 0; int r = it - layer * PER_LAYER;
        unsigned char* wl = p.ws + WS_W + (size_t)layer * W_LAYER;
        const float* W; const float* gk = nullptr; bf16_t* WT; int N, ldk, nnb, kind = 0;
        if (r < 2816) { W = p.in[I_WG1] + (size_t)layer * DM * DFF; gk = p.in[I_N1] + layer * DM; WT = (bf16_t*)(wl + W_GU1); N = DFF; ldk = DM; nnb = 88; kind = 1; }
        else if ((r -= 2816) < 2816) { W = p.in[I_WU1] + (size_t)layer * DM * DFF; gk = p.in[I_N1] + layer * DM; WT = (bf16_t*)(wl + W_GU1); N = DFF; ldk = DM; nnb = 88; kind = 2; }
        else if ((r -= 2816) < 2816) { W = p.in[I_WD1] + (size_t)layer * DFF * DM; WT = (bf16_t*)(wl + W_D1); N = DM; ldk = DFF; nnb = 32; }
        else if ((r -= 2816) < 2176) { W = p.in[I_WIN] + (size_t)layer * DM * DIN; gk = p.in[I_NM] + layer * DM; WT = (bf16_t*)(wl + W_IN); N = DIN; ldk = DM; nnb = 68; }
        else if ((r -= 2176) < 768) { W = p.in[I_WOUT] + (size_t)layer * DM * DM; WT = (bf16_t*)(wl + W_OUT); N = DM; ldk = DM; nnb = 32; }
        else if ((r -= 768) < 2816) { W = p.in[I_WG2] + (size_t)layer * DM * DFF; gk = p.in[I_N2] + layer * DM; WT = (bf16_t*)(wl + W_GU2); N = DFF; ldk = DM; nnb = 88; kind = 1; }
        else if ((r -= 2816) < 2816) { W = p.in[I_WU2] + (size_t)layer * DM * DFF; gk = p.in[I_N2] + layer * DM; WT = (bf16_t*)(wl + W_GU2); N = DFF; ldk = DM; nnb = 88; kind = 2; }
        else { r -= 2816; W = p.in[I_WD2] + (size_t)layer * DFF * DM; WT = (bf16_t*)(wl + W_D2); N = DM; ldk = DFF; nnb = 32; }
        const int kb = r / nnb, nb = r - kb * nnb, k0 = kb * 64, n0 = nb * 64;
        const int drow0 = kind ? ((n0 >> 7) * 256 + (kind - 1) * 128 + (n0 & 127)) : n0;
        tr_item(W, N, gk, WT, ldk, drow0, k0, n0, scr, lane);
    }
    bf16_t* hb = (bf16_t*)(p.ws + WS_HB);
    for (int m = gw; m < MT; m += NGW) {
        const float* xr = (m < MP) ? p.in[I_XP] + (size_t)m * DM : p.in[I_XS] + (size_t)(m - MP) * DM;
        float s = 0.f;
#pragma unroll
        for (int j = 0; j < 4; ++j) { const f32x4 v0 = *(const f32x4*)(xr + j * 512 + lane * 8), v1 = *(const f32x4*)(xr + j * 512 + lane * 8 + 4);
            s += (v0[0] * v0[0] + v0[1] * v0[1]) + (v0[2] * v0[2] + v0[3] * v0[3]) + (v1[0] * v1[0] + v1[1] * v1[1]) + (v1[2] * v1[2] + v1[3] * v1[3]);
            u32x4 w; w.x = cvt_pk_bf16(v0[0], v0[1]); w.y = cvt_pk_bf16(v0[2], v0[3]); w.z = cvt_pk_bf16(v1[0], v1[1]); w.w = cvt_pk_bf16(v1[2], v1[3]);
            *(u32x4*)(hb + (size_t)m * DM + j * 512 + lane * 8) = w; }
        s = wave_sum(s);
        if (lane == 0) ss[m] = s;
    }
}

__device__ __forceinline__ void ld8_bf16(const bf16_t* p, float (&v)[8]) {
    const u32x4 w = *(const u32x4*)p;
    v[0] = bf_lo(w.x); v[1] = bf_hi(w.x); v[2] = bf_lo(w.y); v[3] = bf_hi(w.y); v[4] = bf_lo(w.z); v[5] = bf_hi(w.z); v[6] = bf_lo(w.w); v[7] = bf_hi(w.w);
}
__device__ __forceinline__ void ld8_f32(const float* p, float (&v)[8]) {
    const f32x4 a = *(const f32x4*)p, b = *(const f32x4*)(p + 4);
    v[0] = a[0]; v[1] = a[1]; v[2] = a[2]; v[3] = a[3]; v[4] = b[0]; v[5] = b[1]; v[6] = b[2]; v[7] = b[3];
}
__device__ __forceinline__ void st8_f32(float* p, const float (&v)[8]) {
    *(f32x4*)p = (f32x4){v[0], v[1], v[2], v[3]}; *(f32x4*)(p + 4) = (f32x4){v[4], v[5], v[6], v[7]};
}
__device__ __forceinline__ void st8_bf16(bf16_t* p, const float (&v)[8]) {
    u32x4 w; w.x = cvt_pk_bf16(v[0], v[1]); w.y = cvt_pk_bf16(v[2], v[3]); w.z = cvt_pk_bf16(v[4], v[5]); w.w = cvt_pk_bf16(v[6], v[7]);
    *(u32x4*)p = w;
}

constexpr int TOK = 16, HALO = 30, VROWS = TOK + HALO, CH = 384;
__device__ __forceinline__ void mixer_mid(const Params& p, LAS unsigned char* lds, int G, int layer) {
    int tid = threadIdx.x; asm volatile("" : "+v"(tid));
    const int lane = tid & 63, wave = __builtin_amdgcn_readfirstlane(tid >> 6);
    LAS float* vt = (LAS float*)lds;
    LAS float* cb = (LAS float*)(lds + VROWS * CH * 4);
    const bf16_t* z = (const bf16_t*)(p.ws + WS_ACT);
    bf16_t* cat = (bf16_t*)(p.ws + WS_CAT);
    const float* caw = p.in[I_CAW] + layer * 3 * DA;
    const float* cbw = p.in[I_CBW] + layer * 31 * DB;
    const float* cbb = p.in[I_CBB] + layer * DB;
    const float* lng = p.in[I_LNG] + layer * DB;
    const float* lnb = p.in[I_LNB] + layer * DB;
    constexpr int NCH = MT / TOK, NCH_X = NCH / 8;
    static_assert(NCH % 8 == 0, "chunks divide over the XCDs");
    const int mx_x = (G % 8 == 0) ? (int)(blockIdx.x & 7) : 0, mx_r = (G % 8 == 0) ? (int)(blockIdx.x >> 3) : (int)blockIdx.x, mx_n = (G % 8 == 0) ? G / 8 : G, mx_tot = (G % 8 == 0) ? NCH_X : NCH;
    u32x4 ra[5], rg[5]; bool preloaded = false;
#define MIX_VLOAD(hc_, row0_) do { _Pragma("unroll") for (int i = 0; i < 5; ++i) { const int it = tid + 512 * i; if (it < VROWS * (CH / 8)) { const int j = it / (CH / 8), cl = (it - j * (CH / 8)) * 8; \
            const bf16_t* zr = z + ((ptrdiff_t)(row0_) - HALO + j) * DIN + (hc_) * CH + cl; ra[i] = *(const u32x4*)(zr + 2304); rg[i] = *(const u32x4*)(zr + 3072); } } } while (0)
    for (int ci = mx_r; ci < mx_tot; ci += mx_n) {
        const int ch = mx_x * NCH_X + ci;
        const bool samp = ch >= MP / TOK;
        int seq, l0, L;
        if (!samp) { seq = ch >> 9; l0 = (ch & 511) * TOK; L = 8192; } else { const int cs = ch - MP / TOK; seq = cs >> 2; l0 = (cs & 3) * TOK; L = 64; }
        const int row0 = ch * TOK;
        const bool lastc = (l0 + TOK == L), edge = (l0 < 32);
        const float* hist_a = p.in[I_CA] + (size_t)(layer * 8 + seq) * 2 * DA;
        const float* hist_b = p.in[I_CB] + (size_t)(layer * 8 + seq) * 30 * DB;
        const float* hist_p = p.in[I_CP] + (size_t)(layer * 8 + seq) * 15 * DC;
        float* out_a = p.out + (samp ? OFF_A_S + (layer * 8 + seq) * 2 * DA : OFF_A_P + (layer * 2 + seq) * 2 * DA);
        float* out_b = p.out + (samp ? OFF_B_S + (layer * 8 + seq) * 30 * DB : OFF_B_P + (layer * 2 + seq) * 30 * DB);
        float* out_p = p.out + (samp ? OFF_P_S + (layer * 8 + seq) * 15 * DC : OFF_P_P + (layer * 2 + seq) * 15 * DC);
        if (!preloaded) MIX_VLOAD(0, row0);
        preloaded = false;
#pragma unroll 1
        for (int hc = 0; hc < 2; ++hc) {
#pragma unroll
            for (int i = 0; i < 5; ++i) { const int it = tid + 512 * i; if (it < VROWS * (CH / 8)) { const int j = it / (CH / 8), cl = (it - j * (CH / 8)) * 8, c8 = hc * CH + cl;
                float v[8];
                v[0] = bf_lo(ra[i].x) * sigmoidf_(bf_lo(rg[i].x)); v[1] = bf_hi(ra[i].x) * sigmoidf_(bf_hi(rg[i].x));
                v[2] = bf_lo(ra[i].y) * sigmoidf_(bf_lo(rg[i].y)); v[3] = bf_hi(ra[i].y) * sigmoidf_(bf_hi(rg[i].y));
                v[4] = bf_lo(ra[i].z) * sigmoidf_(bf_lo(rg[i].z)); v[5] = bf_hi(ra[i].z) * sigmoidf_(bf_hi(rg[i].z));
                v[6] = bf_lo(ra[i].w) * sigmoidf_(bf_lo(rg[i].w)); v[7] = bf_hi(ra[i].w) * sigmoidf_(bf_hi(rg[i].w));
                if (edge) { const int l = l0 - HALO + j;
                    if (l < 0) { if (samp) ld8_f32(hist_b + (size_t)(30 + l) * DB + c8, v); else {
#pragma unroll
                        for (int e = 0; e < 8; ++e) v[e] = 0.f; } } }
                *(LAS f32x4*)(vt + j * CH + cl) = (f32x4){v[0], v[1], v[2], v[3]}; *(LAS f32x4*)(vt + j * CH + cl + 4) = (f32x4){v[4], v[5], v[6], v[7]};
                if (lastc && j >= TOK) st8_f32(out_b + (size_t)(j - TOK) * DB + c8, v); } }
            if (hc == 0) MIX_VLOAD(1, row0);
            else {
#pragma unroll
                for (int i = 0; i < 4; ++i) { const int it = tid + 512 * i; if (it < 31 * 64) { const int j = it >> 6, c8 = (it & 63) * 8; ra[i] = *(const u32x4*)(z + ((ptrdiff_t)row0 - 15 + j) * DIN + 3840 + c8); } } }
            __syncthreads();
            if (tid < CH) {
                const int c = hc * CH + tid;
                float wv[31];
#pragma unroll
                for (int k = 0; k < 31; ++k) wv[k] = cbw[k * DB + c];
                const float bias = cbb[c];
                float o[TOK];
#pragma unroll
                for (int i = 0; i < TOK; ++i) o[i] = bias;
                const LAS float* vp = vt + tid;
#pragma unroll
                for (int jj = 0; jj < VROWS; ++jj) { const float x = vp[jj * CH];
#pragma unroll
                    for (int i = 0; i < TOK; ++i) { if (jj - i >= 0 && jj - i <= 30) o[i] += wv[(jj - i >= 0 && jj - i <= 30) ? jj - i : 0] * x; } }
#pragma unroll
                for (int i = 0; i < TOK; ++i) cb[i * DB + c] = o[i];
            }
            __syncthreads();
        }
#pragma unroll
        for (int i = 0; i < 4; ++i) { const int it = tid + 512 * i; if (it < 31 * 64) { const int j = it >> 6, c8 = (it & 63) * 8; const u32x4 r = ra[i];
            float u[8] = {bf_lo(r.x), bf_hi(r.x), bf_lo(r.y), bf_hi(r.y), bf_lo(r.z), bf_hi(r.z), bf_lo(r.w), bf_hi(r.w)};
            if (edge) { const int l = l0 - 15 + j;
                if (l < 0) { if (samp) ld8_f32(hist_p + (size_t)(15 + l) * DC + c8, u); else {
#pragma unroll
                    for (int e = 0; e < 8; ++e) u[e] = 0.f; } } }
            *(LAS f32x4*)(vt + j * DC + c8) = (f32x4){u[0], u[1], u[2], u[3]}; *(LAS f32x4*)(vt + j * DC + c8 + 4) = (f32x4){u[4], u[5], u[6], u[7]}; } }
        { const int cin = ci + mx_n;
          if (cin < mx_tot) { MIX_VLOAD(0, (mx_x * NCH_X + cin) * TOK); preloaded = true; } }
#pragma unroll 1
        for (int tt = 0; tt < 2; ++tt) { const int tk = wave * 2 + tt; f32x2 x[6]; float s = 0.f;
#pragma unroll
            for (int i = 0; i < 6; ++i) { x[i] = *(const LAS f32x2*)(cb + tk * DB + 128 * i + 2 * lane); s += x[i].x + x[i].y; }
            const float mean = wave_sum(s) * (1.f / DB); float q2 = 0.f;
#pragma unroll
            for (int i = 0; i < 6; ++i) { x[i].x -= mean; x[i].y -= mean; q2 += x[i].x * x[i].x + x[i].y * x[i].y; }
            const float rstd = __builtin_amdgcn_rsqf(wave_sum(q2) * (1.f / DB) + EPS);
#pragma unroll
            for (int i = 0; i < 6; ++i) { const int c = 128 * i + 2 * lane; const f32x2 gg = *(const f32x2*)(lng + c), bb = *(const f32x2*)(lnb + c);
                const float y0 = siluf_(x[i].x * rstd * gg.x + bb.x), y1 = siluf_(x[i].y * rstd * gg.y + bb.y);
                *(unsigned*)(cat + (size_t)(row0 + tk) * DM + DA + c) = cvt_pk_bf16(y0, y1); } }
#pragma unroll 1
        for (int i = 0; i < 3; ++i) { const int it = tid + 512 * i, tk = it / 96, c8 = (it - tk * 96) * 8, l = l0 + tk; const size_t row = row0 + tk; const bf16_t* zr = z + row * DIN + c8;
            u32x4 qa[3], qc[3], qb;
#pragma unroll
            for (int q = 0; q < 3; ++q) { qa[q] = *(const u32x4*)(zr - (ptrdiff_t)(2 - q) * DIN); qc[q] = *(const u32x4*)(zr - (ptrdiff_t)(2 - q) * DIN + 1536); }
            qb = *(const u32x4*)(zr + 768);
            float y[8], t[8], w[8];
#pragma unroll
            for (int e = 0; e < 8; ++e) y[e] = 0.f;
#pragma unroll
            for (int q = 0; q < 3; ++q) { ld8_f32(caw + q * DA + c8, w);
                t[0] = bf_lo(qa[q].x) * bf_lo(qc[q].x); t[1] = bf_hi(qa[q].x) * bf_hi(qc[q].x); t[2] = bf_lo(qa[q].y) * bf_lo(qc[q].y); t[3] = bf_hi(qa[q].y) * bf_hi(qc[q].y);
                t[4] = bf_lo(qa[q].z) * bf_lo(qc[q].z); t[5] = bf_hi(qa[q].z) * bf_hi(qc[q].z); t[6] = bf_lo(qa[q].w) * bf_lo(qc[q].w); t[7] = bf_hi(qa[q].w) * bf_hi(qc[q].w);
                if (edge) { const int lq = l - 2 + q;
                    if (lq < 0) { if (samp) ld8_f32(hist_a + (size_t)(2 + lq) * DA + c8, t); else {
#pragma unroll
                        for (int e = 0; e < 8; ++e) t[e] = 0.f; } } }
#pragma unroll
                for (int e = 0; e < 8; ++e) y[e] += w[e] * t[e]; }
            y[0] *= bf_lo(qb.x); y[1] *= bf_hi(qb.x); y[2] *= bf_lo(qb.y); y[3] *= bf_hi(qb.y); y[4] *= bf_lo(qb.z); y[5] *= bf_hi(qb.z); y[6] *= bf_lo(qb.w); y[7] *= bf_hi(qb.w);
            st8_bf16(cat + row * DM + c8, y);
            if (lastc && tk >= TOK - 2) st8_f32(out_a + (size_t)(tk - (TOK - 2)) * DA + c8, t); }
        __syncthreads();
#pragma unroll 1
        for (int i = 0; i < 2; ++i) { const int it = tid + 512 * i, tk = it >> 6, c8 = (it & 63) * 8, l = l0 + tk; const size_t row = row0 + tk; const int w = 2 << (c8 >> 7);
            const LAS float* up = vt + (15 + tk) * DC + c8;
            const f32x4 u0a = *(const LAS f32x4*)up, u0b = *(const LAS f32x4*)(up + 4);
            f32x4 sa = u0a, sb = u0b;
            for (int q = 1; q < w; ++q) { sa += *(const LAS f32x4*)(up - q * DC); sb += *(const LAS f32x4*)(up - q * DC + 4); }
            const int cnt = (samp || l + 1 >= w) ? w : l + 1;
            const float rc = 1.f / (float)cnt; float d[8], u0[8];
#pragma unroll
            for (int e = 0; e < 4; ++e) { u0[e] = u0a[e]; u0[4 + e] = u0b[e]; d[e] = sa[e] * rc - u0a[e]; d[4 + e] = sb[e] * rc - u0b[e]; }
            st8_bf16(cat + row * DM + 1536 + c8, d);
            if (lastc && tk >= 1) st8_f32(out_p + (size_t)(tk - 1) * DC + c8, u0); }
        __syncthreads();
    }
#undef MIX_VLOAD
}

__device__ __forceinline__ void sample_fixup(const Params& p, int G, float* ss_out) {
    int tid = threadIdx.x; asm volatile("" : "+v"(tid));
    const int lane = tid & 63, wave = __builtin_amdgcn_readfirstlane(tid >> 6);
    bf16_t* hb = (bf16_t*)(p.ws + WS_HB);
    const float* slab = (const float*)(p.ws + WS_SLAB);
    for (int m = blockIdx.x * 8 + wave; m < MS; m += G * 8) {
        bf16_t* hr = hb + (size_t)(MP + m) * DM; float s = 0.f;
#pragma unroll
        for (int j = 0; j < 4; ++j) { const int c = j * 512 + lane * 8; float b[8]; ld8_bf16(hr + c, b);
            f32x4 v0 = (f32x4){b[0], b[1], b[2], b[3]}, v1 = (f32x4){b[4], b[5], b[6], b[7]};
#pragma unroll
            for (int q = 0; q < 4; ++q) { const float* sr = slab + (size_t)q * (MS * DM) + (size_t)m * DM + c; v0 += *(const f32x4*)sr; v1 += *(const f32x4*)(sr + 4); }
            u32x4 w; w.x = cvt_pk_bf16(v0[0], v0[1]); w.y = cvt_pk_bf16(v0[2], v0[3]); w.z = cvt_pk_bf16(v1[0], v1[1]); w.w = cvt_pk_bf16(v1[2], v1[3]);
            *(u32x4*)(hr + c) = w;
            const float r[8] = {bf_lo(w.x), bf_hi(w.x), bf_lo(w.y), bf_hi(w.y), bf_lo(w.z), bf_hi(w.z), bf_lo(w.w), bf_hi(w.w)};
#pragma unroll
            for (int e = 0; e < 8; ++e) s += r[e] * r[e]; }
        s = wave_sum(s);
        if (lane == 0) ss_out[MP + m] = s;
    }
    const float* ssp = (const float*)(p.ws + WS_SSP);
    for (int r2 = blockIdx.x * 8 + wave; r2 < MP / 2; r2 += G * 8) {
        const int row = r2 * 2 + (lane >> 5);
        float v = ssp[(size_t)row * 32 + (lane & 31)];
#pragma unroll
        for (int o = 1; o < 32; o <<= 1) v += __shfl_xor(v, o);
        if ((lane & 31) == 0) ss_out[row] = v;
    }
}

__device__ __forceinline__ void final_norm(const Params& p, int G) {
    int tid = threadIdx.x; asm volatile("" : "+v"(tid));
    const int lane = tid & 63, wave = __builtin_amdgcn_readfirstlane(tid >> 6);
    const int gw = blockIdx.x * 8 + wave, NGW = G * 8;
    const float* ss = (const float*)(p.ws + WS_SS) + 6 * MT;
    const float* gn = p.in[I_NF];
    const bf16_t* hb = (const bf16_t*)(p.ws + WS_HB);
    for (int m = gw; m < MT; m += NGW) {
        const float rinv = __builtin_amdgcn_rsqf(ss[m] * (1.f / DM) + EPS);
        float* orow = p.out + (size_t)m * DM;
#pragma unroll
        for (int j = 0; j < 4; ++j) { const int c = j * 512 + lane * 8; float b[8], g[8]; ld8_bf16(hb + (size_t)m * DM + c, b); ld8_f32(gn + c, g);
#pragma unroll
            for (int e = 0; e < 8; ++e) b[e] = b[e] * rinv * g[e];
            st8_f32(orow + c, b); }
    }
}

__device__ __forceinline__ void final_fused(const Params& p, int G) {
    int tid = threadIdx.x; asm volatile("" : "+v"(tid));
    const int lane = tid & 63, wave = __builtin_amdgcn_readfirstlane(tid >> 6);
    const int gw = blockIdx.x * 8 + wave, NGW = G * 8;
    const float* gn = p.in[I_NF];
    const bf16_t* hb = (const bf16_t*)(p.ws + WS_HB);
    const float* ssp = (const float*)(p.ws + WS_SSP);
    const float* slab = (const float*)(p.ws + WS_SLAB);
    for (int m = gw; m < MT; m += NGW) {
        float b[4][8]; float s;
#pragma unroll
        for (int j = 0; j < 4; ++j) ld8_bf16(hb + (size_t)m * DM + j * 512 + lane * 8, b[j]);
        if (m < MP) {
            float v = ssp[(size_t)m * 32 + (lane & 31)];
#pragma unroll
            for (int o = 1; o < 32; o <<= 1) v += __shfl_xor(v, o);
            s = v;
        } else {
            s = 0.f;
#pragma unroll
            for (int j = 0; j < 4; ++j) {
#pragma unroll
                for (int q = 0; q < 4; ++q) { float t[8]; ld8_f32(slab + (size_t)q * (MS * DM) + (size_t)(m - MP) * DM + j * 512 + lane * 8, t);
#pragma unroll
                    for (int e = 0; e < 8; ++e) b[j][e] += t[e]; }
#pragma unroll
                for (int e = 0; e < 8; ++e) s += b[j][e] * b[j][e]; }
            s = wave_sum(s);
        }
        const float rinv = __builtin_amdgcn_rsqf(s * (1.f / DM) + EPS);
        float* orow = p.out + (size_t)m * DM;
#pragma unroll
        for (int j = 0; j < 4; ++j) { const int c = j * 512 + lane * 8; float g[8]; ld8_f32(gn + c, g);
#pragma unroll
            for (int e = 0; e < 8; ++e) b[j][e] = b[j][e] * rinv * g[e];
            st8_f32(orow + c, b[j]); }
    }
}

#define XB_TMO      128
#define XB_XCNT(j)  (256  + 64 * (j))
#define XB_XSUB(j)  (1280 + 64 * (j))
#define XB_XGEN(j)  (2304 + 64 * (j))
#define XB_TOP      3328
#define XB_TOPGEN   3392
#define XCD_BAR_WORDS 3456
#define XB_SPIN_CAP (1u << 22)
__device__ __forceinline__ unsigned xb_ld(unsigned* p)              { return __hip_atomic_load(p, __ATOMIC_RELAXED, __HIP_MEMORY_SCOPE_AGENT); }
__device__ __forceinline__ unsigned xb_add(unsigned* p, unsigned v) { return __hip_atomic_fetch_add(p, v, __ATOMIC_RELAXED, __HIP_MEMORY_SCOPE_AGENT); }
__device__ __forceinline__ unsigned xb_xcc_id() { return (unsigned)__builtin_amdgcn_s_getreg((3 << 11) | 20) & 0xFu; }
#define XB_SPIN(cond, bar) do { unsigned _sp = 0; while (cond) { __builtin_amdgcn_s_sleep(1); \
    if ((++_sp & 255u) == 0u) { if (xb_ld(&(bar)[XB_TMO])) break; if (_sp > XB_SPIN_CAP) { atomicAdd(&(bar)[XB_TMO], 1u); break; } } } } while (0)
struct XcdBarrier { unsigned* bar; unsigned x; volatile LAS unsigned* st; };
__device__ __forceinline__ XcdBarrier xcd_barrier_post(unsigned* bar, volatile LAS unsigned* st) {
    XcdBarrier b; b.bar = bar; b.x = xb_xcc_id(); b.st = st;
    if (threadIdx.x == 0) (void)xb_add(&bar[XB_XCNT(b.x)], 1u);
    return b;
}
__device__ __forceinline__ void xcd_barrier_complete(unsigned* bar, unsigned x, unsigned& nloc, unsigned& nx) {
    const unsigned G = gridDim.x * gridDim.y * gridDim.z;
    unsigned sum, cnt, mine, sp = 0u;
    for (;;) {
        sum = 0u; cnt = 0u; mine = 0u;
#pragma unroll
        for (unsigned j = 0; j < 16; ++j) { const unsigned c = xb_ld(&bar[XB_XCNT(j)]); sum += c; cnt += (c > 0u) ? 1u : 0u; mine = (j == x) ? c : mine; }
        if (sum == G) break;
        __builtin_amdgcn_s_sleep(1);
        if ((++sp & 255u) == 0u) { if (xb_ld(&bar[XB_TMO])) break; if (sp > XB_SPIN_CAP) { atomicAdd(&bar[XB_TMO], 1u); break; } }
    }
    nloc = mine > 0u ? mine : 1u; nx = cnt > 0u ? cnt : 1u;
}
__device__ __forceinline__ void xcd_barrier(const XcdBarrier& b) {
    asm volatile("s_waitcnt vmcnt(0)" ::: "memory");
    __syncthreads();
    if (threadIdx.x == 0) {
        unsigned* bar = b.bar;
        __builtin_amdgcn_s_waitcnt(0);
        unsigned nloc = b.st[0], nx = b.st[1];
        if (nloc == 0u) { xcd_barrier_complete(bar, b.x, nloc, nx); b.st[0] = nloc; b.st[1] = nx; }
        const unsigned old = xb_add(&bar[XB_XSUB(b.x)], 1u);
        const unsigned gen = old / nloc;
        if (old + 1u == (gen + 1u) * nloc) {
            __builtin_amdgcn_fence(__ATOMIC_RELEASE, "agent");
            asm volatile("s_waitcnt vmcnt(0)" ::: "memory");
            const unsigned og = xb_add(&bar[XB_TOP], 1u);
            const unsigned tg = og / nx;
            if (og + 1u == (tg + 1u) * nx) xb_add(&bar[XB_TOPGEN], 1u);
            else XB_SPIN(xb_ld(&bar[XB_TOPGEN]) == tg, bar);
            __builtin_amdgcn_fence(__ATOMIC_ACQUIRE, "agent");
            xb_add(&bar[XB_XGEN(b.x)], 1u);
            asm volatile("s_waitcnt vmcnt(0)" ::: "memory");
        } else {
            XB_SPIN(xb_ld(&bar[XB_XGEN(b.x)]) == gen, bar);
            __builtin_amdgcn_fence(__ATOMIC_ACQUIRE, "agent");
            asm volatile("s_waitcnt vmcnt(0)" ::: "memory");
        }
    }
    __syncthreads();
}

__global__ void __launch_bounds__(512, 2) fwd_megakernel(Params p) {
    extern __shared__ __attribute__((aligned(16))) unsigned char lds_raw[];
    LAS unsigned char* lds = (LAS unsigned char*)lds_raw;
    cg::grid_group grid = cg::this_grid();
    const int G = gridDim.x;
    float* ssb = (float*)(p.ws + WS_SS);
    bf16_t* hb = (bf16_t*)(p.ws + WS_HB);
    bf16_t* act = (bf16_t*)(p.ws + WS_ACT);
    bf16_t* cat = (bf16_t*)(p.ws + WS_CAT);

    volatile LAS unsigned* misc = (volatile LAS unsigned*)(lds + MISC_OFF);
    if (threadIdx.x < 2) misc[threadIdx.x] = 0u;
    __syncthreads();
    const XcdBarrier xbar = xcd_barrier_post((unsigned*)(p.ws + WS_BAR), misc);
#pragma unroll 1
    for (int rep = 0; rep < REP_PRO; ++rep)
    prologue(p, lds, G);
#define GRID_BAR() xcd_barrier(xbar)
    if (gridDim.y > 1u) grid.sync();
    GRID_BAR();

    for (int st = 0; st < 6; ++st) {
        const int layer = st / 3, sub = st - layer * 3;
        unsigned char* wl = p.ws + WS_W + (size_t)layer * W_LAYER;
        if (sub != 1) {
            const int f = sub >> 1;
            const float* ss_in = ssb + (size_t)(layer * 3 + (f ? 2 : 0)) * MT;
            float* ss_out = ssb + (size_t)(layer * 3 + (f ? 3 : 1)) * MT;
            const bf16_t* wgu = (const bf16_t*)(wl + (f ? W_GU2 : W_GU1));
            const bf16_t* wd = (const bf16_t*)(wl + (f ? W_D2 : W_D1));
            { pg8::Gemm g{hb, wgu, MT, 2 * DFF, DM, DM / 64}; pg8::StaticOrder S; S.init(MT, 2 * DFF, G, (int)blockIdx.x);
              pg8::EpiSwiGLU E{act, ss_in};
#pragma unroll 1
              for (int rep = 0; rep < REP_GU; ++rep)
              pg8::gemm_phase<pg8::EpiSwiGLU, pg8::StaticOrder, true, true>(lds, g, S, E); }
            GRID_BAR();
            { const bool first = (st == 0);
              { pg8::Gemm g{act, wd, MP, DM, DFF, DFF / 64}; pg8::StaticOrder S; S.init(MP, DM, G, (int)blockIdx.x);
                pg8::EpiResid E{hb, (float*)(p.ws + WS_SSP), 0.5f};
                pg8::gemm_phase<pg8::EpiResid, pg8::StaticOrder, true, true>(lds, g, S, E); }
              { pg8::Gemm g{act, wd, MT, DM, DFF, DFF / 256}; pg8::SplitOrder S{(int)blockIdx.x, (DFF / 4) * 2};
                pg8::EpiSlab E{(float*)(p.ws + WS_SLAB), 0.5f, (DFF / 4) * 2};
                pg8::gemm_phase<pg8::EpiSlab, pg8::SplitOrder, true, true>(lds, g, S, E); } }
            GRID_BAR();
            if (st != 5) { sample_fixup(p, G, ss_out); GRID_BAR(); }
        } else {
            const float* ss_in = ssb + (size_t)(layer * 3 + 1) * MT;
            float* ss_out = ssb + (size_t)(layer * 3 + 2) * MT;
            { pg8::Gemm g{hb, (const bf16_t*)(wl + W_IN), MT, DIN, DM, DM / 64}; pg8::StaticOrder S; S.init(MT, DIN, G, (int)blockIdx.x);
              pg8::EpiScaleBf16 E{act, DIN, ss_in};
#pragma unroll 1
              for (int rep = 0; rep < REP_WIN; ++rep)
              pg8::gemm_phase<pg8::EpiScaleBf16, pg8::StaticOrder, true, true>(lds, g, S, E); }
            GRID_BAR();
#pragma unroll 1
            for (int rep = 0; rep < REP_MIX; ++rep)
            mixer_mid(p, lds, G, layer);
            GRID_BAR();
            { pg8::Gemm g{cat, (const bf16_t*)(wl + W_OUT), MP, DM, DM, DM / 64}; pg8::StaticOrder S; S.init(MP, DM, G, (int)blockIdx.x);
              pg8::EpiResid E{hb, (float*)(p.ws + WS_SSP), 1.0f};
              pg8::gemm_phase<pg8::EpiResid, pg8::StaticOrder, true, true>(lds, g, S, E); }
            { pg8::Gemm g{cat, (const bf16_t*)(wl + W_OUT), MT, DM, DM, DM / 256}; pg8::SplitOrder S{(int)blockIdx.x, (DM / 4) * 2};
              pg8::EpiSlab E{(float*)(p.ws + WS_SLAB), 1.0f, (DM / 4) * 2};
              pg8::gemm_phase<pg8::EpiSlab, pg8::SplitOrder, true, true>(lds, g, S, E); }
            GRID_BAR();
            sample_fixup(p, G, ss_out);
            GRID_BAR();
        }
    }
    final_fused(p, G);
}

extern "C" void kernel_launch(void* const* d_in, const int* in_sizes, int n_in, void* d_out, int out_size, void* d_ws, size_t ws_size, hipStream_t stream) {
    static int grid = 0;
    if (grid == 0) {
        if (n_in != 24 || ws_size < WS_END) { fprintf(stderr, "kernel_launch: need 24 inputs and >= %zu bytes of workspace (got %d, %zu)\n", (size_t)WS_END, n_in, ws_size); grid = -1; return; }
        int dev = 0, cus = 0, per_cu = 0;
        hipGetDevice(&dev);
        hipDeviceGetAttribute(&cus, hipDeviceAttributeMultiprocessorCount, dev);
        hipFuncSetAttribute((const void*)fwd_megakernel, hipFuncAttributeMaxDynamicSharedMemorySize, LDS_BYTES);
        hipOccupancyMaxActiveBlocksPerMultiprocessor(&per_cu, (const void*)fwd_megakernel, 512, LDS_BYTES);
        if (per_cu < 1) { fprintf(stderr, "kernel_launch: occupancy query returned %d\n", per_cu); per_cu = 1; }
        grid = cus * per_cu;
    }
    if (grid < 0) return;
    if (hipMemsetAsync((char*)d_ws + WS_BAR, 0, WS_BAR_BYTES, stream) != hipSuccess) { fprintf(stderr, "kernel_launch: memset failed\n"); return; }
    Params p{};
    for (int i = 0; i < 24; ++i) p.in[i] = (const float*)d_in[i];
    p.out = (float*)d_out; p.ws = (unsigned char*)d_ws;
    void* args[] = {&p};
    hipError_t e = hipLaunchCooperativeKernel((void*)fwd_megakernel, dim3(grid), dim3(512), args, LDS_BYTES, stream);
    if (e != hipSuccess) fprintf(stderr, "cooperative launch failed: %s (grid %d)\n", hipGetErrorString(e), grid);
}
```

```cpp
#include <hip/hip_runtime.h>
#include <hip/hip_cooperative_groups.h>
#include <cstdio>
#include <cstdint>
namespace cg = cooperative_groups;

#define LAS __attribute__((address_space(3)))
typedef unsigned short bf16_t;
typedef short bf16x8 __attribute__((ext_vector_type(8)));
typedef float f32x4 __attribute__((ext_vector_type(4)));
typedef float f32x2 __attribute__((ext_vector_type(2)));
typedef unsigned u32x4 __attribute__((ext_vector_type(4)));
typedef unsigned u32x2 __attribute__((ext_vector_type(2)));

constexpr int DM = 2048, DFF = 5632, DIN = 4352, DA = 768, DB = 768, DC = 512;
constexpr int MP = 16384, MS = 512, MT = MP + MS;
constexpr float EPS = 1e-6f;
constexpr size_t MiB = 1u << 20;
constexpr size_t WS_SS = 0, WS_W = 1 * MiB, W_LAYER = 157 * MiB;
constexpr size_t W_GU1 = 0, W_D1 = 44 * MiB, W_IN = 66 * MiB, W_OUT = 83 * MiB, W_GU2 = 91 * MiB, W_D2 = 135 * MiB;
constexpr size_t WS_HB = 315 * MiB, WS_ACT = 381 * MiB, WS_CAT = 563 * MiB, WS_SLAB = 629 * MiB, WS_SSP = 645 * MiB, WS_END = 648 * MiB;
constexpr int OFF_A_P = 34603008, OFF_B_P = OFF_A_P + 6144, OFF_P_P = OFF_B_P + 92160, OFF_A_S = OFF_P_P + 30720, OFF_B_S = OFF_A_S + 24576, OFF_P_S = OFF_B_S + 368640;
#ifndef REP_GU
#define REP_GU 1
#endif
#ifndef REP_WIN
#define REP_WIN 1
#endif
#ifndef REP_MIX
#define REP_MIX 1
#endif
#ifndef REP_PRO
#define REP_PRO 1
#endif
constexpr int LDS_BYTES = 147456, MISC_OFF = 139264;
constexpr size_t WS_BAR = 512 * 1024, WS_BAR_BYTES = 16384;

#define LDS_WAIT() asm volatile("s_waitcnt lgkmcnt(0)" ::: "memory")

__device__ __forceinline__ unsigned cvt_pk_bf16(float lo, float hi) { unsigned r; asm volatile("v_cvt_pk_bf16_f32 %0, %1, %2" : "=v"(r) : "v"(lo), "v"(hi)); return r; }
__device__ __forceinline__ float bf_lo(unsigned w) { return __uint_as_float(w << 16); }
__device__ __forceinline__ float bf_hi(unsigned w) { return __uint_as_float(w & 0xffff0000u); }
__device__ __forceinline__ float sigmoidf_(float x) { return __builtin_amdgcn_rcpf(1.f + __builtin_amdgcn_exp2f(-1.44269504f * x)); }
__device__ __forceinline__ float siluf_(float x) { return x * sigmoidf_(x); }
__device__ __forceinline__ float wave_sum(float v) {
#pragma unroll
    for (int o = 1; o < 64; o <<= 1) v += __shfl_xor(v, o);
    return v;
}

namespace pg8 {
constexpr int BM = 256, BK = 64, HALF = 128, HTB = HALF * BK * 2, STAGE_BYTES = 8 * HTB, NXCD = 8, WGM = 4;
__host__ __device__ __forceinline__ int lds_byte(int r, int c) { const int st = (r >> 4) * 2 + (c >> 5), rr = r & 15, cc = c & 31, ob = rr * 64 + cc * 2; return st * 1024 + (ob ^ (((ob >> 9) & 1) << 5)); }
__host__ __device__ __forceinline__ void stage_rc(int b, int& R, int& C) { const int st = b / 1024, sb = b % 1024, swz = sb ^ (((sb >> 9) & 1) << 5); R = (st >> 1) * 16 + swz / 64; C = (st & 1) * 32 + (swz % 64) / 2; }
__host__ __device__ __forceinline__ int perm32(int rho) { const int n = rho >> 4, i = rho & 15; return 8 * (i >> 2) + 4 * n + (i & 3); }

struct Unit { int pm, pn, kb; };
struct Gemm { const bf16_t* A; const bf16_t* Bt; int M, N, K, nt; };

struct StaticOrder {
    int nM, nN, nwg, G, c;
    __device__ void init(int M, int N, int G_, int c_) { nM = M / BM; nN = N / BM; nwg = nM * nN; G = G_; c = c_; }
    __device__ __forceinline__ bool next(int i, Unit& u) const {
        const long L = (long)i * G + c; if (L >= nwg) return false;
        int wgid = (int)L; { const int q = nwg / NXCD, r = nwg % NXCD, xcd = wgid % NXCD, off = wgid / NXCD; wgid = (xcd < r ? xcd * (q + 1) : r * (q + 1) + (xcd - r) * q) + off; }
        const int nig = WGM * nN, gid = wgid / nig, fm = gid * WGM, gsz = (nM - fm) < WGM ? (nM - fm) : WGM;
        u.pm = fm + ((wgid % nig) % gsz); u.pn = (wgid % nig) / gsz; u.kb = 0; return true;
    }
    __device__ __forceinline__ void a_ready(const Unit&) const {}
    __device__ __forceinline__ void done(const Unit&) const {}
};

struct EpiSwiGLU {
    static constexpr bool PERM = true, AFTER_DRAIN = false, PREF = true;
    bf16_t* O; const float* ss;
    __device__ __forceinline__ void prefetch(const Unit& u, int wr, int fr, float (&sv)[8]) const {
        const int row0 = u.pm * BM + wr * 64 + fr;
#pragma unroll
        for (int ai = 0; ai < 2; ++ai)
#pragma unroll
            for (int m = 0; m < 4; ++m) sv[ai * 4 + m] = ss[row0 + ai * HALF + m * 16];
    }
    __device__ __forceinline__ void operator()(const f32x4 (&acc)[2][2][4][2], const Unit& u, int wr, int wc, int fr, int fq, const float (&sv)[8]) const {
        const int row0 = u.pm * BM + wr * 64 + fr, col0 = u.pn * HALF + wc * 32 + 8 * fq;
#pragma unroll
        for (int ai = 0; ai < 2; ++ai)
#pragma unroll
            for (int m = 0; m < 4; ++m) {
                const int row = row0 + ai * HALF + m * 16;
                const float rinv = __builtin_amdgcn_rsqf(sv[ai * 4 + m] * (1.f / DM) + EPS), rneg = rinv * -1.44269504f, r2 = rinv * rinv;
                const f32x4 g0 = acc[ai][0][m][0], g1 = acc[ai][0][m][1], u0 = acc[ai][1][m][0], u1 = acc[ai][1][m][1];
                f32x4 e0, e1;
#pragma unroll
                for (int j = 0; j < 4; ++j) { e0[j] = __builtin_amdgcn_rcpf(1.f + __builtin_amdgcn_exp2f(g0[j] * rneg)); e1[j] = __builtin_amdgcn_rcpf(1.f + __builtin_amdgcn_exp2f(g1[j] * rneg)); }
                const f32x4 a0 = (g0 * u0) * (e0 * r2), a1 = (g1 * u1) * (e1 * r2);
                u32x4 w;
                w.x = cvt_pk_bf16(a0[0], a0[1]); w.y = cvt_pk_bf16(a0[2], a0[3]); w.z = cvt_pk_bf16(a1[0], a1[1]); w.w = cvt_pk_bf16(a1[2], a1[3]);
                *(u32x4*)(O + (size_t)row * DFF + col0) = w;
            }
    }
};
struct EpiScaleBf16 {
    static constexpr bool PERM = true, AFTER_DRAIN = false, PREF = true;
    bf16_t* O; int ldc; const float* ss;
    __device__ __forceinline__ void prefetch(const Unit& u, int wr, int fr, float (&sv)[8]) const {
        const int row0 = u.pm * BM + wr * 64 + fr;
#pragma unroll
        for (int ai = 0; ai < 2; ++ai)
#pragma unroll
            for (int m = 0; m < 4; ++m) sv[ai * 4 + m] = ss[row0 + ai * HALF + m * 16];
    }
    __device__ __forceinline__ void operator()(const f32x4 (&acc)[2][2][4][2], const Unit& u, int wr, int wc, int fr, int fq, const float (&sv)[8]) const {
        const int row0 = u.pm * BM + wr * 64 + fr, col0 = u.pn * BM + wc * 32 + 8 * fq;
#pragma unroll
        for (int ai = 0; ai < 2; ++ai)
#pragma unroll
            for (int m = 0; m < 4; ++m) {
                const int row = row0 + ai * HALF + m * 16;
                const float rinv = __builtin_amdgcn_rsqf(sv[ai * 4 + m] * (1.f / DM) + EPS);
                bf16_t* rowp = O + (size_t)row * ldc + col0;
#pragma unroll
                for (int bj = 0; bj < 2; ++bj) { const f32x4 v0 = acc[ai][bj][m][0] * rinv, v1 = acc[ai][bj][m][1] * rinv;
                    u32x4 w; w.x = cvt_pk_bf16(v0[0], v0[1]); w.y = cvt_pk_bf16(v0[2], v0[3]); w.z = cvt_pk_bf16(v1[0], v1[1]); w.w = cvt_pk_bf16(v1[2], v1[3]);
                    *(u32x4*)(rowp + bj * HALF) = w; }
            }
    }
};
struct EpiResid {
    static constexpr bool PERM = true, AFTER_DRAIN = false, PREF = false;
    bf16_t* hb; float* ssn; float scale;
    __device__ __forceinline__ void prefetch(const Unit&, int, int, float (&)[8]) const {}
    __device__ __forceinline__ void operator()(const f32x4 (&acc)[2][2][4][2], const Unit& u, int wr, int wc, int fr, int fq, const float (&)[8]) const {
        const int row0 = u.pm * BM + wr * 64 + fr, col0 = u.pn * BM + wc * 32 + 8 * fq;
        bf16_t* bp0 = hb + (size_t)row0 * DM + col0;
        u32x4 b[2][4][2];
#pragma unroll
        for (int ai = 0; ai < 2; ++ai)
#pragma unroll
            for (int m = 0; m < 4; ++m)
#pragma unroll
                for (int bj = 0; bj < 2; ++bj) b[ai][m][bj] = *(const u32x4*)(bp0 + (size_t)(ai * HALF + m * 16) * DM + bj * HALF);
#pragma unroll
        for (int ai = 0; ai < 2; ++ai) {
#pragma unroll
            for (int m = 0; m < 4; ++m) {
                const int row = row0 + ai * HALF + m * 16;
                float s = 0.f;
#pragma unroll
                for (int bj = 0; bj < 2; ++bj) { const u32x4 bb = b[ai][m][bj];
                    const f32x4 b0 = (f32x4){bf_lo(bb.x), bf_hi(bb.x), bf_lo(bb.y), bf_hi(bb.y)}, b1 = (f32x4){bf_lo(bb.z), bf_hi(bb.z), bf_lo(bb.w), bf_hi(bb.w)};
                    const f32x4 h0 = b0 + acc[ai][bj][m][0] * scale, h1 = b1 + acc[ai][bj][m][1] * scale;
                    u32x4 w; w.x = cvt_pk_bf16(h0[0], h0[1]); w.y = cvt_pk_bf16(h0[2], h0[3]); w.z = cvt_pk_bf16(h1[0], h1[1]); w.w = cvt_pk_bf16(h1[2], h1[3]);
                    *(u32x4*)(bp0 + (size_t)(ai * HALF + m * 16) * DM + bj * HALF) = w;
                    const f32x4 r0 = (f32x4){bf_lo(w.x), bf_hi(w.x), bf_lo(w.y), bf_hi(w.y)}, r1 = (f32x4){bf_lo(w.z), bf_hi(w.z), bf_lo(w.w), bf_hi(w.w)};
                    s += (r0[0] * r0[0] + r0[1] * r0[1]) + (r0[2] * r0[2] + r0[3] * r0[3]) + (r1[0] * r1[0] + r1[1] * r1[1]) + (r1[2] * r1[2] + r1[3] * r1[3]); }
                s += __shfl_xor(s, 16); s += __shfl_xor(s, 32);
                if (fq == 0) ssn[(size_t)row * 32 + u.pn * 4 + wc] = s;
            }
        }
    }
};

struct SplitOrder {
    int c, kslice;
    __device__ __forceinline__ bool next(int i, Unit& u) const {
        if (i != 0 || c >= 64) return false;
        u.pm = 64 + (c & 1); u.pn = (c >> 1) & 7; u.kb = (c >> 4) * kslice; return true;
    }
    __device__ __forceinline__ void a_ready(const Unit&) const {}
    __device__ __forceinline__ void done(const Unit&) const {}
};
struct EpiSlab {
    static constexpr bool PERM = true, AFTER_DRAIN = false;
    static constexpr bool PREF = false;
    float* slab; float scale; int kslice;
    __device__ __forceinline__ void prefetch(const Unit&, int, int, float (&)[8]) const {}
    __device__ __forceinline__ void operator()(const f32x4 (&acc)[2][2][4][2], const Unit& u, int wr, int wc, int fr, int fq, const float (&)[8]) const {
        const int row0 = (u.pm - 64) * BM + wr * 64 + fr, col0 = u.pn * BM + wc * 32 + 8 * fq;
        float* sp = slab + (size_t)(u.kb / kslice) * (MS * DM);
#pragma unroll
        for (int ai = 0; ai < 2; ++ai)
#pragma unroll
            for (int m = 0; m < 4; ++m) { float* rp = sp + (size_t)(row0 + ai * HALF + m * 16) * DM + col0;
#pragma unroll
                for (int bj = 0; bj < 2; ++bj)
#pragma unroll
                    for (int n = 0; n < 2; ++n) *(f32x4*)(rp + bj * HALF + n * 4) = acc[ai][bj][m][n] * scale; }
    }
};

template <class Epi, class Sched, bool ALIGN_EPI = false, bool SP2 = false>
__device__ __forceinline__ void gemm_phase(LAS unsigned char* lds, const Gemm g, const Sched& S, const Epi& E) {
    int tid = threadIdx.x; asm volatile("" : "+v"(tid));
    const int wid = __builtin_amdgcn_readfirstlane(tid >> 6), lane = tid & 63, wr = wid >> 2, wc = wid & 3, fr = lane & 15, fq = lane >> 4;
    const int K = g.K, nt = g.nt;
    unsigned voffA[2], voffB[2];
#pragma unroll
    for (int i = 0; i < 2; ++i) { int R, C; stage_rc(tid * 16 + i * 8192, R, C); const int Rb = Epi::PERM ? ((R & ~31) + perm32(R & 31)) : R;
        voffA[i] = (unsigned)(R * K + C) * 2u; voffB[i] = (unsigned)(Rb * K + C) * 2u; }
    const size_t kstep = (size_t)(BK * 2);
    const size_t hstep = (size_t)HALF * K * 2;
    const size_t tstep = 2 * hstep;
    const unsigned ldsw = (unsigned)wid * 1024u;
    const int aoff = lds_byte(wr * 64 + fr, fq * 8), boff = lds_byte(wc * 32 + fr, fq * 8);
#define PG8_SA(b, h) (((b) * 2 + (h)) * HTB)
#define PG8_SB(b, h) ((4 + (b) * 2 + (h)) * HTB)
#define PG8_STAGE(bufoff, gbase, voff) do { _Pragma("unroll") for (int _i = 0; _i < 2; ++_i) \
        __builtin_amdgcn_global_load_lds((const unsigned*)((const char*)(gbase) + (voff)[_i]), (LAS unsigned*)(lds + (bufoff) + ldsw + _i * 8192), 16, 0, 0); } while (0)
#define PG8_LDA(dst, b, h) do { _Pragma("unroll") for (int m = 0; m < 4; ++m) _Pragma("unroll") for (int k = 0; k < 2; ++k) dst[m][k] = *(const LAS bf16x8*)(lds + PG8_SA(b, h) + aoff + m * 2048 + k * 1024); } while (0)
#define PG8_LDB(dst, b, h) do { _Pragma("unroll") for (int n = 0; n < 2; ++n) _Pragma("unroll") for (int k = 0; k < 2; ++k) dst[n][k] = *(const LAS bf16x8*)(lds + PG8_SB(b, h) + boff + n * 2048 + k * 1024); } while (0)
#define PG8_MMA(ai, bj, At, Bt) do { __builtin_amdgcn_s_setprio(1); _Pragma("unroll") for (int m = 0; m < 4; ++m) _Pragma("unroll") for (int n = 0; n < 2; ++n) _Pragma("unroll") for (int k = 0; k < 2; ++k) \
        acc[ai][bj][m][n] = __builtin_amdgcn_mfma_f32_16x16x32_bf16(Bt[n][k], At[m][k], acc[ai][bj][m][n], 0, 0, 0); __builtin_amdgcn_s_setprio(0); } while (0)
#define PG8_WAIT_V(n) asm volatile("s_waitcnt vmcnt(" #n ")" ::: "memory")
#define PG8_WAIT_L(n) asm volatile("s_waitcnt lgkmcnt(" #n ")" ::: "memory")
#define PG8_BAR __builtin_amdgcn_s_barrier()
#define PG8_SCHED __builtin_amdgcn_sched_barrier(0)
    Unit cur, nxt; int ui = 0;
    if (!S.next(0, cur)) return;
    f32x4 acc[2][2][4][2];
#pragma unroll
    for (int a = 0; a < 2; ++a)
#pragma unroll
        for (int b = 0; b < 2; ++b)
#pragma unroll
            for (int m = 0; m < 4; ++m)
#pragma unroll
                for (int n = 0; n < 2; ++n) acc[a][b][m][n] = (f32x4){0.f, 0.f, 0.f, 0.f};
    bf16x8 At[4][2], B0[2][2], B1[2][2];
    const char* cA = (const char*)g.A + (size_t)cur.pm * tstep + cur.kb; const char* cB = (const char*)g.Bt + (size_t)cur.pn * tstep + cur.kb;
    S.a_ready(cur);
    float sv[8];
#define PG8_SS_DMA(u, buf) do { if constexpr (Epi::PREF) { if (wid == 0) __builtin_amdgcn_global_load_lds((const unsigned*)(E.ss + (size_t)(u).pm * BM + 4 * lane), (LAS unsigned*)(lds + STAGE_BYTES + (buf) * 1024), 16, 0, 0); } } while (0)
    PG8_SS_DMA(cur, 0);
    if constexpr (SP2) {
        PG8_STAGE(PG8_SB(0, 0), cB, voffB); PG8_STAGE(PG8_SB(0, 1), cB + hstep, voffB); PG8_STAGE(PG8_SA(0, 0), cA, voffA); PG8_STAGE(PG8_SA(0, 1), cA + hstep, voffA);
        if (wr == 1) PG8_BAR;
        PG8_WAIT_V(2); PG8_BAR;
        PG8_STAGE(PG8_SB(1, 0), cB + kstep, voffB); PG8_STAGE(PG8_SA(1, 0), cA + kstep, voffA); PG8_STAGE(PG8_SB(1, 1), cB + hstep + kstep, voffB);
        PG8_WAIT_V(6); PG8_BAR;
    } else {
        PG8_STAGE(PG8_SB(0, 0), cB, voffB); PG8_STAGE(PG8_SA(0, 0), cA, voffA); PG8_STAGE(PG8_SB(0, 1), cB + hstep, voffB); PG8_STAGE(PG8_SA(0, 1), cA + hstep, voffA);
        if (wr == 1) PG8_BAR;
        PG8_WAIT_V(4); PG8_BAR;
        PG8_STAGE(PG8_SB(1, 0), cB + kstep, voffB); PG8_STAGE(PG8_SA(1, 0), cA + kstep, voffA); PG8_STAGE(PG8_SB(1, 1), cB + hstep + kstep, voffB);
        PG8_WAIT_V(6); PG8_BAR;
    }
    for (;;) {
        const bool has_next = S.next(ui + 1, nxt);
        const char* nA = has_next ? (const char*)g.A + (size_t)nxt.pm * tstep + nxt.kb : cA; const char* nB = has_next ? (const char*)g.Bt + (size_t)nxt.pn * tstep + nxt.kb : cB;
        for (int t = 0; t < nt; t += 2) {
            const bool last = (t == nt - 2);
            const char* a1 = cA + (size_t)(t + 1) * kstep;
            const char* a2 = last ? nA : cA + (size_t)(t + 2) * kstep; const char* b2 = last ? nB : cB + (size_t)(t + 2) * kstep;
            const char* a3 = a2 + kstep; const char* b3 = b2 + kstep;
            if (last && has_next) S.a_ready(nxt);
            if constexpr (SP2) {
            PG8_LDB(B0, 0, 0); PG8_LDB(B1, 0, 1); PG8_SCHED; PG8_LDA(At, 0, 0); PG8_STAGE(PG8_SA(1, 1), a1 + hstep, voffA);
            PG8_WAIT_V(8); PG8_WAIT_L(0); PG8_BAR; PG8_MMA(0, 0, At, B0); PG8_MMA(0, 1, At, B1); PG8_BAR; PG8_SCHED;
            PG8_LDA(At, 0, 1); PG8_STAGE(PG8_SB(0, 0), b2, voffB); PG8_STAGE(PG8_SB(0, 1), b2 + hstep, voffB); PG8_STAGE(PG8_SA(0, 0), a2, voffA);
            PG8_WAIT_V(8); PG8_WAIT_L(0); PG8_BAR; PG8_MMA(1, 0, At, B0); PG8_MMA(1, 1, At, B1); PG8_BAR; PG8_SCHED;
            PG8_LDB(B0, 1, 0); PG8_LDB(B1, 1, 1); PG8_SCHED; PG8_LDA(At, 1, 0); PG8_STAGE(PG8_SA(0, 1), a2 + hstep, voffA);
            PG8_WAIT_V(8); PG8_WAIT_L(0); PG8_BAR; PG8_MMA(0, 0, At, B0); PG8_MMA(0, 1, At, B1); PG8_BAR; PG8_SCHED;
            PG8_LDA(At, 1, 1); PG8_STAGE(PG8_SB(1, 0), b3, voffB); PG8_STAGE(PG8_SB(1, 1), b3 + hstep, voffB); PG8_STAGE(PG8_SA(1, 0), a3, voffA);
            PG8_WAIT_V(8); PG8_WAIT_L(0); PG8_BAR; PG8_MMA(1, 0, At, B0); PG8_MMA(1, 1, At, B1); PG8_BAR; PG8_SCHED;
            } else {
            PG8_LDB(B0, 0, 0); PG8_SCHED; PG8_LDA(At, 0, 0); PG8_STAGE(PG8_SA(1, 1), a1 + hstep, voffA);
            PG8_WAIT_L(8); PG8_BAR; PG8_WAIT_L(0); PG8_MMA(0, 0, At, B0); PG8_BAR; PG8_SCHED;
            PG8_LDB(B1, 0, 1); PG8_STAGE(PG8_SB(0, 0), b2, voffB);
            PG8_BAR; PG8_WAIT_L(0); PG8_MMA(0, 1, At, B1); PG8_BAR;
            PG8_LDA(At, 0, 1); PG8_STAGE(PG8_SA(0, 0), a2, voffA);
            PG8_BAR; PG8_WAIT_L(0); PG8_MMA(1, 0, At, B0); PG8_BAR; PG8_SCHED;
            PG8_STAGE(PG8_SB(0, 1), b2 + hstep, voffB);
            PG8_WAIT_V(6); PG8_BAR; PG8_MMA(1, 1, At, B1); PG8_BAR;
            PG8_LDB(B0, 1, 0); PG8_SCHED; PG8_LDA(At, 1, 0); PG8_STAGE(PG8_SA(0, 1), a2 + hstep, voffA);
            PG8_WAIT_L(8); PG8_BAR; PG8_WAIT_L(0); PG8_MMA(0, 0, At, B0); PG8_BAR; PG8_SCHED;
            PG8_LDB(B1, 1, 1); PG8_STAGE(PG8_SB(1, 0), b3, voffB);
            PG8_BAR; PG8_WAIT_L(0); PG8_MMA(0, 1, At, B1); PG8_BAR;
            PG8_LDA(At, 1, 1); PG8_STAGE(PG8_SA(1, 0), a3, voffA);
            PG8_BAR; PG8_WAIT_L(0); PG8_MMA(1, 0, At, B0); PG8_BAR; PG8_SCHED;
            PG8_STAGE(PG8_SB(1, 1), b3 + hstep, voffB);
            PG8_WAIT_V(6); PG8_BAR; PG8_MMA(1, 1, At, B1); PG8_BAR;
            }
        }
        if constexpr (ALIGN_EPI) { if (wr == 0) PG8_BAR; }
        if constexpr (Epi::PREF) {
#pragma unroll
            for (int ai = 0; ai < 2; ++ai)
#pragma unroll
                for (int m = 0; m < 4; ++m) sv[ai * 4 + m] = *(const LAS float*)(lds + STAGE_BYTES + (ui & 1) * 1024 + 4 * (ai * HALF + wr * 64 + m * 16 + fr));
        }
        if constexpr (!Epi::AFTER_DRAIN) { E(acc, cur, wr, wc, fr, fq, sv); S.done(cur); }
        if (!has_next) break;
#pragma unroll
        for (int a = 0; a < 2; ++a)
#pragma unroll
            for (int b = 0; b < 2; ++b)
#pragma unroll
                for (int m = 0; m < 4; ++m)
#pragma unroll
                    for (int n = 0; n < 2; ++n) acc[a][b][m][n] = (f32x4){0.f, 0.f, 0.f, 0.f};
        cur = nxt; cA = nA; cB = nB; ++ui;
        PG8_SS_DMA(cur, ui & 1);
        if constexpr (ALIGN_EPI) { if (wr == 1) PG8_BAR; }
    }
    PG8_WAIT_V(0);
    if constexpr (!ALIGN_EPI) { if (wr == 0) PG8_BAR; }
    PG8_BAR;
#undef PG8_SS_DMA
#undef PG8_SA
#undef PG8_SB
#undef PG8_STAGE
#undef PG8_LDA
#undef PG8_LDB
#undef PG8_MMA
#undef PG8_WAIT_V
#undef PG8_WAIT_L
#undef PG8_BAR
#undef PG8_SCHED
}
}

struct Params { const float* in[24]; float* out; unsigned char* ws; };
enum { I_XP = 0, I_XS, I_CA, I_CB, I_CP, I_N1, I_WG1, I_WU1, I_WD1, I_NM, I_WIN, I_CAW, I_CBW, I_CBB, I_LNG, I_LNB, I_PW, I_PS, I_WOUT, I_N2, I_WG2, I_WU2, I_WD2, I_NF };

__device__ __forceinline__ void tr_item(const float* W, int N, const float* gk, bf16_t* WT, int ldk, int drow0, int k0, int n0, LAS float* scr, int lane) {
    const int l16 = lane & 15, kq = lane >> 4;
    f32x4 v[16];
#pragma unroll
    for (int i = 0; i < 16; ++i) v[i] = *(const f32x4*)(W + (size_t)(k0 + 4 * i + kq) * N + n0 + 4 * l16);
    if (gk) {
#pragma unroll
        for (int i = 0; i < 16; ++i) v[i] = v[i] * gk[k0 + 4 * i + kq]; }
#pragma unroll
    for (int i = 0; i < 16; ++i) { LAS float* d = scr + (4 * i + kq) * 65 + 4 * l16; d[0] = v[i][0]; d[1] = v[i][1]; d[2] = v[i][2]; d[3] = v[i][3]; }
    LDS_WAIT(); asm volatile("" ::: "memory");
    const int c = lane & 7;
#pragma unroll
    for (int j = 0; j < 8; ++j) { const int n = (lane >> 3) + 8 * j; const LAS float* s = scr + (8 * c) * 65 + n;
        u32x4 o; o.x = cvt_pk_bf16(s[0 * 65], s[1 * 65]); o.y = cvt_pk_bf16(s[2 * 65], s[3 * 65]); o.z = cvt_pk_bf16(s[4 * 65], s[5 * 65]); o.w = cvt_pk_bf16(s[6 * 65], s[7 * 65]);
        *(u32x4*)(WT + (size_t)(drow0 + n) * ldk + k0 + 8 * c) = o; }
    LDS_WAIT(); asm volatile("" ::: "memory");
}

__device__ __forceinline__ void prologue(const Params& p, LAS unsigned char* lds, int G) {
    const int tid = threadIdx.x, lane = tid & 63, wave = __builtin_amdgcn_readfirstlane(tid >> 6);
    const int gw = blockIdx.x * 8 + wave, NGW = G * 8;
    float* ss = (float*)(p.ws + WS_SS);
    for (int b = blockIdx.x; b < 256; b += G) {
        const int layer = b >> 7, g = (b >> 5) & 3, n0 = (b & 31) * 64;
        LAS float* Bs = (LAS float*)lds;
        LAS float* As = (LAS float*)(lds + 32768);
        const float* wo = p.in[I_WOUT] + (size_t)layer * DM * DM + (size_t)(1536 + g * 128) * DM + n0;
        const float* ps = p.in[I_PS] + layer * DC + g * 128;
        const float* pw = p.in[I_PW] + (size_t)(layer * 4 + g) * 128 * 128;
#pragma unroll
        for (int i = 0; i < 4; ++i) { const int e = (i * 512 + tid) * 4, d = e >> 6, n = e & 63; const f32x4 v = *(const f32x4*)(wo + (size_t)d * DM + n) * ps[d]; *(LAS f32x4*)(Bs + d * 64 + n) = v; }
#pragma unroll
        for (int i = 0; i < 8; ++i) { const int e = (i * 512 + tid) * 4, c = e >> 7, d = e & 127; const f32x4 v = *(const f32x4*)(pw + e); LAS float* dp = As + c * 129 + d; dp[0] = v[0]; dp[1] = v[1]; dp[2] = v[2]; dp[3] = v[3]; }
        __syncthreads();
        float a[16];
#pragma unroll
        for (int i = 0; i < 16; ++i) a[i] = 0.f;
        for (int d = 0; d < 128; ++d) { const float bv = Bs[d * 64 + lane];
#pragma unroll
            for (int i = 0; i < 16; ++i) a[i] += As[(wave * 16 + i) * 129 + d] * bv; }
        bf16_t* dst = (bf16_t*)(p.ws + WS_W + (size_t)layer * W_LAYER + W_OUT) + (size_t)(n0 + lane) * DM + 1536 + g * 128 + wave * 16;
        u32x4 o0, o1;
        o0.x = cvt_pk_bf16(a[0], a[1]); o0.y = cvt_pk_bf16(a[2], a[3]); o0.z = cvt_pk_bf16(a[4], a[5]); o0.w = cvt_pk_bf16(a[6], a[7]);
        o1.x = cvt_pk_bf16(a[8], a[9]); o1.y = cvt_pk_bf16(a[10], a[11]); o1.z = cvt_pk_bf16(a[12], a[13]); o1.w = cvt_pk_bf16(a[14], a[15]);
        *(u32x4*)dst = o0; *(u32x4*)(dst + 8) = o1;
        __syncthreads();
    }
    LAS float* scr = (LAS float*)(lds + wave * 16640);
    constexpr int PER_LAYER = 2816 * 6 + 2176 + 768;
#pragma unroll 1
    for (int it = gw; it < 2 * PER_LAYER; it += NGW) {
        const int layer = it >= PER_LAYER ? 1 : 0; int r = it - layer * PER_LAYER;
        unsigned char* wl = p.ws + WS_W + (size_t)layer * W_LAYER;
        const float* W; const float* gk = nullptr; bf16_t* WT; int N, ldk, nnb, kind = 0;
        if (r < 2816) { W = p.in[I_WG1] + (size_t)layer * DM * DFF; gk = p.in[I_N1] + layer * DM; WT = (bf16_t*)(wl + W_GU1); N = DFF; ldk = DM; nnb = 88; kind = 1; }
        else if ((r -= 2816) < 2816) { W = p.in[I_WU1] + (size_t)layer * DM * DFF; gk = p.in[I_N1] + layer * DM; WT = (bf16_t*)(wl + W_GU1); N = DFF; ldk = DM; nnb = 88; kind = 2; }
        else if ((r -= 2816) < 2816) { W = p.in[I_WD1] + (size_t)layer * DFF * DM; WT = (bf16_t*)(wl + W_D1); N = DM; ldk = DFF; nnb = 32; }
        else if ((r -= 2816) < 2176) { W = p.in[I_WIN] + (size_t)layer * DM * DIN; gk = p.in[I_NM] + layer * DM; WT = (bf16_t*)(wl + W_IN); N = DIN; ldk = DM; nnb = 68; }
        else if ((r -= 2176) < 768) { W = p.in[I_WOUT] + (size_t)layer * DM * DM; WT = (bf16_t*)(wl + W_OUT); N = DM; ldk = DM; nnb = 32; }
        else if ((r -= 768) < 2816) { W = p.in[I_WG2] + (size_t)layer * DM * DFF; gk = p.in[I_N2] + layer * DM; WT = (bf16_t*)(wl + W_GU2); N = DFF; ldk = DM; nnb = 88; kind = 1; }
        else if ((r -= 2816) < 2816) { W = p.in[I_WU2] + (size_t)layer * DM * DFF; gk = p.in[I_N2] + layer * DM; WT = (bf16_t*)(wl + W_GU2); N = DFF; ldk = DM; nnb = 88; kind = 2; }
        else { r -= 2816; W = p.in[I_WD2] + (size_t)layer * DFF * DM; WT = (bf16_t*)(wl + W_D2); N = DM; ldk = DFF; nnb = 32; }
        const int kb = r / nnb, nb = r - kb * nnb, k0 = kb * 64, n0 = nb * 64;
        const int drow0 = kind ? ((n0 >> 7) * 256 + (kind - 1) * 128 + (n0 & 127)) : n0;
        tr_item(W, N, gk, WT, ldk, drow0, k0, n0, scr, lane);
    }
    bf16_t* hb = (bf16_t*)(p.ws + WS_HB);
    for (int m = gw; m < MT; m += NGW) {
        const float* xr = (m < MP) ? p.in[I_XP] + (size_t)m * DM : p.in[I_XS] + (size_t)(m - MP) * DM;
        float s = 0.f;
#pragma unroll
        for (int j = 0; j < 4; ++j) { const f32x4 v0 = *(const f32x4*)(xr + j * 512 + lane * 8), v1 = *(const f32x4*)(xr + j * 512 + lane * 8 + 4);
            s += (v0[0] * v0[0] + v0[1] * v0[1]) + (v0[2] * v0[2] + v0[3] * v0[3]) + (v1[0] * v1[0] + v1[1] * v1[1]) + (v1[2] * v1[2] + v1[3] * v1[3]);
            u32x4 w; w.x = cvt_pk_bf16(v0[0], v0[1]); w.y = cvt_pk_bf16(v0[2], v0[3]); w.z = cvt_pk_bf16(v1[0], v1[1]); w.w = cvt_pk_bf16(v1[2], v1[3]);
            *(u32x4*)(hb + (size_t)m * DM + j * 512 + lane * 8) = w; }
        s = wave_sum(s);
        if (lane == 0) ss[m] = s;
    }
}

__device__ __forceinline__ void ld8_bf16(const bf16_t* p, float (&v)[8]) {
    const u32x4 w = *(const u32x4*)p;
    v[0] = bf_lo(w.x); v[1] = bf_hi(w.x); v[2] = bf_lo(w.y); v[3] = bf_hi(w.y); v[4] = bf_lo(w.z); v[5] = bf_hi(w.z); v[6] = bf_lo(w.w); v[7] = bf_hi(w.w);
}
__device__ __forceinline__ void ld8_f32(const float* p, float (&v)[8]) {
    const f32x4 a = *(const f32x4*)p, b = *(const f32x4*)(p + 4);
    v[0] = a[0]; v[1] = a[1]; v[2] = a[2]; v[3] = a[3]; v[4] = b[0]; v[5] = b[1]; v[6] = b[2]; v[7] = b[3];
}
__device__ __forceinline__ void st8_f32(float* p, const float (&v)[8]) {
    *(f32x4*)p = (f32x4){v[0], v[1], v[2], v[3]}; *(f32x4*)(p + 4) = (f32x4){v[4], v[5], v[6], v[7]};
}
__device__ __forceinline__ void st8_bf16(bf16_t* p, const float (&v)[8]) {
    u32x4 w; w.x = cvt_pk_bf16(v[0], v[1]); w.y = cvt_pk_bf16(v[2], v[3]); w.z = cvt_pk_bf16(v[4], v[5]); w.w = cvt_pk_bf16(v[6], v[7]);
    *(u32x4*)p = w;
}

constexpr int TOK = 16, HALO = 30, VROWS = TOK + HALO, CH = 384, UP = DC + 16;
static_assert(31 * UP <= VROWS * CH, "parked pooling rows fit in the GLU tile");
__device__ __forceinline__ void mixer_mid(const Params& p, LAS unsigned char* lds, int G, int layer) {
    int tid = threadIdx.x; asm volatile("" : "+v"(tid));
    const int lane = tid & 63, wave = __builtin_amdgcn_readfirstlane(tid >> 6);
    LAS float* vt = (LAS float*)lds;
    LAS float* cb = (LAS float*)(lds + VROWS * CH * 4);
    const bf16_t* z = (const bf16_t*)(p.ws + WS_ACT);
    bf16_t* cat = (bf16_t*)(p.ws + WS_CAT);
    const float* caw = p.in[I_CAW] + layer * 3 * DA;
    const float* cbw = p.in[I_CBW] + layer * 31 * DB;
    const float* cbb = p.in[I_CBB] + layer * DB;
    const float* lng = p.in[I_LNG] + layer * DB;
    const float* lnb = p.in[I_LNB] + layer * DB;
    constexpr int NCH = MT / TOK, NCH_X = NCH / 8;
    static_assert(NCH % 8 == 0, "chunks divide over the XCDs");
    const int mx_x = (G % 8 == 0) ? (int)(blockIdx.x & 7) : 0, mx_r = (G % 8 == 0) ? (int)(blockIdx.x >> 3) : (int)blockIdx.x, mx_n = (G % 8 == 0) ? G / 8 : G, mx_tot = (G % 8 == 0) ? NCH_X : NCH;
    u32x4 ra[5], rg[5]; bool preloaded = false;
#define MIX_VLOAD(hc_, row0_) do { _Pragma("unroll") for (int i = 0; i < 5; ++i) { const int it = tid + 512 * i; if (it < VROWS * (CH / 8)) { const int j = it / (CH / 8), cl = (it - j * (CH / 8)) * 8; \
            const bf16_t* zr = z + ((ptrdiff_t)(row0_) - HALO + j) * DIN + (hc_) * CH + cl; ra[i] = *(const u32x4*)(zr + 2304); rg[i] = *(const u32x4*)(zr + 3072); } } } while (0)
    for (int ci = mx_r; ci < mx_tot; ci += mx_n) {
        const int ch = mx_x * NCH_X + ci;
        const bool samp = ch >= MP / TOK;
        int seq, l0, L;
        if (!samp) { seq = ch >> 9; l0 = (ch & 511) * TOK; L = 8192; } else { const int cs = ch - MP / TOK; seq = cs >> 2; l0 = (cs & 3) * TOK; L = 64; }
        const int row0 = ch * TOK;
        const bool lastc = (l0 + TOK == L), edge = (l0 < 32);
        const float* hist_a = p.in[I_CA] + (size_t)(layer * 8 + seq) * 2 * DA;
        const float* hist_b = p.in[I_CB] + (size_t)(layer * 8 + seq) * 30 * DB;
        const float* hist_p = p.in[I_CP] + (size_t)(layer * 8 + seq) * 15 * DC;
        float* out_a = p.out + (samp ? OFF_A_S + (layer * 8 + seq) * 2 * DA : OFF_A_P + (layer * 2 + seq) * 2 * DA);
        float* out_b = p.out + (samp ? OFF_B_S + (layer * 8 + seq) * 30 * DB : OFF_B_P + (layer * 2 + seq) * 30 * DB);
        float* out_p = p.out + (samp ? OFF_P_S + (layer * 8 + seq) * 15 * DC : OFF_P_P + (layer * 2 + seq) * 15 * DC);
        if (!preloaded) MIX_VLOAD(0, row0);
        preloaded = false;
#pragma unroll 1
        for (int hc = 0; hc < 2; ++hc) {
#pragma unroll
            for (int i = 0; i < 5; ++i) { const int it = tid + 512 * i; if (it < VROWS * (CH / 8)) { const int j = it / (CH / 8), cl = (it - j * (CH / 8)) * 8, c8 = hc * CH + cl;
                float v[8];
                v[0] = bf_lo(ra[i].x) * sigmoidf_(bf_lo(rg[i].x)); v[1] = bf_hi(ra[i].x) * sigmoidf_(bf_hi(rg[i].x));
                v[2] = bf_lo(ra[i].y) * sigmoidf_(bf_lo(rg[i].y)); v[3] = bf_hi(ra[i].y) * sigmoidf_(bf_hi(rg[i].y));
                v[4] = bf_lo(ra[i].z) * sigmoidf_(bf_lo(rg[i].z)); v[5] = bf_hi(ra[i].z) * sigmoidf_(bf_hi(rg[i].z));
                v[6] = bf_lo(ra[i].w) * sigmoidf_(bf_lo(rg[i].w)); v[7] = bf_hi(ra[i].w) * sigmoidf_(bf_hi(rg[i].w));
                if (edge) { const int l = l0 - HALO + j;
                    if (l < 0) { if (samp) ld8_f32(hist_b + (size_t)(30 + l) * DB + c8, v); else {
#pragma unroll
                        for (int e = 0; e < 8; ++e) v[e] = 0.f; } } }
                *(LAS f32x4*)(vt + j * CH + cl) = (f32x4){v[0], v[1], v[2], v[3]}; *(LAS f32x4*)(vt + j * CH + cl + 4) = (f32x4){v[4], v[5], v[6], v[7]};
                if (lastc && j >= TOK) st8_f32(out_b + (size_t)(j - TOK) * DB + c8, v); } }
            if (hc == 0) MIX_VLOAD(1, row0);
            else {
#pragma unroll
                for (int i = 0; i < 4; ++i) { const int it = tid + 512 * i; if (it < 31 * 64) { const int j = it >> 6, c8 = (it & 63) * 8; ra[i] = *(const u32x4*)(z + ((ptrdiff_t)row0 - 15 + j) * DIN + 3840 + c8); } } }
            __syncthreads();
            if (tid < CH) {
                const int c = hc * CH + tid;
                float wv[31];
#pragma unroll
                for (int k = 0; k < 31; ++k) wv[k] = cbw[k * DB + c];
                const float bias = cbb[c];
                float o[TOK];
#pragma unroll
                for (int i = 0; i < TOK; ++i) o[i] = bias;
                const LAS float* vp = vt + tid;
#pragma unroll
                for (int jj = 0; jj < VROWS; ++jj) { const float x = vp[jj * CH];
#pragma unroll
                    for (int i = 0; i < TOK; ++i) { if (jj - i >= 0 && jj - i <= 30) o[i] += wv[(jj - i >= 0 && jj - i <= 30) ? jj - i : 0] * x; } }
#pragma unroll
                for (int i = 0; i < TOK; ++i) cb[i * DB + c] = o[i];
            }
            __syncthreads();
        }
#pragma unroll
        for (int i = 0; i < 4; ++i) { const int it = tid + 512 * i; if (it < 31 * 64) { const int j = it >> 6, c8 = (it & 63) * 8; const u32x4 r = ra[i];
            float u[8] = {bf_lo(r.x), bf_hi(r.x), bf_lo(r.y), bf_hi(r.y), bf_lo(r.z), bf_hi(r.z), bf_lo(r.w), bf_hi(r.w)};
            if (edge) { const int l = l0 - 15 + j;
                if (l < 0) { if (samp) ld8_f32(hist_p + (size_t)(15 + l) * DC + c8, u); else {
#pragma unroll
                    for (int e = 0; e < 8; ++e) u[e] = 0.f; } } }
            *(LAS f32x4*)(vt + j * UP + c8) = (f32x4){u[0], u[1], u[2], u[3]}; *(LAS f32x4*)(vt + j * UP + c8 + 4) = (f32x4){u[4], u[5], u[6], u[7]}; } }
        { const int cin = ci + mx_n;
          if (cin < mx_tot) { MIX_VLOAD(0, (mx_x * NCH_X + cin) * TOK); preloaded = true; } }
#pragma unroll 1
        for (int tt = 0; tt < 2; ++tt) { const int tk = wave * 2 + tt; f32x2 x[6]; float s = 0.f;
#pragma unroll
            for (int i = 0; i < 6; ++i) { x[i] = *(const LAS f32x2*)(cb + tk * DB + 128 * i + 2 * lane); s += x[i].x + x[i].y; }
            const float mean = wave_sum(s) * (1.f / DB); float q2 = 0.f;
#pragma unroll
            for (int i = 0; i < 6; ++i) { x[i].x -= mean; x[i].y -= mean; q2 += x[i].x * x[i].x + x[i].y * x[i].y; }
            const float rstd = __builtin_amdgcn_rsqf(wave_sum(q2) * (1.f / DB) + EPS);
#pragma unroll
            for (int i = 0; i < 6; ++i) { const int c = 128 * i + 2 * lane; const f32x2 gg = *(const f32x2*)(lng + c), bb = *(const f32x2*)(lnb + c);
                const float y0 = siluf_(x[i].x * rstd * gg.x + bb.x), y1 = siluf_(x[i].y * rstd * gg.y + bb.y);
                *(unsigned*)(cat + (size_t)(row0 + tk) * DM + DA + c) = cvt_pk_bf16(y0, y1); } }
        if (tid < 4 * 96) {
            const int tq = tid / 96, c8 = (tid - tq * 96) * 8, lb = l0 + 4 * tq; const size_t rowb = row0 + 4 * tq; const bf16_t* zr = z + rowb * DIN + c8;
            u32x4 qa[6], qc[6], qb[4];
#pragma unroll
            for (int r = 0; r < 6; ++r) { qa[r] = *(const u32x4*)(zr + (ptrdiff_t)(r - 2) * DIN); qc[r] = *(const u32x4*)(zr + (ptrdiff_t)(r - 2) * DIN + 1536); }
#pragma unroll
            for (int k = 0; k < 4; ++k) qb[k] = *(const u32x4*)(zr + (size_t)k * DIN + 768);
            float w[3][8];
#pragma unroll
            for (int q = 0; q < 3; ++q) ld8_f32(caw + q * DA + c8, w[q]);
            float t[6][8];
#pragma unroll
            for (int r = 0; r < 6; ++r) {
                t[r][0] = bf_lo(qa[r].x) * bf_lo(qc[r].x); t[r][1] = bf_hi(qa[r].x) * bf_hi(qc[r].x); t[r][2] = bf_lo(qa[r].y) * bf_lo(qc[r].y); t[r][3] = bf_hi(qa[r].y) * bf_hi(qc[r].y);
                t[r][4] = bf_lo(qa[r].z) * bf_lo(qc[r].z); t[r][5] = bf_hi(qa[r].z) * bf_hi(qc[r].z); t[r][6] = bf_lo(qa[r].w) * bf_lo(qc[r].w); t[r][7] = bf_hi(qa[r].w) * bf_hi(qc[r].w);
                if (edge) { const int lq = lb - 2 + r;
                    if (lq < 0) { if (samp) ld8_f32(hist_a + (size_t)(2 + lq) * DA + c8, t[r]); else {
#pragma unroll
                        for (int e = 0; e < 8; ++e) t[r][e] = 0.f; } } } }
#pragma unroll
            for (int k = 0; k < 4; ++k) { float y[8];
#pragma unroll
                for (int e = 0; e < 8; ++e) { y[e] = 0.f; y[e] += w[0][e] * t[k][e]; y[e] += w[1][e] * t[k + 1][e]; y[e] += w[2][e] * t[k + 2][e]; }
                y[0] *= bf_lo(qb[k].x); y[1] *= bf_hi(qb[k].x); y[2] *= bf_lo(qb[k].y); y[3] *= bf_hi(qb[k].y); y[4] *= bf_lo(qb[k].z); y[5] *= bf_hi(qb[k].z); y[6] *= bf_lo(qb[k].w); y[7] *= bf_hi(qb[k].w);
                st8_bf16(cat + (rowb + k) * DM + c8, y); }
            if (lastc && tq == 3) { st8_f32(out_a + c8, t[4]); st8_f32(out_a + DA + c8, t[5]); }
        }
        __syncthreads();
#pragma unroll 1
        for (int i = 0; i < 2; ++i) { const int it = i == 0 ? tid : 1023 - tid, g = it >> 8, tk = (it >> 4) & 15, c8 = g * 128 + (it & 15) * 8, l = l0 + tk; const size_t row = row0 + tk; const int w = 2 << g;
            const LAS float* up = vt + (15 + tk) * UP + c8;
            const f32x4 u0a = *(const LAS f32x4*)up, u0b = *(const LAS f32x4*)(up + 4);
            f32x4 sa = u0a, sb = u0b;
            for (int q = 1; q < w; ++q) { sa += *(const LAS f32x4*)(up - q * UP); sb += *(const LAS f32x4*)(up - q * UP + 4); }
            const int cnt = (samp || l + 1 >= w) ? w : l + 1;
            const float rc = 1.f / (float)cnt; float d[8], u0[8];
#pragma unroll
            for (int e = 0; e < 4; ++e) { u0[e] = u0a[e]; u0[4 + e] = u0b[e]; d[e] = sa[e] * rc - u0a[e]; d[4 + e] = sb[e] * rc - u0b[e]; }
            st8_bf16(cat + row * DM + 1536 + c8, d);
            if (lastc && tk >= 1) st8_f32(out_p + (size_t)(tk - 1) * DC + c8, u0); }
        __syncthreads();
    }
#undef MIX_VLOAD
}

__device__ __forceinline__ void sample_fixup(const Params& p, int G, float* ss_out) {
    int tid = threadIdx.x; asm volatile("" : "+v"(tid));
    const int lane = tid & 63, wave = __builtin_amdgcn_readfirstlane(tid >> 6);
    bf16_t* hb = (bf16_t*)(p.ws + WS_HB);
    const float* slab = (const float*)(p.ws + WS_SLAB);
    for (int m = blockIdx.x * 8 + wave; m < MS; m += G * 8) {
        bf16_t* hr = hb + (size_t)(MP + m) * DM; float s = 0.f;
#pragma unroll
        for (int j = 0; j < 4; ++j) { const int c = j * 512 + lane * 8; float b[8]; ld8_bf16(hr + c, b);
            f32x4 v0 = (f32x4){b[0], b[1], b[2], b[3]}, v1 = (f32x4){b[4], b[5], b[6], b[7]};
#pragma unroll
            for (int q = 0; q < 4; ++q) { const float* sr = slab + (size_t)q * (MS * DM) + (size_t)m * DM + c; v0 += *(const f32x4*)sr; v1 += *(const f32x4*)(sr + 4); }
            u32x4 w; w.x = cvt_pk_bf16(v0[0], v0[1]); w.y = cvt_pk_bf16(v0[2], v0[3]); w.z = cvt_pk_bf16(v1[0], v1[1]); w.w = cvt_pk_bf16(v1[2], v1[3]);
            *(u32x4*)(hr + c) = w;
            const float r[8] = {bf_lo(w.x), bf_hi(w.x), bf_lo(w.y), bf_hi(w.y), bf_lo(w.z), bf_hi(w.z), bf_lo(w.w), bf_hi(w.w)};
#pragma unroll
            for (int e = 0; e < 8; ++e) s += r[e] * r[e]; }
        s = wave_sum(s);
        if (lane == 0) ss_out[MP + m] = s;
    }
    const float* ssp = (const float*)(p.ws + WS_SSP);
    for (int r2 = blockIdx.x * 8 + wave; r2 < MP / 2; r2 += G * 8) {
        const int row = r2 * 2 + (lane >> 5);
        float v = ssp[(size_t)row * 32 + (lane & 31)];
#pragma unroll
        for (int o = 1; o < 32; o <<= 1) v += __shfl_xor(v, o);
        if ((lane & 31) == 0) ss_out[row] = v;
    }
}

__device__ __forceinline__ void final_norm(const Params& p, int G) {
    int tid = threadIdx.x; asm volatile("" : "+v"(tid));
    const int lane = tid & 63, wave = __builtin_amdgcn_readfirstlane(tid >> 6);
    const int gw = blockIdx.x * 8 + wave, NGW = G * 8;
    const float* ss = (const float*)(p.ws + WS_SS) + 6 * MT;
    const float* gn = p.in[I_NF];
    const bf16_t* hb = (const bf16_t*)(p.ws + WS_HB);
    for (int m = gw; m < MT; m += NGW) {
        const float rinv = __builtin_amdgcn_rsqf(ss[m] * (1.f / DM) + EPS);
        float* orow = p.out + (size_t)m * DM;
#pragma unroll
        for (int j = 0; j < 4; ++j) { const int c = j * 512 + lane * 8; float b[8], g[8]; ld8_bf16(hb + (size_t)m * DM + c, b); ld8_f32(gn + c, g);
#pragma unroll
            for (int e = 0; e < 8; ++e) b[e] = b[e] * rinv * g[e];
            st8_f32(orow + c, b); }
    }
}

__device__ __forceinline__ void final_fused(const Params& p, int G) {
    int tid = threadIdx.x; asm volatile("" : "+v"(tid));
    const int lane = tid & 63, wave = __builtin_amdgcn_readfirstlane(tid >> 6);
    const int gw = blockIdx.x * 8 + wave, NGW = G * 8;
    const float* gn = p.in[I_NF];
    const bf16_t* hb = (const bf16_t*)(p.ws + WS_HB);
    const float* ssp = (const float*)(p.ws + WS_SSP);
    const float* slab = (const float*)(p.ws + WS_SLAB);
    for (int m = gw; m < MT; m += NGW) {
        float b[4][8]; float s;
#pragma unroll
        for (int j = 0; j < 4; ++j) ld8_bf16(hb + (size_t)m * DM + j * 512 + lane * 8, b[j]);
        if (m < MP) {
            float v = ssp[(size_t)m * 32 + (lane & 31)];
#pragma unroll
            for (int o = 1; o < 32; o <<= 1) v += __shfl_xor(v, o);
            s = v;
        } else {
            s = 0.f;
#pragma unroll
            for (int j = 0; j < 4; ++j) {
#pragma unroll
                for (int q = 0; q < 4; ++q) { float t[8]; ld8_f32(slab + (size_t)q * (MS * DM) + (size_t)(m - MP) * DM + j * 512 + lane * 8, t);
#pragma unroll
                    for (int e = 0; e < 8; ++e) b[j][e] += t[e]; }
#pragma unroll
                for (int e = 0; e < 8; ++e) s += b[j][e] * b[j][e]; }
            s = wave_sum(s);
        }
        const float rinv = __builtin_amdgcn_rsqf(s * (1.f / DM) + EPS);
        float* orow = p.out + (size_t)m * DM;
#pragma unroll
        for (int j = 0; j < 4; ++j) { const int c = j * 512 + lane * 8; float g[8]; ld8_f32(gn + c, g);
#pragma unroll
            for (int e = 0; e < 8; ++e) b[j][e] = b[j][e] * rinv * g[e];
            st8_f32(orow + c, b[j]); }
    }
}

#define XB_TMO      128
#define XB_XCNT(j)  (256  + 64 * (j))
#define XB_XSUB(j)  (1280 + 64 * (j))
#define XB_XGEN(j)  (2304 + 64 * (j))
#define XB_TOP      3328
#define XB_TOPGEN   3392
#define XCD_BAR_WORDS 3456
#define XB_SPIN_CAP (1u << 22)
__device__ __forceinline__ unsigned xb_ld(unsigned* p)              { return __hip_atomic_load(p, __ATOMIC_RELAXED, __HIP_MEMORY_SCOPE_AGENT); }
__device__ __forceinline__ unsigned xb_add(unsigned* p, unsigned v) { return __hip_atomic_fetch_add(p, v, __ATOMIC_RELAXED, __HIP_MEMORY_SCOPE_AGENT); }
__device__ __forceinline__ unsigned xb_xcc_id() { return (unsigned)__builtin_amdgcn_s_getreg((3 << 11) | 20) & 0xFu; }
#define XB_SPIN(cond, bar) do { unsigned _sp = 0; while (cond) { __builtin_amdgcn_s_sleep(1); \
    if ((++_sp & 255u) == 0u) { if (xb_ld(&(bar)[XB_TMO])) break; if (_sp > XB_SPIN_CAP) { atomicAdd(&(bar)[XB_TMO], 1u); break; } } } } while (0)
struct XcdBarrier { unsigned* bar; unsigned x; volatile LAS unsigned* st; };
__device__ __forceinline__ XcdBarrier xcd_barrier_post(unsigned* bar, volatile LAS unsigned* st) {
    XcdBarrier b; b.bar = bar; b.x = xb_xcc_id(); b.st = st;
    if (threadIdx.x == 0) (void)xb_add(&bar[XB_XCNT(b.x)], 1u);
    return b;
}
__device__ __forceinline__ void xcd_barrier_complete(unsigned* bar, unsigned x, unsigned& nloc, unsigned& nx) {
    const unsigned G = gridDim.x * gridDim.y * gridDim.z;
    unsigned sum, cnt, mine, sp = 0u;
    for (;;) {
        sum = 0u; cnt = 0u; mine = 0u;
#pragma unroll
        for (unsigned j = 0; j < 16; ++j) { const unsigned c = xb_ld(&bar[XB_XCNT(j)]); sum += c; cnt += (c > 0u) ? 1u : 0u; mine = (j == x) ? c : mine; }
        if (sum == G) break;
        __builtin_amdgcn_s_sleep(1);
        if ((++sp & 255u) == 0u) { if (xb_ld(&bar[XB_TMO])) break; if (sp > XB_SPIN_CAP) { atomicAdd(&bar[XB_TMO], 1u); break; } }
    }
    nloc = mine > 0u ? mine : 1u; nx = cnt > 0u ? cnt : 1u;
}
__device__ __forceinline__ void xcd_barrier(const XcdBarrier& b) {
    asm volatile("s_waitcnt vmcnt(0)" ::: "memory");
    __syncthreads();
    if (threadIdx.x == 0) {
        unsigned* bar = b.bar;
        __builtin_amdgcn_s_waitcnt(0);
        unsigned nloc = b.st[0], nx = b.st[1];
        if (nloc == 0u) { xcd_barrier_complete(bar, b.x, nloc, nx); b.st[0] = nloc; b.st[1] = nx; }
        const unsigned old = xb_add(&bar[XB_XSUB(b.x)], 1u);
        const unsigned gen = old / nloc;
        if (old + 1u == (gen + 1u) * nloc) {
            __builtin_amdgcn_fence(__ATOMIC_RELEASE, "agent");
            asm volatile("s_waitcnt vmcnt(0)" ::: "memory");
            const unsigned og = xb_add(&bar[XB_TOP], 1u);
            const unsigned tg = og / nx;
            if (og + 1u == (tg + 1u) * nx) xb_add(&bar[XB_TOPGEN], 1u);
            else XB_SPIN(xb_ld(&bar[XB_TOPGEN]) == tg, bar);
            __builtin_amdgcn_fence(__ATOMIC_ACQUIRE, "agent");
            xb_add(&bar[XB_XGEN(b.x)], 1u);
            asm volatile("s_waitcnt vmcnt(0)" ::: "memory");
        } else {
            XB_SPIN(xb_ld(&bar[XB_XGEN(b.x)]) == gen, bar);
            __builtin_amdgcn_fence(__ATOMIC_ACQUIRE, "agent");
            asm volatile("s_waitcnt vmcnt(0)" ::: "memory");
        }
    }
    __syncthreads();
}

__global__ void __launch_bounds__(512, 2) fwd_megakernel(Params p) {
    extern __shared__ __attribute__((aligned(16))) unsigned char lds_raw[];
    LAS unsigned char* lds = (LAS unsigned char*)lds_raw;
    cg::grid_group grid = cg::this_grid();
    const int G = gridDim.x;
    float* ssb = (float*)(p.ws + WS_SS);
    bf16_t* hb = (bf16_t*)(p.ws + WS_HB);
    bf16_t* act = (bf16_t*)(p.ws + WS_ACT);
    bf16_t* cat = (bf16_t*)(p.ws + WS_CAT);

    volatile LAS unsigned* misc = (volatile LAS unsigned*)(lds + MISC_OFF);
    if (threadIdx.x < 2) misc[threadIdx.x] = 0u;
    __syncthreads();
    const XcdBarrier xbar = xcd_barrier_post((unsigned*)(p.ws + WS_BAR), misc);
#pragma unroll 1
    for (int rep = 0; rep < REP_PRO; ++rep)
    prologue(p, lds, G);
#define GRID_BAR() xcd_barrier(xbar)
    if (gridDim.y > 1u) grid.sync();
    GRID_BAR();

    for (int st = 0; st < 6; ++st) {
        const int layer = st / 3, sub = st - layer * 3;
        unsigned char* wl = p.ws + WS_W + (size_t)layer * W_LAYER;
        if (sub != 1) {
            const int f = sub >> 1;
            const float* ss_in = ssb + (size_t)(layer * 3 + (f ? 2 : 0)) * MT;
            float* ss_out = ssb + (size_t)(layer * 3 + (f ? 3 : 1)) * MT;
            const bf16_t* wgu = (const bf16_t*)(wl + (f ? W_GU2 : W_GU1));
            const bf16_t* wd = (const bf16_t*)(wl + (f ? W_D2 : W_D1));
            { pg8::Gemm g{hb, wgu, MT, 2 * DFF, DM, DM / 64}; pg8::StaticOrder S; S.init(MT, 2 * DFF, G, (int)blockIdx.x);
              pg8::EpiSwiGLU E{act, ss_in};
#pragma unroll 1
              for (int rep = 0; rep < REP_GU; ++rep)
              pg8::gemm_phase<pg8::EpiSwiGLU, pg8::StaticOrder, true, true>(lds, g, S, E); }
            GRID_BAR();
            { const bool first = (st == 0);
              { pg8::Gemm g{act, wd, MP, DM, DFF, DFF / 64}; pg8::StaticOrder S; S.init(MP, DM, G, (int)blockIdx.x);
                pg8::EpiResid E{hb, (float*)(p.ws + WS_SSP), 0.5f};
                pg8::gemm_phase<pg8::EpiResid, pg8::StaticOrder, true, true>(lds, g, S, E); }
              { pg8::Gemm g{act, wd, MT, DM, DFF, DFF / 256}; pg8::SplitOrder S{(int)blockIdx.x, (DFF / 4) * 2};
                pg8::EpiSlab E{(float*)(p.ws + WS_SLAB), 0.5f, (DFF / 4) * 2};
                pg8::gemm_phase<pg8::EpiSlab, pg8::SplitOrder, true, true>(lds, g, S, E); } }
            GRID_BAR();
            if (st != 5) { sample_fixup(p, G, ss_out); GRID_BAR(); }
        } else {
            const float* ss_in = ssb + (size_t)(layer * 3 + 1) * MT;
            float* ss_out = ssb + (size_t)(layer * 3 + 2) * MT;
            { pg8::Gemm g{hb, (const bf16_t*)(wl + W_IN), MT, DIN, DM, DM / 64}; pg8::StaticOrder S; S.init(MT, DIN, G, (int)blockIdx.x);
              pg8::EpiScaleBf16 E{act, DIN, ss_in};
#pragma unroll 1
              for (int rep = 0; rep < REP_WIN; ++rep)
              pg8::gemm_phase<pg8::EpiScaleBf16, pg8::StaticOrder, true, true>(lds, g, S, E); }
            GRID_BAR();
#pragma unroll 1
            for (int rep = 0; rep < REP_MIX; ++rep)
            mixer_mid(p, lds, G, layer);
            GRID_BAR();
            { pg8::Gemm g{cat, (const bf16_t*)(wl + W_OUT), MP, DM, DM, DM / 64}; pg8::StaticOrder S; S.init(MP, DM, G, (int)blockIdx.x);
              pg8::EpiResid E{hb, (float*)(p.ws + WS_SSP), 1.0f};
              pg8::gemm_phase<pg8::EpiResid, pg8::StaticOrder, true, true>(lds, g, S, E); }
            { pg8::Gemm g{cat, (const bf16_t*)(wl + W_OUT), MT, DM, DM, DM / 256}; pg8::SplitOrder S{(int)blockIdx.x, (DM / 4) * 2};
              pg8::EpiSlab E{(float*)(p.ws + WS_SLAB), 1.0f, (DM / 4) * 2};
              pg8::gemm_phase<pg8::EpiSlab, pg8::SplitOrder, true, true>(lds, g, S, E); }
            GRID_BAR();
            sample_fixup(p, G, ss_out);
            GRID_BAR();
        }
    }
    final_fused(p, G);
}

extern "C" void kernel_launch(void* const* d_in, const int* in_sizes, int n_in, void* d_out, int out_size, void* d_ws, size_t ws_size, hipStream_t stream) {
    static int grid = 0;
    if (grid == 0) {
        if (n_in != 24 || ws_size < WS_END) { fprintf(stderr, "kernel_launch: need 24 inputs and >= %zu bytes of workspace (got %d, %zu)\n", (size_t)WS_END, n_in, ws_size); grid = -1; return; }
        int dev = 0, cus = 0, per_cu = 0;
        hipGetDevice(&dev);
        hipDeviceGetAttribute(&cus, hipDeviceAttributeMultiprocessorCount, dev);
        hipFuncSetAttribute((const void*)fwd_megakernel, hipFuncAttributeMaxDynamicSharedMemorySize, LDS_BYTES);
        hipOccupancyMaxActiveBlocksPerMultiprocessor(&per_cu, (const void*)fwd_megakernel, 512, LDS_BYTES);
        if (per_cu < 1) { fprintf(stderr, "kernel_launch: occupancy query returned %d\n", per_cu); per_cu = 1; }
        grid = cus * per_cu;
    }
    if (grid < 0) return;
    if (hipMemsetAsync((char*)d_ws + WS_BAR, 0, WS_BAR_BYTES, stream) != hipSuccess) { fprintf(stderr, "kernel_launch: memset failed\n"); return; }
    Params p{};
    for (int i = 0; i < 24; ++i) p.in[i] = (const float*)d_in[i];
    p.out = (float*)d_out; p.ws = (unsigned char*)d_ws;
    void* args[] = {&p};
    hipError_t e = hipLaunchCooperativeKernel((void*)fwd_megakernel, dim3(grid), dim3(512), args, LDS_BYTES, stream);
    if (e != hipSuccess) fprintf(stderr, "cooperative launch failed: %s (grid %d)\n", hipGetErrorString(e), grid);
}
```
